# Optimizing an MI355X kernel written in HIP

```python
import jax
import jax.numpy as jnp
from jax import lax
import numpy as np

D_MODEL = 2048
BATCH = 4
SEQ = 4096
DEPTH = 2

GRID_W = 64
CTX_LEN = 256
HEAD_DIM = 64
ROPE_THETA = 10000.0
EPS = 1e-6
NEG_INF = -1e30

A_HEADS = 8
A_KV_HEADS = 2
A_REP = A_HEADS // A_KV_HEADS
A_WINDOW = 128
A_BLOCK = 128

B_HEADS = 8
B_Q_RANK = 384
B_KV_RANK = 128
B_NOPE = 64
B_ROPE = 32
B_QK = B_NOPE + B_ROPE
B_V = 64
B_QBLOCK = 128

C_HEADS = 8
C_CHUNK = 128

D_HEADS = 8
NA_ROWS = 8
NA_COLS = 16

MIX_WIDTH = (A_HEADS + B_HEADS + C_HEADS + D_HEADS) * HEAD_DIM
IN_SIZES = (A_HEADS * HEAD_DIM, A_KV_HEADS * HEAD_DIM, A_KV_HEADS * HEAD_DIM,
            B_Q_RANK, B_KV_RANK, B_ROPE,
            C_HEADS * HEAD_DIM, C_HEADS * HEAD_DIM, C_HEADS * HEAD_DIM, C_HEADS * HEAD_DIM,
            D_HEADS * HEAD_DIM, D_HEADS * HEAD_DIM, D_HEADS * HEAD_DIM)
IN_COLS = sum(IN_SIZES)

D_FF = 7168
N_EXPERTS = 8
TOP_K = 2
EXPERT_FF = 7168
N_DENSE = (DEPTH + 1) // 2
N_MOE = DEPTH // 2

kernel_name = 'hybrid_parallel_heads_diffusion_block'


def rms_norm(x, gain=None):
    xf = x.astype(jnp.float32)
    y = xf * lax.rsqrt(jnp.mean(xf * xf, axis=-1, keepdims=True) + EPS)
    if gain is not None:
        y = y * gain.astype(jnp.float32)
    return y.astype(x.dtype)


def modulate(x, shift, scale):
    return x * (1.0 + scale) + shift


def axial_rope_tables(n_tokens, rot_dim):
    n_freq = rot_dim // 4
    t = jnp.arange(n_tokens, dtype=jnp.int32)
    row = (t // GRID_W).astype(jnp.float32)
    col = (t % GRID_W).astype(jnp.float32)
    freqs = ROPE_THETA ** (-jnp.arange(n_freq, dtype=jnp.float32) / n_freq)
    ang = jnp.concatenate([row[:, None] * freqs[None, :], col[:, None] * freqs[None, :]], axis=-1)
    return jnp.cos(ang), jnp.sin(ang)


def apply_rope(x, cos, sin):
    half = x.shape[-1] // 2
    x1, x2 = x[..., :half], x[..., half:]
    c = cos[None, :, None, :].astype(x.dtype)
    s = sin[None, :, None, :].astype(x.dtype)
    return jnp.concatenate([x1 * c - x2 * s, x1 * s + x2 * c], axis=-1)


def context_attention(q, k, v, scale, sink=None):
    s = jnp.einsum('bqhd,bkhd->bhqk', q, k).astype(jnp.float32) * scale
    n_keys = k.shape[1]
    if sink is not None:
        sink_logit = jnp.broadcast_to(sink.astype(jnp.float32)[None, :, None, None], s.shape[:3] + (1,))
        s = jnp.concatenate([s, sink_logit], axis=-1)
    p = jax.nn.softmax(s, axis=-1)[..., :n_keys]
    o = jnp.einsum('bhqk,bkhd->bqhd', p.astype(v.dtype), v)
    return o.reshape(o.shape[0], o.shape[1], -1)


def window_gqa_mixer(q, k, v, qc, kc, vc, q_gain, k_gain, sink, cos, sin, with_ctx_out):
    B, S, _ = q.shape
    L = kc.shape[1]
    scale = HEAD_DIM ** -0.5
    q = apply_rope(rms_norm(q.reshape(B, S, A_HEADS, HEAD_DIM), q_gain), cos, sin)
    k = apply_rope(rms_norm(k.reshape(B, S, A_KV_HEADS, HEAD_DIM), k_gain), cos, sin)
    v = v.reshape(B, S, A_KV_HEADS, HEAD_DIM)
    kc = rms_norm(kc.reshape(B, L, A_KV_HEADS, HEAD_DIM), k_gain)
    vc = vc.reshape(B, L, A_KV_HEADS, HEAD_DIM)
    sink32 = sink.astype(jnp.float32)
    nb = S // A_BLOCK
    qb = q.reshape(B, nb, A_BLOCK, A_KV_HEADS, A_REP, HEAD_DIM)

    def band(t):
        tp = jnp.pad(t, ((0, 0), (A_BLOCK, A_BLOCK), (0, 0), (0, 0)))
        tp = tp.reshape(B, nb + 2, A_BLOCK, A_KV_HEADS, HEAD_DIM)
        return jnp.concatenate([tp[:, :-2], tp[:, 1:-1], tp[:, 2:]], axis=2)

    kb, vb = band(k), band(v)
    n_band = 3 * A_BLOCK
    qi = jnp.arange(A_BLOCK)[:, None]
    kj = jnp.arange(n_band)[None, :] - A_BLOCK
    kpos = jnp.arange(nb)[:, None, None] * A_BLOCK + kj
    valid = (jnp.abs(qi - kj) <= A_WINDOW) & (kpos >= 0) & (kpos < S)
    s_win = jnp.einsum('bnqgrd,bnkgd->bgrnqk', qb, kb).astype(jnp.float32) * scale
    s_win = jnp.where(valid, s_win, NEG_INF)
    s_ctx = jnp.einsum('bnqgrd,bkgd->bgrnqk', qb, kc).astype(jnp.float32) * scale
    s_sink = jnp.broadcast_to(sink32.reshape(A_KV_HEADS, A_REP)[None, :, :, None, None, None],
                              s_win.shape[:-1] + (1,))
    p = jax.nn.softmax(jnp.concatenate([s_win, s_ctx, s_sink], axis=-1), axis=-1)
    o = (jnp.einsum('bgrnqk,bnkgd->bnqgrd', p[..., :n_band].astype(v.dtype), vb)
         + jnp.einsum('bgrnqk,bkgd->bnqgrd', p[..., n_band:n_band + L].astype(v.dtype), vc))
    o = o.reshape(B, S, A_HEADS * HEAD_DIM)
    o_ctx = None
    if with_ctx_out:
        qcr = rms_norm(qc.reshape(B, L, A_HEADS, HEAD_DIM), q_gain)
        o_ctx = context_attention(qcr, jnp.repeat(kc, A_REP, axis=2), jnp.repeat(vc, A_REP, axis=2), scale, sink32)
    return o, o_ctx


def mla_mixer(cq, ckv, kr, cq_c, ckv_c, kr_c, qa_gain, kva_gain, w_uq, w_ukv, q_gain, k_gain, cos, sin,
              with_ctx_out):
    scale = B_QK ** -0.5

    def queries(c_q, rotate):
        Bn, T, _ = c_q.shape
        q = rms_norm((rms_norm(c_q, qa_gain) @ w_uq).reshape(Bn, T, B_HEADS, B_QK), q_gain)
        if rotate:
            q = jnp.concatenate([q[..., :B_NOPE], apply_rope(q[..., B_NOPE:], cos, sin)], axis=-1)
        return q

    def keys_values(c_kv, k_rope, rotate):
        Bn, T, _ = c_kv.shape
        kv = (rms_norm(c_kv, kva_gain) @ w_ukv).reshape(Bn, T, B_HEADS, B_NOPE + B_V)
        k_shared = jnp.broadcast_to(k_rope[:, :, None, :], (Bn, T, B_HEADS, B_ROPE))
        k = rms_norm(jnp.concatenate([kv[..., :B_NOPE], k_shared], axis=-1), k_gain)
        if rotate:
            k = jnp.concatenate([k[..., :B_NOPE], apply_rope(k[..., B_NOPE:], cos, sin)], axis=-1)
        return k, kv[..., B_NOPE:]

    q = queries(cq, True)
    k, v = keys_values(ckv, kr, True)
    k_c, v_c = keys_values(ckv_c, kr_c, False)
    B, S = q.shape[0], q.shape[1]
    nq = S // B_QBLOCK
    q_blocks = jnp.moveaxis(q.reshape(B, nq, B_QBLOCK, B_HEADS, B_QK), 1, 0)

    def attend(q_blk):
        s = jnp.concatenate([jnp.einsum('bqhd,bkhd->bhqk', q_blk, k),
                             jnp.einsum('bqhd,bkhd->bhqk', q_blk, k_c)], axis=-1)
        p = jax.nn.softmax(s.astype(jnp.float32) * scale, axis=-1)
        return (jnp.einsum('bhqk,bkhd->bqhd', p[..., :S].astype(v.dtype), v)
                + jnp.einsum('bhqk,bkhd->bqhd', p[..., S:].astype(v.dtype), v_c))

    o = jnp.moveaxis(lax.map(attend, q_blocks), 0, 1).reshape(B, S, B_HEADS * B_V)
    o_ctx = context_attention(queries(cq_c, False), k_c, v_c, scale) if with_ctx_out else None
    return o, o_ctx


def retention_scan(q, k, v, log_gamma, s0, with_output):
    B, T, H, dk = q.shape
    dv = v.shape[-1]
    n = T // C_CHUNK
    kf = k.astype(jnp.float32).reshape(B, n, C_CHUNK, H, dk)
    vf = v.astype(jnp.float32).reshape(B, n, C_CHUNK, H, dv)
    pos = jnp.arange(C_CHUNK, dtype=jnp.float32)
    lg = log_gamma[:, None]
    k_w = jnp.exp(lg * (C_CHUNK - 1.0 - pos))
    kv_chunk = jnp.einsum('bnjhd,hj,bnjhe->bnhde', kf, k_w, vf)
    chunk_decay = jnp.exp(log_gamma * C_CHUNK)[None, :, None, None]

    def step(s, kv):
        return s * chunk_decay + kv, s

    s_final, s_prev = lax.scan(step, s0, jnp.moveaxis(kv_chunk, 1, 0))
    if not with_output:
        return None, s_final
    qf = q.astype(jnp.float32).reshape(B, n, C_CHUNK, H, dk)
    diff = pos[:, None] - pos[None, :]
    decay = jnp.where(diff >= 0, jnp.exp(lg[:, :, None] * jnp.maximum(diff, 0.0)), 0.0)
    scores = jnp.einsum('bnihd,bnjhd->bnhij', qf, kf) * decay
    o_intra = jnp.einsum('bnhij,bnjhe->bnihe', scores, vf)
    q_w = jnp.exp(lg * (pos + 1.0))
    o_cross = jnp.einsum('bnihd,hi,nbhde->bnihe', qf, q_w, s_prev)
    return (o_intra + o_cross).reshape(B, T, H, dv), s_final


def retention_mixer(q, k, v, g, qc, kc, vc, gc, log_decay, cos, sin, with_ctx_out):
    B, S, _ = q.shape
    L = kc.shape[1]
    k_scale = HEAD_DIM ** -0.5

    def heads(t):
        return t.reshape(t.shape[0], t.shape[1], C_HEADS, HEAD_DIM)

    q_l = apply_rope(heads(q), cos, sin)
    k_l = apply_rope(heads(k), cos, sin) * k_scale
    v_l = heads(v)
    q_c, k_c, v_c = heads(qc), heads(kc) * k_scale, heads(vc)
    log_gamma = -jnp.exp(log_decay.astype(jnp.float32))
    s0 = jnp.zeros((B, C_HEADS, HEAD_DIM, HEAD_DIM), jnp.float32)
    o = jnp.zeros((B, S, C_HEADS, HEAD_DIM), jnp.float32)
    o_c = jnp.zeros((B, L, C_HEADS, HEAD_DIM), jnp.float32) if with_ctx_out else None
    for direction in range(2):
        rev = (lambda t: t[:, ::-1]) if direction == 1 else (lambda t: t)
        oc_d, s_ctx = retention_scan(rev(q_c), rev(k_c), rev(v_c), log_gamma[direction], s0, with_ctx_out)
        o_d, _ = retention_scan(rev(q_l), rev(k_l), rev(v_l), log_gamma[direction], s_ctx, True)
        o = o + rev(o_d)
        if with_ctx_out:
            o_c = o_c + rev(oc_d)

    def finish(o_, g_):
        o_n = rms_norm(o_).reshape(o_.shape[0], o_.shape[1], -1)
        return (jax.nn.silu(g_.astype(jnp.float32)) * o_n).astype(g_.dtype)

    return finish(o, g), (finish(o_c, gc) if with_ctx_out else None)


def neighborhood_mixer(q, k, v, qc, kc, vc, q_gain, k_gain, rpb, with_ctx_out):
    B, S, _ = q.shape
    L = kc.shape[1]
    rows = S // GRID_W
    kh = min(NA_ROWS, rows)
    kw = NA_COLS
    scale = HEAD_DIM ** -0.5
    qg = rms_norm(q.reshape(B, rows, GRID_W, D_HEADS, HEAD_DIM), q_gain)
    kg = rms_norm(k.reshape(B, rows, GRID_W, D_HEADS, HEAD_DIM), k_gain)
    vg = v.reshape(B, rows, GRID_W, D_HEADS, HEAD_DIM)
    kc_ = rms_norm(kc.reshape(B, L, D_HEADS, HEAD_DIM), k_gain)
    vc_ = vc.reshape(B, L, D_HEADS, HEAD_DIM)
    r = jnp.arange(rows)
    row_idx = jnp.clip(r - kh // 2, 0, rows - kh)[:, None] + jnp.arange(kh)[None, :]
    k_band = kg[:, row_idx]
    v_band = vg[:, row_idx]
    cidx = jnp.arange(GRID_W)
    col_start = jnp.clip(cidx - kw // 2, 0, GRID_W - kw)
    col_ok = (cidx[None, :] >= col_start[:, None]) & (cidx[None, :] < col_start[:, None] + kw)
    d_row = row_idx - r[:, None] + (NA_ROWS - 1)
    d_col = jnp.clip(cidx[None, :] - cidx[:, None] + (NA_COLS - 1), 0, 2 * NA_COLS - 2)
    bias = rpb[:, d_row[:, None, :, None], d_col[None, :, None, :]]
    s_win = jnp.einsum('brwhd,brkchd->bhrwkc', qg, k_band).astype(jnp.float32) * scale
    s_win = jnp.where(col_ok[:, None, :], s_win + bias.astype(jnp.float32)[None], NEG_INF)
    n_win = kh * GRID_W
    s_win = s_win.reshape(B, D_HEADS, rows, GRID_W, n_win)
    s_ctx = jnp.einsum('brwhd,bkhd->bhrwk', qg, kc_).astype(jnp.float32) * scale
    p = jax.nn.softmax(jnp.concatenate([s_win, s_ctx], axis=-1), axis=-1)
    p_win = p[..., :n_win].reshape(B, D_HEADS, rows, GRID_W, kh, GRID_W).astype(v.dtype)
    o = (jnp.einsum('bhrwkc,brkchd->brwhd', p_win, v_band)
         + jnp.einsum('bhrwk,bkhd->brwhd', p[..., n_win:].astype(v.dtype), vc_))
    o = o.reshape(B, S, D_HEADS * HEAD_DIM)
    o_ctx = None
    if with_ctx_out:
        qcr = rms_norm(qc.reshape(B, L, D_HEADS, HEAD_DIM), q_gain)
        o_ctx = context_attention(qcr, kc_, vc_, scale)
    return o, o_ctx


def parallel_mixers(h, hc, w_in, w_out, a_q_norm, a_k_norm, a_sink, b_q_a_norm, b_kv_a_norm, b_w_uq, b_w_ukv,
                    b_q_norm, b_k_norm, c_log_decay, d_q_norm, d_k_norm, d_rpb, with_ctx_out):
    S = h.shape[1]
    split_at = [int(i) for i in np.cumsum(IN_SIZES)[:-1]]
    aq, ak, av, bq, bkv, bkr, cq, ck, cv, cg, dq, dk, dv = jnp.split(h @ w_in, split_at, axis=-1)
    aq_c, ak_c, av_c, bq_c, bkv_c, bkr_c, cq_c, ck_c, cv_c, cg_c, dq_c, dk_c, dv_c = jnp.split(
        hc @ w_in, split_at, axis=-1)
    cos_h, sin_h = axial_rope_tables(S, HEAD_DIM)
    cos_r, sin_r = axial_rope_tables(S, B_ROPE)
    oa, oa_c = window_gqa_mixer(aq, ak, av, aq_c, ak_c, av_c, a_q_norm, a_k_norm, a_sink, cos_h, sin_h,
                                with_ctx_out)
    ob, ob_c = mla_mixer(bq, bkv, bkr, bq_c, bkv_c, bkr_c, b_q_a_norm, b_kv_a_norm, b_w_uq, b_w_ukv,
                         b_q_norm, b_k_norm, cos_r, sin_r, with_ctx_out)
    oc, oc_c = retention_mixer(cq, ck, cv, cg, cq_c, ck_c, cv_c, cg_c, c_log_decay, cos_h, sin_h, with_ctx_out)
    od, od_c = neighborhood_mixer(dq, dk, dv, dq_c, dk_c, dv_c, d_q_norm, d_k_norm, d_rpb, with_ctx_out)
    y = jnp.concatenate([oa, ob, oc, od], axis=-1) @ w_out
    y_c = (jnp.concatenate([oa_c, ob_c, oc_c, od_c], axis=-1) @ w_out) if with_ctx_out else None
    return y, y_c


def swiglu(h, w_gate_up, w_down):
    gate, up = jnp.split(h @ w_gate_up, 2, axis=-1)
    return (jax.nn.silu(gate) * up) @ w_down


def moe_swiglu(h, router, w_gate_up, w_down):
    logits = (h @ router).astype(jnp.float32)
    top_val, top_idx = lax.top_k(logits, TOP_K)
    gates = jax.nn.softmax(top_val, axis=-1)
    combine = jnp.einsum('btk,btke->bte', gates, jax.nn.one_hot(top_idx, N_EXPERTS, dtype=jnp.float32))
    out = jnp.zeros_like(h)
    for e in range(N_EXPERTS):
        out = out + combine[..., e:e + 1].astype(h.dtype) * swiglu(h, w_gate_up[e], w_down[e])
    return out


def channel_mixer(t, layer, ffn_w_gate_up, ffn_w_down, moe_router, moe_w_gate_up, moe_w_down):
    i = layer // 2
    if layer % 2 == 0:
        return swiglu(t, ffn_w_gate_up[i], ffn_w_down[i])
    return moe_swiglu(t, moe_router[i], moe_w_gate_up[i], moe_w_down[i])


def setup_inputs(seed: int = 0) -> dict:
    key = jax.random.key(seed)
    keys = iter(jax.random.split(key, 40))

    def normal(shape, std):
        return jax.random.normal(next(keys), shape, jnp.float32) * std

    def gain(shape):
        return 1.0 + 0.1 * jax.random.normal(next(keys), shape, jnp.float32)

    heads_idx = jnp.arange(C_HEADS, dtype=jnp.float32)
    base_log_decay = jnp.log(-jnp.log(1.0 - 2.0 ** (-5.0 - heads_idx)))
    return {
        'x': normal((BATCH, SEQ, D_MODEL), 1.0),
        'c': normal((BATCH, D_MODEL), 1.0),
        'ctx': normal((BATCH, CTX_LEN, D_MODEL), 1.0),
        'c_ctx': normal((D_MODEL,), 1.0),
        'w_ada': normal((DEPTH, D_MODEL, 6 * D_MODEL), 0.5 * D_MODEL ** -0.5),
        'b_ada': normal((DEPTH, 6 * D_MODEL), 0.02),
        'norm_mix': gain((DEPTH, D_MODEL)),
        'norm_ffn': gain((DEPTH, D_MODEL)),
        'w_in': normal((DEPTH, D_MODEL, IN_COLS), D_MODEL ** -0.5),
        'w_out': normal((DEPTH, MIX_WIDTH, D_MODEL), MIX_WIDTH ** -0.5),
        'a_q_norm': gain((DEPTH, HEAD_DIM)),
        'a_k_norm': gain((DEPTH, HEAD_DIM)),
        'a_sink': normal((DEPTH, A_HEADS), 0.5),
        'b_q_a_norm': gain((DEPTH, B_Q_RANK)),
        'b_kv_a_norm': gain((DEPTH, B_KV_RANK)),
        'b_w_uq': normal((DEPTH, B_Q_RANK, B_HEADS * B_QK), B_Q_RANK ** -0.5),
        'b_w_ukv': normal((DEPTH, B_KV_RANK, B_HEADS * (B_NOPE + B_V)), B_KV_RANK ** -0.5),
        'b_q_norm': gain((DEPTH, B_QK)),
        'b_k_norm': gain((DEPTH, B_QK)),
        'c_log_decay': base_log_decay[None, None, :] + normal((DEPTH, 2, C_HEADS), 0.1),
        'd_q_norm': gain((DEPTH, HEAD_DIM)),
        'd_k_norm': gain((DEPTH, HEAD_DIM)),
        'd_rpb': normal((DEPTH, D_HEADS, 2 * NA_ROWS - 1, 2 * NA_COLS - 1), 0.1),
        'ffn_w_gate_up': normal((N_DENSE, D_MODEL, 2 * D_FF), D_MODEL ** -0.5),
        'ffn_w_down': normal((N_DENSE, D_FF, D_MODEL), D_FF ** -0.5),
        'moe_router': normal((N_MOE, D_MODEL, N_EXPERTS), D_MODEL ** -0.5),
        'moe_w_gate_up': normal((N_MOE, N_EXPERTS, D_MODEL, 2 * EXPERT_FF), D_MODEL ** -0.5),
        'moe_w_down': normal((N_MOE, N_EXPERTS, EXPERT_FF, D_MODEL), EXPERT_FF ** -0.5),
    }


def reference(x, c, ctx, c_ctx, w_ada, b_ada, norm_mix, norm_ffn, w_in, w_out, a_q_norm, a_k_norm, a_sink,
              b_q_a_norm, b_kv_a_norm, b_w_uq, b_w_ukv, b_q_norm, b_k_norm, c_log_decay, d_q_norm, d_k_norm,
              d_rpb, ffn_w_gate_up, ffn_w_down, moe_router, moe_w_gate_up, moe_w_down):
    xc = ctx
    silu_c = jax.nn.silu(c)
    silu_cc = jax.nn.silu(c_ctx)
    for l in range(DEPTH):
        last = l == DEPTH - 1
        mod = silu_c @ w_ada[l] + b_ada[l]
        mod_c = silu_cc @ w_ada[l] + b_ada[l]
        sh1, sc1, g1, sh2, sc2, g2 = [m[:, None, :] for m in jnp.split(mod, 6, axis=-1)]
        sh1c, sc1c, g1c, sh2c, sc2c, g2c = jnp.split(mod_c, 6, axis=-1)
        h = modulate(rms_norm(x, norm_mix[l]), sh1, sc1)
        hc = modulate(rms_norm(xc, norm_mix[l]), sh1c, sc1c)
        y, y_c = parallel_mixers(h, hc, w_in[l], w_out[l], a_q_norm[l], a_k_norm[l], a_sink[l],
                                 b_q_a_norm[l], b_kv_a_norm[l], b_w_uq[l], b_w_ukv[l], b_q_norm[l], b_k_norm[l],
                                 c_log_decay[l], d_q_norm[l], d_k_norm[l], d_rpb[l], not last)
        x = x + g1 * y
        h2 = modulate(rms_norm(x, norm_ffn[l]), sh2, sc2)
        x = x + g2 * channel_mixer(h2, l, ffn_w_gate_up, ffn_w_down, moe_router, moe_w_gate_up, moe_w_down)
        if not last:
            xc = xc + g1c * y_c
            h2c = modulate(rms_norm(xc, norm_ffn[l]), sh2c, sc2c)
            xc = xc + g2c * channel_mixer(h2c, l, ffn_w_gate_up, ffn_w_down, moe_router, moe_w_gate_up,
                                          moe_w_down)
    return x
```

```cpp
#include <hip/hip_runtime.h>
#include <cstdio>
#include <cstdint>

#define LAS __attribute__((address_space(3)))
#define GAS __attribute__((address_space(1)))
typedef unsigned short bf16_t;
typedef short bf16x8 __attribute__((ext_vector_type(8)));
typedef float f32x2 __attribute__((ext_vector_type(2)));
typedef float f32x4 __attribute__((ext_vector_type(4)));
typedef float f32x16 __attribute__((ext_vector_type(16)));
typedef unsigned u32x2 __attribute__((ext_vector_type(2)));
typedef unsigned u32x4 __attribute__((ext_vector_type(4)));
typedef GAS unsigned gu32;
typedef int i32x4r __attribute__((ext_vector_type(4)));

#ifndef FFN1_FP8
#define FFN1_FP8 1
#endif
#ifndef FFN2_FP8
#define FFN2_FP8 1
#endif
#ifndef MK_ONE_LAUNCH
#define MK_ONE_LAUNCH 1
#endif

constexpr int DM = 2048, NB = 4, SEQ = 4096, CTXL = 256, KEYS = SEQ + CTXL;
constexpr int ML = NB * SEQ, MC = NB * CTXL, MT = ML + MC;
constexpr int INC = 4896, INCP = 5120, DFF = 7168, NEXP = 8, MODW = 6 * DM;
constexpr int MSLOT = 2 * ML + NEXP * 256;
constexpr float EPS = 1e-6f, LOG2E = 1.4426950408889634f;
constexpr int PC_AQ = 0, PC_AK = 512, PC_AV = 640, PC_BQ = 768, PC_BKV = 1152, PC_CQ = 1280, PC_CK = 1792, PC_CV = 2304, PC_CG = 2816,
              PC_DQ = 3328, PC_DK = 3840, PC_DV = 4352, PC_BKR = 4864;

constexpr size_t al256(size_t x) { return (x + 255) & ~(size_t)255; }
constexpr size_t WS_CTL = 0, CTL_BYTES = 1u << 20;
constexpr size_t WS_MOD = WS_CTL + CTL_BYTES;
constexpr size_t WS_ROPE64 = WS_MOD + al256((size_t)2 * 5 * MODW * 4);
constexpr size_t WS_ROPE32 = WS_ROPE64 + al256((size_t)SEQ * 32 * 2 * 4);
constexpr size_t WS_RKV = WS_ROPE32 + al256((size_t)SEQ * 16 * 2 * 4);
constexpr size_t WS_RPB = WS_RKV + al256((size_t)MT * 4);
constexpr size_t WS_ROUTE = WS_RPB + al256((size_t)2 * 8 * 15 * 128 * 4);
constexpr size_t WS_WIN = WS_ROUTE + al256((size_t)ML * 32);
constexpr size_t WS_WOUT = WS_WIN + al256((size_t)2 * INCP * DM * 2);
constexpr size_t WS_WUP = WS_WOUT + al256((size_t)2 * DM * DM * 2);
constexpr size_t WS_WGU = WS_WUP + al256((size_t)2 * 1792 * 512 * 2);
constexpr size_t WS_WD = WS_WGU + al256((size_t)2 * DFF * DM * 2);
constexpr size_t WS_MGU = WS_WD + al256((size_t)DM * DFF * 2);
constexpr size_t WS_MD = WS_MGU + al256((size_t)NEXP * 2 * DFF * DM * 2);
constexpr size_t WS_X1 = WS_MD + al256((size_t)NEXP * DM * DFF * 2);
constexpr size_t WS_H = WS_X1 + al256((size_t)MT * DM * 4);
constexpr size_t WS_P = WS_H + al256((size_t)MT * DM * 2);
constexpr size_t WS_UPRAW = WS_P + al256((size_t)MT * INCP * 2);
constexpr size_t WS_QA = WS_UPRAW + al256((size_t)MT * 1792 * 2);
constexpr size_t WS_KA = WS_QA + al256((size_t)MT * 512 * 2);
constexpr size_t WS_VTA = WS_KA + al256((size_t)NB * 2 * KEYS * 64 * 2);
constexpr size_t WS_QB = WS_VTA + al256((size_t)NB * 2 * KEYS * 64 * 2);
constexpr size_t WS_KB = WS_QB + al256((size_t)MT * 768 * 2);
constexpr size_t WS_VTB = WS_KB + al256((size_t)NB * 8 * KEYS * 96 * 2);
constexpr size_t HB64 = al256((size_t)NB * 8 * KEYS * 64 * 2);
constexpr size_t WS_QC = WS_VTB + HB64;
constexpr size_t WS_KC = WS_QC + al256((size_t)MT * 512 * 2);
constexpr size_t WS_KWF = WS_KC + HB64, WS_KWR = WS_KWF + HB64, WS_VTC = WS_KWR + HB64;
constexpr size_t WS_QD = WS_VTC + HB64;
constexpr size_t WS_KD = WS_QD + al256((size_t)MT * 512 * 2), WS_VTD = WS_KD + HB64;
constexpr size_t WS_KVST = WS_VTD + HB64;
constexpr size_t WS_SPREV = WS_KVST + al256((size_t)64 * 34 * 4096 * 4);
constexpr size_t WS_OCAT = WS_SPREV + al256((size_t)64 * 34 * 4096 * 2);
constexpr size_t WS_ACT = WS_OCAT + al256((size_t)MT * DM * 2);
constexpr size_t WS_HS = WS_ACT + al256((size_t)MSLOT * DFF * 2);
constexpr size_t WS_YS = WS_HS + al256((size_t)MSLOT * DM * 2);
constexpr size_t WS_SPLIT = WS_YS + al256((size_t)MSLOT * DM * 2);
constexpr size_t WS_RQ = WS_SPLIT + (size_t)64 * 65536 * 4;
constexpr size_t WS_END = WS_RQ + al256((size_t)MT * 4);
constexpr int CW_BAR = 4096;
constexpr int CW_Q = 8192;
constexpr int CW_ECNT = 16384;
constexpr int CW_SPLIT = 36864;
constexpr int CW_TAIL = 32768;

constexpr int RING_BYTES = 131072;
constexpr int MISC_OFF = 146432;
constexpr int LDS_BYTES = 147456;

__device__ __forceinline__ unsigned cvt_pk_bf16(float lo, float hi) { unsigned r; asm volatile("v_cvt_pk_bf16_f32 %0, %1, %2" : "=v"(r) : "v"(lo), "v"(hi)); return r; }
__device__ __forceinline__ float bf_lo(unsigned w) { return __uint_as_float(w << 16); }
__device__ __forceinline__ float bf_hi(unsigned w) { return __uint_as_float(w & 0xffff0000u); }
__device__ __forceinline__ float bf2f(bf16_t h) { return __uint_as_float((unsigned)h << 16); }
__device__ __forceinline__ float fexp2(float x) { return __builtin_amdgcn_exp2f(x); }
__device__ __forceinline__ float frcp(float x) { return __builtin_amdgcn_rcpf(x); }
__device__ __forceinline__ float silu_f(float g) { return g * frcp(1.0f + fexp2(-g * LOG2E)); }
__device__ __forceinline__ unsigned pack_fp8x4(float a, float b, float c, float d) {
    a = __builtin_amdgcn_fmed3f(a, -448.f, 448.f); b = __builtin_amdgcn_fmed3f(b, -448.f, 448.f); c = __builtin_amdgcn_fmed3f(c, -448.f, 448.f); d = __builtin_amdgcn_fmed3f(d, -448.f, 448.f);
    int w = 0; w = __builtin_amdgcn_cvt_pk_fp8_f32(a, b, w, false); w = __builtin_amdgcn_cvt_pk_fp8_f32(c, d, w, true); return (unsigned)w; }
#if 1
__device__ __forceinline__ float opaque_zero() { return 0.f; }
#else
__device__ __forceinline__ float opaque_zero() { float z; asm volatile("v_mov_b32 %0, 0" : "=v"(z)); return z; }
#endif
__device__ __forceinline__ float xhalf_max(float m) { const auto rr = __builtin_amdgcn_permlane32_swap(__float_as_uint(m), __float_as_uint(m), false, false); return fmaxf(__uint_as_float(rr[0]), __uint_as_float(rr[1])); }
__device__ __forceinline__ float xhalf_sum(float m) { const auto rr = __builtin_amdgcn_permlane32_swap(__float_as_uint(m), __float_as_uint(m), false, false); return __uint_as_float(rr[0]) + __uint_as_float(rr[1]); }
__device__ __forceinline__ int lnd_s(int x) { asm volatile("" : "+s"(x)); return x; }
__device__ __forceinline__ float shfl_idx(float x, int src) { return __int_as_float(__builtin_amdgcn_ds_bpermute(src << 2, __float_as_int(x))); }
__device__ __forceinline__ int lane_id_asm() { int l; asm volatile("v_mbcnt_lo_u32_b32 %0, -1, 0\n\tv_mbcnt_hi_u32_b32 %0, -1, %0" : "=v"(l)); return l; }
template <int N> __device__ __forceinline__ float dpp_ror(float v) { return __int_as_float(__builtin_amdgcn_update_dpp(0, __float_as_int(v), 0x120 + N, 0xf, 0xf, false)); }
__device__ __forceinline__ float row_sum16(float v) { v += dpp_ror<8>(v); v += dpp_ror<4>(v); v += dpp_ror<2>(v); v += dpp_ror<1>(v); return v; }
__device__ __forceinline__ float wave_sum(float v) {
    v = row_sum16(v);
    const float a = __int_as_float(__builtin_amdgcn_readlane(__float_as_int(v), 0)), b = __int_as_float(__builtin_amdgcn_readlane(__float_as_int(v), 16));
    const float c = __int_as_float(__builtin_amdgcn_readlane(__float_as_int(v), 32)), d = __int_as_float(__builtin_amdgcn_readlane(__float_as_int(v), 48));
    return (a + b) + (c + d);
}
__device__ __forceinline__ void row_bp(int row, int& b, int& p) { if (row < ML) { b = row >> 12; p = row & (SEQ - 1); } else { const int r = row - ML; b = r >> 8; p = SEQ + (r & (CTXL - 1)); } }
__device__ __forceinline__ int bp_row(int b, int p) { return p < SEQ ? b * SEQ + p : ML + b * CTXL + (p - SEQ); }
namespace pg8 {
constexpr int BM = 256, BK = 64, HALF = 128, HTB = HALF * BK * 2  , STAGE_BYTES = 8 * HTB, NXCD = 8, WGM = 8;
__host__ __device__ __forceinline__ int lds_byte(int r, int c) { const int st = (r >> 4) * 2 + (c >> 5), rr = r & 15, cc = c & 31, ob = rr * 64 + cc * 2; return st * 1024 + (ob ^ (((ob >> 9) & 1) << 5)); }
__host__ __device__ __forceinline__ void stage_rc(int b, int& R, int& C) { const int st = b / 1024, sb = b % 1024, swz = sb ^ (((sb >> 9) & 1) << 5); R = (st >> 1) * 16 + swz / 64; C = (st & 1) * 32 + (swz % 64) / 2; }
__host__ __device__ __forceinline__ int perm32(int rho) { const int n = rho >> 4, i = rho & 15; return 8 * (i >> 2) + 4 * n + (i & 3); }

struct Unit { int pm, pn, eb; };
struct Gemm { const void* A; const void* Bt; int lda, K; size_t bstride; int scaleA, scaleB; int ldb; };
typedef int i32x8 __attribute__((ext_vector_type(8)));
typedef int i32x4 __attribute__((ext_vector_type(4)));
__device__ __forceinline__ i32x8 cat8(bf16x8 lo, bf16x8 hi) { return __builtin_shufflevector(__builtin_bit_cast(i32x4, lo), __builtin_bit_cast(i32x4, hi), 0, 1, 2, 3, 4, 5, 6, 7); }

struct TileOrder {
    int nM, nN, nwg, G, c; const LAS int* tile_e;
    __device__ void init(int nM_, int nN_, int G_, int c_, const LAS int* te) { nM = nM_; nN = nN_; nwg = nM * nN; G = G_; c = c_; tile_e = te; }
    __device__ bool idle_last_round() const { const int R = (nwg + G - 1) / G; return c + (R - 1) * G >= nwg; }
    __device__ int first_idle() const { const int R = (nwg + G - 1) / G; return nwg - (R - 1) * G; }
    __device__ bool next(int i, Unit& u) const {
        const long L = (long)i * G + c; if (L >= nwg) return false;
        int wgid = (int)L; { const int q = nwg / NXCD, r = nwg % NXCD, xcd = wgid % NXCD, off = wgid / NXCD; wgid = (xcd < r ? xcd * (q + 1) : r * (q + 1) + (xcd - r) * q) + off; }
        const int nig = WGM * nN, gid = wgid / nig, fm = gid * WGM, gsz = (nM - fm) < WGM ? (nM - fm) : WGM;
        u.pm = fm + ((wgid % nig) % gsz); u.pn = (wgid % nig) / gsz; u.eb = tile_e ? __builtin_amdgcn_readfirstlane(tile_e[u.pm]) : 0; return true;
    }
};

struct EpiBf16 {
    static constexpr bool PERM = true;
    bf16_t* O; int ldc; int wt;
    __device__ __forceinline__ void operator()(const f32x4 (&acc)[2][2][4][2], const Unit& u, int wr, int wc, int fr, int fq) const {
        const int row0 = u.pm * BM + wr * 64 + fr, col0 = u.pn * BM + wc * 32 + 8 * fq;
        if (wt) {
            const __amdgpu_buffer_rsrc_t rs = __builtin_amdgcn_make_buffer_rsrc((void*)O, 0, 0x7ffffff0, 0x00020000);
#pragma unroll
            for (int ai = 0; ai < 2; ++ai)
#pragma unroll
                for (int m = 0; m < 4; ++m) { const int ob = ((row0 + ai * HALF + m * 16) * ldc + col0) * 2;
#pragma unroll
                    for (int bj = 0; bj < 2; ++bj) { const f32x4 v0 = acc[ai][bj][m][0], v1 = acc[ai][bj][m][1];
                        u32x4 w; w.x = cvt_pk_bf16(v0[0], v0[1]); w.y = cvt_pk_bf16(v0[2], v0[3]); w.z = cvt_pk_bf16(v1[0], v1[1]); w.w = cvt_pk_bf16(v1[2], v1[3]);
                        __builtin_amdgcn_raw_buffer_store_b128(w, rs, ob + bj * HALF * 2, 0, 16); } }
            return;
        }
#pragma unroll
        for (int ai = 0; ai < 2; ++ai)
#pragma unroll
            for (int m = 0; m < 4; ++m) { bf16_t* rowp = O + (size_t)(row0 + ai * HALF + m * 16) * ldc + col0;
#pragma unroll
                for (int bj = 0; bj < 2; ++bj) { const f32x4 v0 = acc[ai][bj][m][0], v1 = acc[ai][bj][m][1];
                    u32x4 w; w.x = cvt_pk_bf16(v0[0], v0[1]); w.y = cvt_pk_bf16(v0[2], v0[3]); w.z = cvt_pk_bf16(v1[0], v1[1]); w.w = cvt_pk_bf16(v1[2], v1[3]);
                    *(u32x4*)(rowp + bj * HALF) = w; } }
    }
};
struct EpiSwiGLU {
    static constexpr bool PERM = true;
    bf16_t* O; int ldc;
    __device__ __forceinline__ void operator()(const f32x4 (&acc)[2][2][4][2], const Unit& u, int wr, int wc, int fr, int fq) const {
        const int row0 = u.pm * BM + wr * 64 + fr, col0 = u.pn * HALF + wc * 32 + 8 * fq;
#pragma unroll
        for (int ai = 0; ai < 2; ++ai)
#pragma unroll
            for (int m = 0; m < 4; ++m) { bf16_t* rowp = O + (size_t)(row0 + ai * HALF + m * 16) * ldc + col0;
                float o[8];
#pragma unroll
                for (int n = 0; n < 2; ++n)
#pragma unroll
                    for (int j = 0; j < 4; ++j) o[n * 4 + j] = silu_f(acc[ai][0][m][n][j]) * acc[ai][1][m][n][j];
                u32x4 w; w.x = cvt_pk_bf16(o[0], o[1]); w.y = cvt_pk_bf16(o[2], o[3]); w.z = cvt_pk_bf16(o[4], o[5]); w.w = cvt_pk_bf16(o[6], o[7]);
                *(u32x4*)rowp = w; asm volatile("" ::: "memory"); }
    }
};
struct EpiSwiGLU8 {
    static constexpr bool PERM = true;
    unsigned char* O; int ldc;
    __device__ __forceinline__ void operator()(const f32x4 (&acc)[2][2][4][2], const Unit& u, int wr, int wc, int fr, int fq) const {
        const int row0 = u.pm * BM + wr * 64 + fr, col0 = u.pn * HALF + wc * 32 + 8 * fq;
#pragma unroll
        for (int ai = 0; ai < 2; ++ai)
#pragma unroll
            for (int m = 0; m < 4; ++m) { unsigned char* rowp = O + (size_t)(row0 + ai * HALF + m * 16) * ldc + col0;
                float o[8];
#pragma unroll
                for (int n = 0; n < 2; ++n)
#pragma unroll
                    for (int j = 0; j < 4; ++j) o[n * 4 + j] = silu_f(acc[ai][0][m][n][j]) * acc[ai][1][m][n][j];
                u32x2 w; w.x = pack_fp8x4(o[0], o[1], o[2], o[3]); w.y = pack_fp8x4(o[4], o[5], o[6], o[7]);
                *(u32x2*)rowp = w; asm volatile("" ::: "memory"); }
    }
};
template <bool BF32>
struct EpiResid {
    static constexpr bool PERM = true;
    const void* base_lat; const void* base_ctx; bf16_t* out; const float* gate;
    __device__ __forceinline__ void operator()(const f32x4 (&acc)[2][2][4][2], const Unit& u, int wr, int wc, int fr, int fq) const {
        const bool isctx = u.pm >= ML / BM;
        const char* base = isctx ? (const char*)base_ctx - (size_t)ML * DM * (BF32 ? 4 : 2) : (const char*)base_lat;
        const float* gv = gate + (size_t)(isctx ? 4 : (u.pm >> 4)) * MODW;
        const int col0 = u.pn * BM + wc * 32 + 8 * fq;
        f32x4 g[2][2];
#pragma unroll
        for (int bj = 0; bj < 2; ++bj)
#pragma unroll
            for (int n = 0; n < 2; ++n) g[bj][n] = *(const f32x4*)(gv + col0 + bj * HALF + n * 4);
        f32x4 bsf[BF32 ? 3 : 1][2][2]; u32x4 bsb[BF32 ? 1 : 3][2];
        const size_t off0 = (size_t)(u.pm * BM + wr * 64 + fr) * DM + col0;
#define ER_LOAD(q) do { const size_t off_ = off0 + (size_t)(((q) >> 2) * HALF + ((q) & 3) * 16) * DM; _Pragma("unroll") for (int bj = 0; bj < 2; ++bj) { \
            if constexpr (BF32) { _Pragma("unroll") for (int n = 0; n < 2; ++n) bsf[(q) % 3][bj][n] = *(const f32x4*)((const float*)base + off_ + bj * HALF + n * 4); } \
            else bsb[(q) % 3][bj] = *(const u32x4*)((const bf16_t*)base + off_ + bj * HALF); } } while (0)
        ER_LOAD(0); ER_LOAD(1);
#pragma unroll
        for (int q = 0; q < 8; ++q) {
            if (q + 2 < 8) ER_LOAD(q + 2);
            const int ai = q >> 2, m = q & 3; const size_t off = off0 + (size_t)(ai * HALF + m * 16) * DM;
#pragma unroll
            for (int bj = 0; bj < 2; ++bj) {
                f32x4 b0, b1;
                if constexpr (BF32) { b0 = bsf[q % 3][bj][0]; b1 = bsf[q % 3][bj][1]; }
                else { const u32x4 w = bsb[q % 3][bj]; b0 = (f32x4){bf_lo(w.x), bf_hi(w.x), bf_lo(w.y), bf_hi(w.y)}; b1 = (f32x4){bf_lo(w.z), bf_hi(w.z), bf_lo(w.w), bf_hi(w.w)}; }
                const f32x4 r0 = b0 + g[bj][0] * acc[ai][bj][m][0], r1 = b1 + g[bj][1] * acc[ai][bj][m][1];
                u32x4 o; o.x = cvt_pk_bf16(r0[0], r0[1]); o.y = cvt_pk_bf16(r0[2], r0[3]); o.z = cvt_pk_bf16(r1[0], r1[1]); o.w = cvt_pk_bf16(r1[2], r1[3]);
                *(u32x4*)(out + off + bj * HALF) = o; }
            asm volatile("" ::: "memory");
        }
#undef ER_LOAD
    }
};

struct OneUnit { int pm, pn, eb, valid; __device__ bool next(int i, Unit& u) const { if (i > 0 || !valid) return false; u.pm = pm; u.pn = pn; u.eb = eb; return true; } };
struct EpiPartial {
    static constexpr bool PERM = true;
    float* P; unsigned* flag;
    __device__ __forceinline__ void operator()(const f32x4 (&acc)[2][2][4][2], const Unit& u, int wr, int wc, int fr, int fq) const {
        const int wv = wr * 4 + wc, ln = fq * 16 + fr;
        const __amdgpu_buffer_rsrc_t rs = __builtin_amdgcn_make_buffer_rsrc((void*)P, 0, 65536 * 4, 0x00020000);
#pragma unroll
        for (int ai = 0; ai < 2; ++ai)
#pragma unroll
            for (int bj = 0; bj < 2; ++bj)
#pragma unroll
                for (int m = 0; m < 4; ++m)
#pragma unroll
                    for (int n = 0; n < 2; ++n) { const int gi = ((ai * 2 + bj) * 4 + m) * 2 + n;
                        __builtin_amdgcn_raw_buffer_store_b128(__builtin_bit_cast(u32x4, acc[ai][bj][m][n]), rs, ((wv * 32 + gi) * 64 + ln) * 16, 0, 16); }
        asm volatile("s_waitcnt vmcnt(0)" ::: "memory");
        if (ln == 0) __hip_atomic_fetch_add(flag, 1u, __ATOMIC_RELAXED, __HIP_MEMORY_SCOPE_AGENT);
    }
};
struct EpiBf16Add {
    static constexpr bool PERM = true;
    bf16_t* O; int ldc; const float* P; unsigned* flag;
    __device__ __forceinline__ void operator()(const f32x4 (&acc)[2][2][4][2], const Unit& u, int wr, int wc, int fr, int fq) const {
        const int wv = wr * 4 + wc, ln = fq * 16 + fr;
        while (__builtin_amdgcn_readfirstlane(__hip_atomic_load(flag, __ATOMIC_RELAXED, __HIP_MEMORY_SCOPE_AGENT)) < 8u) __builtin_amdgcn_s_sleep(4);
        __builtin_amdgcn_fence(__ATOMIC_ACQUIRE, "agent");
        const f32x4* pp = (const f32x4*)P + (size_t)(wv * 32) * 64 + ln;
        const int row0 = u.pm * BM + wr * 64 + fr, col0 = u.pn * BM + wc * 32 + 8 * fq;
        const __amdgpu_buffer_rsrc_t rs = __builtin_amdgcn_make_buffer_rsrc((void*)O, 0, 0x7ffffff0, 0x00020000);
        f32x4 q[3][2][2];
#define EA_LOAD(g_) do { _Pragma("unroll") for (int bj = 0; bj < 2; ++bj) _Pragma("unroll") for (int n = 0; n < 2; ++n) \
            q[(g_) % 3][bj][n] = pp[(((((g_) >> 2) * 2 + bj) * 4 + ((g_) & 3)) * 2 + n) * 64]; } while (0)
        EA_LOAD(0); EA_LOAD(1);
#pragma unroll
        for (int g_ = 0; g_ < 8; ++g_) {
            if (g_ + 2 < 8) EA_LOAD(g_ + 2);
            const int ai = g_ >> 2, m = g_ & 3; const int ob = ((row0 + ai * HALF + m * 16) * ldc + col0) * 2;
#pragma unroll
            for (int bj = 0; bj < 2; ++bj) { const f32x4 v0 = acc[ai][bj][m][0] + q[g_ % 3][bj][0], v1 = acc[ai][bj][m][1] + q[g_ % 3][bj][1];
                u32x4 w; w.x = cvt_pk_bf16(v0[0], v0[1]); w.y = cvt_pk_bf16(v0[2], v0[3]); w.z = cvt_pk_bf16(v1[0], v1[1]); w.w = cvt_pk_bf16(v1[2], v1[3]);
                __builtin_amdgcn_raw_buffer_store_b128(w, rs, ob + bj * HALF * 2, 0, 16); }
            asm volatile("" ::: "memory");
        }
#undef EA_LOAD
    }
};

template <int ES  , class Epi, class Sched>
__device__ __forceinline__ void gemm_phase(LAS unsigned char* lds, const Gemm g, const Sched& S, const Epi& E, int wid) {
    const int lane = lane_id_asm(), tid = wid * 64 + lane, wr = wid >> 2, wc = wid & 3, fr = lane & 15, fq = lane >> 4;
    const int K = g.K, nt = K * ES / (BK * 2), lda = g.lda, ldb = g.ldb ? g.ldb : g.K;
    int sclA = g.scaleA, sclB = g.scaleB; asm volatile("" : "+v"(sclA), "+v"(sclB));
    unsigned voffA[2], voffB[2];
#pragma unroll
    for (int i = 0; i < 2; ++i) { int R, C; stage_rc(tid * 16 + i * 8192, R, C); const int Rb = Epi::PERM ? ((R & ~31) + perm32(R & 31)) : R;
        voffA[i] = (unsigned)(R * lda * ES + C * 2); voffB[i] = (unsigned)(Rb * ldb * ES + C * 2); }
    const size_t kstep = (size_t)(BK * 2);
    const size_t hstepA = (size_t)HALF * lda * ES, hstepB = (size_t)HALF * ldb * ES;
    const size_t tstepA = 2 * hstepA, tstepB = 2 * hstepB;
    const unsigned ldsw = (unsigned)wid * 1024u;
    const int aoff = lds_byte(wr * 64 + fr, fq * 8), boff = lds_byte(wc * 32 + fr, fq * 8);
#define PG8_SA(b, h) (((b) * 2 + (h)) * HTB)
#define PG8_SB(b, h) ((4 + (b) * 2 + (h)) * HTB)
#define PG8_STAGE(bufoff, gbase, voff) do { _Pragma("unroll") for (int _i = 0; _i < 2; ++_i) \
        __builtin_amdgcn_global_load_lds((const GAS unsigned*)((const char*)(gbase) + (voff)[_i]), (LAS unsigned*)(lds + (bufoff) + ldsw + _i * 8192), 16, 0, 0); } while (0)
#define PG8_LDA(dst, b, h) do { _Pragma("unroll") for (int m = 0; m < 4; ++m) _Pragma("unroll") for (int k = 0; k < 2; ++k) dst[m][k] = *(const LAS bf16x8*)(lds + PG8_SA(b, h) + aoff + m * 2048 + k * 1024); } while (0)
#define PG8_LDB(dst, b, h) do { _Pragma("unroll") for (int n = 0; n < 2; ++n) _Pragma("unroll") for (int k = 0; k < 2; ++k) dst[n][k] = *(const LAS bf16x8*)(lds + PG8_SB(b, h) + boff + n * 2048 + k * 1024); } while (0)
#define PG8_MMA(ai, bj, At, Bt) do { __builtin_amdgcn_s_setprio(1); _Pragma("unroll") for (int m = 0; m < 4; ++m) _Pragma("unroll") for (int n = 0; n < 2; ++n) { \
        if constexpr (ES == 2) { _Pragma("unroll") for (int k = 0; k < 2; ++k) acc[ai][bj][m][n] = __builtin_amdgcn_mfma_f32_16x16x32_bf16(Bt[n][k], At[m][k], acc[ai][bj][m][n], 0, 0, 0); } \
        else { const i32x8 _a = cat8(Bt[n][0], Bt[n][1]), _b = cat8(At[m][0], At[m][1]); \
               asm volatile("v_mfma_scale_f32_16x16x128_f8f6f4 %0, %1, %2, %0, %3, %4 op_sel_hi:[0,0,0]" : "+v"(acc[ai][bj][m][n]) : "v"(_a), "v"(_b), "v"(sclB), "v"(sclA)); } } \
        __builtin_amdgcn_s_setprio(0); } while (0)
#define PG8_WAIT_V(n) asm volatile("s_waitcnt vmcnt(" #n ")" ::: "memory")
#define PG8_WAIT_L(n) asm volatile("s_waitcnt lgkmcnt(" #n ")" ::: "memory")
#define PG8_BAR __builtin_amdgcn_s_barrier()
#define PG8_SCHED __builtin_amdgcn_sched_barrier(0)
    Unit cur, nxt; int ui = 0;
    if (!S.next(0, cur)) return;
    f32x4 acc[2][2][4][2];
    float zr = opaque_zero();
#pragma unroll
    for (int a = 0; a < 2; ++a)
#pragma unroll
        for (int b = 0; b < 2; ++b)
#pragma unroll
            for (int m = 0; m < 4; ++m)
#pragma unroll
                for (int n = 0; n < 2; ++n) acc[a][b][m][n] = (f32x4){zr, zr, zr, zr};
    bf16x8 At[4][2], B0[2][2], B1[2][2];
    const char* cA = (const char*)g.A + (size_t)cur.pm * tstepA; const char* cB = (const char*)g.Bt + ((size_t)cur.eb * g.bstride) * ES + (size_t)cur.pn * tstepB;
    PG8_STAGE(PG8_SB(0, 0), cB, voffB); PG8_STAGE(PG8_SB(0, 1), cB + hstepB, voffB); PG8_STAGE(PG8_SA(0, 0), cA, voffA); PG8_STAGE(PG8_SA(0, 1), cA + hstepA, voffA);
    if (wr == 1) PG8_BAR;
    PG8_WAIT_V(2); PG8_BAR;
    PG8_STAGE(PG8_SB(1, 0), cB + kstep, voffB); PG8_STAGE(PG8_SA(1, 0), cA + kstep, voffA); PG8_STAGE(PG8_SB(1, 1), cB + hstepB + kstep, voffB);
    PG8_WAIT_V(6); PG8_BAR;
    for (;;) {
        const bool has_next = S.next(ui + 1, nxt);
        const char* nA = has_next ? (const char*)g.A + (size_t)nxt.pm * tstepA : cA;
        const char* nB = has_next ? (const char*)g.Bt + ((size_t)nxt.eb * g.bstride) * ES + (size_t)nxt.pn * tstepB : cB;
#pragma nounroll
        for (int t = 0; t < nt; t += 2) {
            const bool last = (t == nt - 2);
            const char* a1 = cA + (size_t)(t + 1) * kstep;
            const char* a2 = last ? nA : cA + (size_t)(t + 2) * kstep; const char* b2 = last ? nB : cB + (size_t)(t + 2) * kstep;
            const char* a3 = a2 + kstep; const char* b3 = b2 + kstep;
            PG8_LDB(B0, 0, 0); PG8_LDB(B1, 0, 1); PG8_SCHED; PG8_LDA(At, 0, 0); PG8_STAGE(PG8_SA(1, 1), a1 + hstepA, voffA);
            PG8_WAIT_V(8); PG8_WAIT_L(0); PG8_BAR; PG8_MMA(0, 0, At, B0); PG8_MMA(0, 1, At, B1); PG8_BAR; PG8_SCHED;
            PG8_LDA(At, 0, 1); PG8_STAGE(PG8_SB(0, 0), b2, voffB); PG8_STAGE(PG8_SB(0, 1), b2 + hstepB, voffB); PG8_STAGE(PG8_SA(0, 0), a2, voffA);
            PG8_WAIT_V(8); PG8_WAIT_L(0); PG8_BAR; PG8_MMA(1, 0, At, B0); PG8_MMA(1, 1, At, B1); PG8_BAR; PG8_SCHED;
            PG8_LDB(B0, 1, 0); PG8_LDB(B1, 1, 1); PG8_SCHED; PG8_LDA(At, 1, 0); PG8_STAGE(PG8_SA(0, 1), a2 + hstepA, voffA);
            PG8_WAIT_V(8); PG8_WAIT_L(0); PG8_BAR; PG8_MMA(0, 0, At, B0); PG8_MMA(0, 1, At, B1); PG8_BAR; PG8_SCHED;
            PG8_LDA(At, 1, 1); PG8_STAGE(PG8_SB(1, 0), b3, voffB); PG8_STAGE(PG8_SB(1, 1), b3 + hstepB, voffB); PG8_STAGE(PG8_SA(1, 0), a3, voffA);
            PG8_WAIT_V(8); PG8_WAIT_L(0); PG8_BAR; PG8_MMA(1, 0, At, B0); PG8_MMA(1, 1, At, B1); PG8_BAR; PG8_SCHED;
        }
        if (wr == 0) PG8_BAR;
        if constexpr (ES == 1) asm volatile("s_nop 15\n\ts_nop 15" ::: "memory");
        E(acc, cur, wr, wc, fr, fq);
        if (!has_next) break;
        zr = opaque_zero();
#pragma unroll
        for (int a = 0; a < 2; ++a)
#pragma unroll
            for (int b = 0; b < 2; ++b)
#pragma unroll
                for (int m = 0; m < 4; ++m)
#pragma unroll
                    for (int n = 0; n < 2; ++n) acc[a][b][m][n] = (f32x4){zr, zr, zr, zr};
        cur = nxt; cA = nA; cB = nB; ++ui;
        if (wr == 1) PG8_BAR;
    }
    PG8_WAIT_V(0);
    PG8_BAR;
#undef PG8_SA
#undef PG8_SB
#undef PG8_STAGE
#undef PG8_LDA
#undef PG8_LDB
#undef PG8_MMA
#undef PG8_WAIT_V
#undef PG8_WAIT_L
#undef PG8_BAR
#undef PG8_SCHED
}
}
#define XB_TMO      128
#define XB_XCNT(j)  (256  + 64 * (j))
#define XB_XSUB(j)  (1280 + 64 * (j))
#define XB_XGEN(j)  (2304 + 64 * (j))
#define XB_TOP      3328
#define XB_TOPGEN   3392
#define XCD_BAR_WORDS 3456
#define XB_SPIN_CAP (1u << 18)
__device__ __forceinline__ unsigned xb_ld(unsigned* p)              { return __hip_atomic_load(p, __ATOMIC_RELAXED, __HIP_MEMORY_SCOPE_AGENT); }
__device__ __forceinline__ unsigned xb_add(unsigned* p, unsigned v) { return __hip_atomic_fetch_add(p, v, __ATOMIC_RELAXED, __HIP_MEMORY_SCOPE_AGENT); }
__device__ __forceinline__ unsigned xb_xcc_id() { return (unsigned)__builtin_amdgcn_s_getreg((3 << 11) | 20) & 0xFu; }
#define XB_SPIN(cond, bar) do { unsigned _sp = 0; while (cond) { __builtin_amdgcn_s_sleep(1); \
    if ((++_sp & 255u) == 0u) { if (xb_ld(&(bar)[XB_TMO])) break; if (_sp > XB_SPIN_CAP) { atomicAdd(&(bar)[XB_TMO], 1u); break; } } } } while (0)
struct XcdBarrier { unsigned* bar; unsigned x; volatile LAS unsigned* st; };
__device__ __forceinline__ XcdBarrier xcd_barrier_post(unsigned* bar, volatile LAS unsigned* st, bool leader) {
    XcdBarrier b; b.bar = bar; b.x = xb_xcc_id(); b.st = st;
    if (leader) (void)xb_add(&bar[XB_XCNT(b.x)], 1u);
    return b;
}
__device__ __forceinline__ void xcd_barrier_complete(unsigned* bar, unsigned x, unsigned& nloc, unsigned& nx) {
    const unsigned G = gridDim.x * gridDim.y * gridDim.z;
    unsigned sum, cnt, mine, sp = 0u;
    for (;;) {
        sum = 0u; cnt = 0u; mine = 0u;
#pragma unroll
        for (unsigned j = 0; j < 16; ++j) { const unsigned c = xb_ld(&bar[XB_XCNT(j)]); sum += c; cnt += (c > 0u) ? 1u : 0u; mine = (j == x) ? c : mine; }
        if (sum == G) break;
        __builtin_amdgcn_s_sleep(1);
        if ((++sp & 255u) == 0u) { if (xb_ld(&bar[XB_TMO])) break; if (sp > XB_SPIN_CAP) { atomicAdd(&bar[XB_TMO], 1u); break; } }
    }
    nloc = mine > 0u ? mine : 1u; nx = cnt > 0u ? cnt : 1u;
}
__device__ __forceinline__ void xcd_barrier(const XcdBarrier& b, bool leader) {
    asm volatile("s_waitcnt vmcnt(0)" ::: "memory");
    __syncthreads();
    if (leader) {
        unsigned* bar = b.bar; unsigned bx = b.x;
        asm volatile("" : "+s"(bar), "+s"(bx));
        __builtin_amdgcn_s_waitcnt(0);
        unsigned nloc = b.st[0], nx = b.st[1];
        if (nloc == 0u) { xcd_barrier_complete(bar, bx, nloc, nx); b.st[0] = nloc; b.st[1] = nx; }
        const unsigned old = xb_add(&bar[XB_XSUB(bx)], 1u);
        const unsigned gen = old / nloc;
        if (old + 1u == (gen + 1u) * nloc) {
            __builtin_amdgcn_fence(__ATOMIC_RELEASE, "agent");
            asm volatile("s_waitcnt vmcnt(0)" ::: "memory");
            const unsigned og = xb_add(&bar[XB_TOP], 1u);
            const unsigned tg = og / nx;
            if (og + 1u == (tg + 1u) * nx) xb_add(&bar[XB_TOPGEN], 1u);
            else XB_SPIN(xb_ld(&bar[XB_TOPGEN]) == tg, bar);
            __builtin_amdgcn_fence(__ATOMIC_ACQUIRE, "agent");
            xb_add(&bar[XB_XGEN(bx)], 1u);
            asm volatile("s_waitcnt vmcnt(0)" ::: "memory");
        } else {
            XB_SPIN(xb_ld(&bar[XB_XGEN(bx)]) == gen, bar);
            __builtin_amdgcn_fence(__ATOMIC_ACQUIRE, "agent");
            asm volatile("s_waitcnt vmcnt(0)" ::: "memory");
        }
    }
    __syncthreads();
}

struct Params { const float* in[28]; float* out; unsigned char* ws; int ph_lo, ph_hi; };
enum { I_X = 0, I_C, I_CTX, I_CCTX, I_WADA, I_BADA, I_NMIX, I_NFFN, I_WIN, I_WOUT, I_AQN, I_AKN, I_ASINK, I_BQAN, I_BKVAN, I_BWUQ, I_BWUKV, I_BQN, I_BKN,
       I_CLD, I_DQN, I_DKN, I_DRPB, I_FGU, I_FD, I_MR, I_MGU, I_MD };
template <class T> __device__ __forceinline__ T* wsp(const Params& p, size_t off) { return (T*)(p.ws + off); }
typedef const __attribute__((address_space(4))) Params* KArg;
__device__ __forceinline__ Params load_params(KArg k) {
    asm volatile("" : "+s"(k));
    Params p;
#pragma unroll
    for (int i = 0; i < 28; ++i) p.in[i] = k->in[i];
    p.out = k->out; p.ws = k->ws; p.ph_lo = k->ph_lo; p.ph_hi = k->ph_hi; return p;
}

__device__ __forceinline__ int q_next(const Params& p, int q, int lane) {
    unsigned v = 0;
    if (lane == 0) v = __hip_atomic_fetch_add(wsp<unsigned>(p, WS_CTL) + CW_Q + 64 * q, 1u, __ATOMIC_RELAXED, __HIP_MEMORY_SCOPE_AGENT);
    return (int)__builtin_amdgcn_readfirstlane(v);
}

template <class RMap>
__device__ __forceinline__ void transpose_item(const float* W, int K, int N, bf16_t* WT, int ldt, const float* kgain, LAS float* scr, int item, int lane, RMap rmap) {
    const int nblk = N / 32, kb = item / nblk, nb = item % nblk, k0 = 64 * kb, n0 = 32 * nb;
#pragma unroll
    for (int i = 0; i < 32; ++i) { const int kk = 2 * i + (lane >> 5); float v = W[(size_t)(k0 + kk) * N + n0 + (lane & 31)]; if (kgain) v *= kgain[k0 + kk]; scr[kk * 33 + (lane & 31)] = v; }
    asm volatile("s_waitcnt lgkmcnt(0)" ::: "memory");
    const int c = lane & 7; const int drow = rmap(n0);
#pragma unroll
    for (int j = 0; j < 4; ++j) { const int n = (lane >> 3) + 8 * j; const LAS float* s = scr + (8 * c) * 33 + n;
        u32x4 o; o.x = cvt_pk_bf16(s[0 * 33], s[1 * 33]); o.y = cvt_pk_bf16(s[2 * 33], s[3 * 33]); o.z = cvt_pk_bf16(s[4 * 33], s[5 * 33]); o.w = cvt_pk_bf16(s[6 * 33], s[7 * 33]);
        *(u32x4*)(WT + (size_t)(drow + n) * ldt + k0 + 8 * c) = o; }
    asm volatile("s_waitcnt lgkmcnt(0)" ::: "memory");
}
template <class RMap>
__device__ __forceinline__ void transpose_item_fp8(const float* W, int K, int N, unsigned char* WT, LAS float* scr, int item, int lane, RMap rmap) {
    const int nblk = N / 32, kb = item / nblk, nb = item % nblk, k0 = 64 * kb, n0 = 32 * nb;
#pragma unroll 8
    for (int i = 0; i < 32; ++i) { const int kk = 2 * i + (lane >> 5); scr[kk * 33 + (lane & 31)] = W[(size_t)(k0 + kk) * N + n0 + (lane & 31)] * 256.0f; }
    asm volatile("s_waitcnt lgkmcnt(0)" ::: "memory");
    const int c = lane & 7; const int drow = rmap(n0);
#pragma unroll
    for (int j = 0; j < 4; ++j) { const int n = (lane >> 3) + 8 * j; const LAS float* s = scr + (8 * c) * 33 + n;
        u32x2 o; o.x = pack_fp8x4(s[0 * 33], s[1 * 33], s[2 * 33], s[3 * 33]); o.y = pack_fp8x4(s[4 * 33], s[5 * 33], s[6 * 33], s[7 * 33]);
        *(u32x2*)(WT + (size_t)(drow + n) * K + k0 + 8 * c) = o; }
    asm volatile("s_waitcnt lgkmcnt(0)" ::: "memory");
}
template <bool FP8, class RMap>
__device__ __forceinline__ void transpose_item64(const float* W, int K, int N, void* WT, LAS float* scr, int item, int lane, RMap rmap) {
    const int nblk = N / 64, kb = item / nblk, nb = item % nblk, k0 = 64 * kb, n0 = 64 * nb;
    f32x4 v[16];
    const float* src = W + (size_t)(k0 + (lane >> 4)) * N + n0 + 4 * (lane & 15);
#pragma unroll
    for (int i = 0; i < 16; ++i) v[i] = __builtin_nontemporal_load((const f32x4*)(src + (size_t)(4 * i) * N));
#pragma unroll
    for (int i = 0; i < 16; ++i) { LAS float* d = scr + ((lane >> 4) + 4 * i) * 65 + 4 * (lane & 15); d[0] = v[i].x; d[1] = v[i].y; d[2] = v[i].z; d[3] = v[i].w; }
    asm volatile("s_waitcnt lgkmcnt(0)" ::: "memory");
    const int c = lane & 7; const int drow = rmap(n0);
#pragma unroll
    for (int j = 0; j < 8; ++j) { const int n = (lane >> 3) + 8 * j; const LAS float* s = scr + (8 * c) * 65 + n;
        if constexpr (FP8) { u32x2 o; o.x = pack_fp8x4(s[0] * 256.f, s[65] * 256.f, s[130] * 256.f, s[195] * 256.f); o.y = pack_fp8x4(s[260] * 256.f, s[325] * 256.f, s[390] * 256.f, s[455] * 256.f);
            *(u32x2*)((unsigned char*)WT + (size_t)(drow + n) * K + k0 + 8 * c) = o; }
        else { u32x4 o; o.x = cvt_pk_bf16(s[0], s[65]); o.y = cvt_pk_bf16(s[130], s[195]); o.z = cvt_pk_bf16(s[260], s[325]); o.w = cvt_pk_bf16(s[390], s[455]);
            *(u32x4*)((bf16_t*)WT + (size_t)(drow + n) * K + k0 + 8 * c) = o; } }
    asm volatile("s_waitcnt lgkmcnt(0)" ::: "memory");
}
struct RmIdent { __device__ int operator()(int n0) const { return n0; } };
struct RmWin { __device__ int operator()(int n0) const { return n0 < 1280 ? n0 : (n0 < 1312 ? n0 - 1280 + PC_BKR : n0 - 32); } };
struct RmGateUp { __device__ int operator()(int n0) const { const int u = n0 < DFF ? n0 : n0 - DFF; return 256 * (u >> 7) + (n0 < DFF ? 0 : 128) + (u & 127); } };

constexpr int DI_IN = (DM / 64) * (INC / 32), DI_OUT = (DM / 64) * (DM / 32), DI_UQ = (384 / 64) * (768 / 32), DI_UKV = (128 / 64) * (1024 / 32);
constexpr int DI_GU = (DM / 64) * (2 * DFF / 64), DI_DN = (DFF / 64) * (DM / 64);
constexpr int DI_PER_L = DI_IN + DI_OUT + DI_UQ + DI_UKV, DI_ALL = 2 * DI_PER_L + DI_GU + DI_DN;
__device__ __forceinline__ void dense_items(const Params& p, LAS unsigned char* lds, int wave, int lane, int lo, int hi, int wi, int nw) {
    LAS float* scr = (LAS float*)(lds + wave * 16896);
    constexpr int I_IN = DI_IN, I_OUT = DI_OUT, I_UQ = DI_UQ, I_GU = DI_GU, I_DN = DI_DN, PER_L = DI_PER_L;
    for (int it = lo + wi; it < hi; it += nw) {
        int r = it;
        if (r < 2 * PER_L) { const int l = r / PER_L; r -= l * PER_L;
            if (r < I_IN) { transpose_item(p.in[I_WIN] + (size_t)l * DM * INC, DM, INC, wsp<bf16_t>(p, WS_WIN) + (size_t)l * INCP * DM, DM, nullptr, scr, r, lane, RmWin()); continue; } r -= I_IN;
            if (r < I_OUT) { transpose_item(p.in[I_WOUT] + (size_t)l * DM * DM, DM, DM, wsp<bf16_t>(p, WS_WOUT) + (size_t)l * DM * DM, DM, nullptr, scr, r, lane, RmIdent()); continue; } r -= I_OUT;
            if (r < I_UQ) { transpose_item(p.in[I_BWUQ] + (size_t)l * 384 * 768, 384, 768, wsp<bf16_t>(p, WS_WUP) + (size_t)l * 1792 * 512, 512, p.in[I_BQAN] + l * 384, scr, r, lane, RmIdent()); continue; } r -= I_UQ;
            transpose_item(p.in[I_BWUKV] + (size_t)l * 128 * 1024, 128, 1024, wsp<bf16_t>(p, WS_WUP) + (size_t)l * 1792 * 512 + (size_t)768 * 512 + 384, 512, p.in[I_BKVAN] + l * 128, scr, r, lane, RmIdent()); continue; }
        r -= 2 * PER_L;
        if (r < I_GU) { transpose_item64<(FFN1_FP8 != 0)>(p.in[I_FGU], DM, 2 * DFF, wsp<unsigned char>(p, WS_WGU), scr, r, lane, RmGateUp()); continue; } r -= I_GU;
#if FFN2_FP8
        if (r < I_DN) { transpose_item64<true>(p.in[I_FD], DFF, DM, wsp<unsigned char>(p, WS_WD), scr, r, lane, RmIdent()); continue; } r -= I_DN;
#else
        if (r < I_DN) { transpose_item64<false>(p.in[I_FD], DFF, DM, wsp<bf16_t>(p, WS_WD), scr, r, lane, RmIdent()); continue; } r -= I_DN;
#endif
    }
}
__device__ __forceinline__ void p0_prologue(const Params& p, LAS unsigned char* lds, int G, int vcu, int wave) {
    const int lane = lane_id_asm(), tid = wave * 64 + lane;
    {
        LAS float* sv = (LAS float*)lds;
        LAS float* red = (LAS float*)(lds + 5 * DM * 4);
        bool loaded = false;
        for (int u = blockIdx.x; u < 2 * (MODW / 128); u += G) {
            if (!loaded) { for (int i = tid; i < 5 * DM; i += 512) { const int v = i / DM, k = i % DM; const float cv = v < 4 ? p.in[I_C][v * DM + k] : p.in[I_CCTX][k]; sv[i] = cv / (1.0f + __expf(-cv)); } loaded = true; __syncthreads(); }
            const int l = u / (MODW / 128), n0 = (u % (MODW / 128)) * 128;
            int hi = lane >> 5, c4 = lane & 31; asm volatile("" : "+v"(hi), "+v"(c4));
            const float* W = p.in[I_WADA] + (size_t)l * DM * MODW + n0 + 4 * c4 + (size_t)hi * MODW;
            float a[5][4];
#pragma unroll
            for (int v = 0; v < 5; ++v) { a[v][0] = 0.f; a[v][1] = 0.f; a[v][2] = 0.f; a[v][3] = 0.f; }
#pragma unroll 16
            for (int k = wave * 256; k < wave * 256 + 256; k += 2) { const f32x4 w = __builtin_nontemporal_load((const f32x4*)(W + (size_t)k * MODW));
#pragma unroll
                for (int v = 0; v < 5; ++v) { const float s = sv[v * DM + k + hi]; a[v][0] += s * w.x; a[v][1] += s * w.y; a[v][2] += s * w.z; a[v][3] += s * w.w; } }
#pragma unroll
            for (int v = 0; v < 5; ++v) {
#pragma unroll
                for (int j = 0; j < 4; ++j) a[v][j] = xhalf_sum(a[v][j]);
                if (hi == 0) *(LAS f32x4*)(red + (wave * 5 + v) * 128 + 4 * c4) = (f32x4){a[v][0], a[v][1], a[v][2], a[v][3]}; }
            __syncthreads();
            for (int i = tid; i < 5 * 128; i += 512) { const int v = i / 128, n = i % 128; float s = 0.f;
#pragma unroll
                for (int w = 0; w < 8; ++w) s += red[(w * 5 + v) * 128 + n];
                wsp<float>(p, WS_MOD)[((size_t)l * 5 + v) * MODW + n0 + n] = s + p.in[I_BADA][(size_t)l * MODW + n0 + n]; }
            __syncthreads();
        }
        __syncthreads();
    }
    const int gw = vcu * 8 + wave, NGW = G * 8;
    const unsigned zu = __float_as_uint(opaque_zero());
    for (int i = gw * 64 + lane; i < SEQ * 48; i += NGW * 64) {
        const int t = i / 48, j = i % 48; const float rw = (float)(t >> 6), cl = (float)(t & 63);
        if (j < 32) { const float fr = __powf(10000.0f, -(float)(j & 15) / 16.0f); const float ang = (j < 16 ? rw : cl) * fr; const float s = __sinf(ang), c = __cosf(ang);
            wsp<float>(p, WS_ROPE64)[(t * 32 + j) * 2] = c; wsp<float>(p, WS_ROPE64)[(t * 32 + j) * 2 + 1] = s; }
        else { const int jj = j - 32; const float fr = __powf(10000.0f, -(float)(jj & 7) / 8.0f); const float ang = (jj < 8 ? rw : cl) * fr; const float s = __sinf(ang), c = __cosf(ang);
            wsp<float>(p, WS_ROPE32)[(t * 16 + jj) * 2] = c; wsp<float>(p, WS_ROPE32)[(t * 16 + jj) * 2 + 1] = s; }
    }
    for (int i = gw * 64 + lane; i < 2 * 8 * 15 * 128; i += NGW * 64) {
        const int lh = i / (15 * 128), r = i % (15 * 128), dr = r >> 7, dc = (r & 127) - 48;
        wsp<float>(p, WS_RPB)[i] = (dc >= 0 && dc < 31) ? p.in[I_DRPB][(size_t)lh * 15 * 31 + dr * 31 + dc] * LOG2E : 0.f;
    }
    for (int i = gw * 64 + lane; i < 2 * (INCP - INC) * DM / 8; i += NGW * 64) {
        const int l = i / ((INCP - INC) * DM / 8), r = i % ((INCP - INC) * DM / 8);
        *(u32x4*)(wsp<bf16_t>(p, WS_WIN) + ((size_t)l * INCP + INC) * DM + (size_t)r * 8) = (u32x4){zu, zu, zu, zu};
    }
    for (int i = gw * 64 + lane; i < 2 * (768 * 16 + 1024 * 48); i += NGW * 64) {
        const int l = i / (768 * 16 + 1024 * 48), r = i % (768 * 16 + 1024 * 48);
        bf16_t* base = wsp<bf16_t>(p, WS_WUP) + (size_t)l * 1792 * 512;
        bf16_t* d = r < 768 * 16 ? base + (size_t)(r / 16) * 512 + 384 + (r % 16) * 8 : base + (size_t)(768 + (r - 768 * 16) / 48) * 512 + ((r - 768 * 16) % 48) * 8;
        *(u32x4*)d = (u32x4){zu, zu, zu, zu};
    }
    dense_items(p, lds, wave, lane, 0, DI_PER_L, gw, NGW);
}

constexpr int CONV_GU = (DM / 64) * (2 * DFF / 64), CONV_DN = (DFF / 64) * (DM / 64), NCONV = NEXP * (CONV_GU + CONV_DN);
struct ConvItem { const float* src; unsigned char* dst; int N, K; };
__device__ __forceinline__ void moe_item_load(const Params& p, int r, int lane, ConvItem& it, f32x4 (&v)[16]) {
    const int e = r / (CONV_GU + CONV_DN); r -= e * (CONV_GU + CONV_DN);
    const bool gu = r < CONV_GU; const int item = gu ? r : r - CONV_GU;
    const int N = gu ? 2 * DFF : DM, K = gu ? DM : DFF;
    const float* W = gu ? p.in[I_MGU] + (size_t)e * DM * 2 * DFF : p.in[I_MD] + (size_t)e * DFF * DM;
    unsigned char* WT = gu ? wsp<unsigned char>(p, WS_MGU) + (size_t)e * 2 * DFF * DM : wsp<unsigned char>(p, WS_MD) + (size_t)e * DM * DFF;
    const int nblk = N / 64, kb = item / nblk, nb = item % nblk, k0 = 64 * kb, n0 = 64 * nb;
    const int drow = gu ? RmGateUp()(n0) : n0;
    it.src = W + (size_t)(k0 + (lane >> 4)) * N + n0 + 4 * (lane & 15); it.N = N; it.K = K;
    it.dst = WT + (size_t)drow * K + k0 + 8 * (lane & 7);
#pragma unroll
    for (int i = 0; i < 16; ++i) v[i] = __builtin_nontemporal_load((const f32x4*)(it.src + (size_t)(4 * i) * N));
}
__device__ __forceinline__ void moe_item_finish(const ConvItem& it, const f32x4 (&v)[16], LAS float* scr, int lane) {
#pragma unroll
    for (int i = 0; i < 16; ++i) { LAS float* d = scr + ((lane >> 4) + 4 * i) * 65 + 4 * (lane & 15); d[0] = v[i].x; d[1] = v[i].y; d[2] = v[i].z; d[3] = v[i].w; }
    asm volatile("s_waitcnt lgkmcnt(0)" ::: "memory");
    const int c = lane & 7;
#pragma unroll
    for (int j = 0; j < 8; ++j) { const int n = (lane >> 3) + 8 * j; const LAS float* s = scr + (8 * c) * 65 + n;
        u32x2 o; o.x = pack_fp8x4(s[0] * 256.f, s[65] * 256.f, s[130] * 256.f, s[195] * 256.f); o.y = pack_fp8x4(s[260] * 256.f, s[325] * 256.f, s[390] * 256.f, s[455] * 256.f);
        *(u32x2*)(it.dst + (size_t)n * it.K) = o; }
    asm volatile("s_waitcnt lgkmcnt(0)" ::: "memory");
}
__device__ __forceinline__ void moe_convert_pipe(const Params& p, LAS unsigned char* lds, int wave, int lane, int lo, int hi, int wi, int nw) {
    LAS float* scr = (LAS float*)(lds + wave * 16896);
    int r = lo + wi;
    if (r >= hi) return;
    ConvItem ia, ib; f32x4 va[16], vb[16];
    moe_item_load(p, r, lane, ia, va);
    for (;;) {
        const int rb = r + nw;
        if (rb < hi) moe_item_load(p, rb, lane, ib, vb);
        moe_item_finish(ia, va, scr, lane);
        if (rb >= hi) break;
        const int ra = rb + nw;
        if (ra < hi) moe_item_load(p, ra, lane, ia, va);
        moe_item_finish(ib, vb, scr, lane);
        if (ra >= hi) break;
        r = ra;
    }
}

__device__ __forceinline__ void moe_convert_item(const Params& p, LAS float* scr, int r, int lane) {
    const int e = r / (CONV_GU + CONV_DN); r -= e * (CONV_GU + CONV_DN);
    if (r < CONV_GU) transpose_item64<true>(p.in[I_MGU] + (size_t)e * DM * 2 * DFF, DM, 2 * DFF, wsp<unsigned char>(p, WS_MGU) + (size_t)e * 2 * DFF * DM, scr, r, lane, RmGateUp());
    else transpose_item64<true>(p.in[I_MD] + (size_t)e * DFF * DM, DFF, DM, wsp<unsigned char>(p, WS_MD) + (size_t)e * DM * DFF, scr, r - CONV_GU, lane, RmIdent());
}
__device__ __forceinline__ void moe_convert(const Params& p, LAS unsigned char* lds, int wave, int lane, int lo, int hi, int wi, int nw) {
    LAS float* scr = (LAS float*)(lds + wave * 16896);
    for (int r = lo + wi; r < hi; r += nw) moe_convert_item(p, scr, r, lane);
}

__device__ __forceinline__ f32x4 ldx4(const void* row, int c, bool xb) {
    if (xb) { const u32x2 w = *((const u32x2*)row + c); return (f32x4){bf_lo(w.x), bf_hi(w.x), bf_lo(w.y), bf_hi(w.y)}; }
    return *((const f32x4*)row + c);
}
template <bool FP8 = false, bool XB = false>
__device__ __forceinline__ void norm_mod_row(const void* xrow, const float* gain, const float* sh, const float* sc, bf16_t* orow, int lane, f32x4 (&v)[8]) {
    float ss = 0.f;
    f32x4 gq[8], aq[8], sq[8];
#pragma unroll
    for (int j = 0; j < 8; ++j) { const int c = lane + 64 * j; v[j] = ldx4(xrow, c, XB); gq[j] = *((const f32x4*)gain + c); aq[j] = *((const f32x4*)sc + c); sq[j] = *((const f32x4*)sh + c); }
#pragma unroll
    for (int j = 0; j < 8; ++j) ss += (v[j].x * v[j].x + v[j].y * v[j].y) + (v[j].z * v[j].z + v[j].w * v[j].w);
    const float rstd = 1.0f / sqrtf(wave_sum(ss) * (1.0f / DM) + EPS);
#pragma unroll
    for (int j = 0; j < 8; ++j) { const int c = lane + 64 * j; const f32x4 g = gq[j], a = aq[j], s = sq[j];
        v[j] = (v[j] * rstd * g) * (a + 1.0f) + s;
        if constexpr (FP8) { *((unsigned*)orow + c) = pack_fp8x4(v[j].x, v[j].y, v[j].z, v[j].w); }
        else { u32x2 w; w.x = cvt_pk_bf16(v[j].x, v[j].y); w.y = cvt_pk_bf16(v[j].z, v[j].w); *((u32x2*)orow + c) = w; } }
}
template <bool FP8 = false, bool XB = false>
__device__ __forceinline__ void norm_mod_row2(const void* xa, const float* gain, const float* sh, const float* sc, bf16_t* oa, int opitch_elems, int lane) {
    f32x4 va[8], vb[8], g[8], a[8], s[8];
#pragma unroll
    for (int j = 0; j < 8; ++j) { const int c = lane + 64 * j; va[j] = ldx4(xa, c, XB); vb[j] = ldx4((const char*)xa + (size_t)DM * (XB ? 2 : 4), c, XB);
        g[j] = *((const f32x4*)gain + c); a[j] = *((const f32x4*)sc + c); s[j] = *((const f32x4*)sh + c); }
    float sa = 0.f, sb = 0.f;
#pragma unroll
    for (int j = 0; j < 8; ++j) { sa += (va[j].x * va[j].x + va[j].y * va[j].y) + (va[j].z * va[j].z + va[j].w * va[j].w); sb += (vb[j].x * vb[j].x + vb[j].y * vb[j].y) + (vb[j].z * vb[j].z + vb[j].w * vb[j].w); }
    const float ra = 1.0f / sqrtf(wave_sum(sa) * (1.0f / DM) + EPS), rb = 1.0f / sqrtf(wave_sum(sb) * (1.0f / DM) + EPS);
    bf16_t* ob = oa + opitch_elems;
#pragma unroll
    for (int j = 0; j < 8; ++j) { const int c = lane + 64 * j; const f32x4 m1 = g[j] * (a[j] + 1.0f);
        const f32x4 ya = (va[j] * ra) * m1 + s[j], yb = (vb[j] * rb) * m1 + s[j];
        if constexpr (FP8) { *((unsigned*)oa + c) = pack_fp8x4(ya.x, ya.y, ya.z, ya.w); *((unsigned*)ob + c) = pack_fp8x4(yb.x, yb.y, yb.z, yb.w); }
        else { u32x2 w; w.x = cvt_pk_bf16(ya.x, ya.y); w.y = cvt_pk_bf16(ya.z, ya.w); *((u32x2*)oa + c) = w; w.x = cvt_pk_bf16(yb.x, yb.y); w.y = cvt_pk_bf16(yb.z, yb.w); *((u32x2*)ob + c) = w; } }
}
struct HeadKind { int src, nh; const float* gain; int rope; float scale; bf16_t* dst; int keymajor; };
__device__ __forceinline__ void prep_heads_load(const Params& p, const HeadKind& k, int row, int lane, u32x2 (&w)[2]) {
    const int g = lane >> 4, l16 = lane & 15;
    const bf16_t* prow = wsp<bf16_t>(p, WS_P) + (size_t)row * INCP + k.src + 4 * l16;
#pragma unroll
    for (int it = 0; it < 2; ++it) { const int h = min(4 * it + g, k.nh - 1); w[it] = *(const u32x2*)(prow + h * 64); }
}
__device__ __forceinline__ void prep_heads_compute(const Params& p, const HeadKind& k, int row, int lane, const u32x2 (&w)[2], const f32x4 (&rope)[2], const f32x4 gn) {
    const int g = lane >> 4, l16 = lane & 15;
    int b, pos; row_bp(row, b, pos);
    const bool dorope = k.rope && row < ML;
#pragma unroll
    for (int it = 0; it < 2; ++it) {
        const int h = 4 * it + g;
        if (4 * it < k.nh) {
            float x[4] = {bf_lo(w[it].x), bf_hi(w[it].x), bf_lo(w[it].y), bf_hi(w[it].y)};
            if (k.gain) {
                float ss = (x[0] * x[0] + x[1] * x[1]) + (x[2] * x[2] + x[3] * x[3]);
                ss = row_sum16(ss);
                const float r = 1.0f / sqrtf(ss * (1.0f / 64.0f) + EPS);
                x[0] *= r * gn.x; x[1] *= r * gn.y; x[2] *= r * gn.z; x[3] *= r * gn.w;
            }
            if (k.rope) {
                float y[4];
#pragma unroll
                for (int e = 0; e < 4; ++e) y[e] = dpp_ror<8>(x[e]);
                if (dorope) {
                    const float cs[8] = {rope[0].x, rope[0].y, rope[0].z, rope[0].w, rope[1].x, rope[1].y, rope[1].z, rope[1].w};
#pragma unroll
                    for (int e = 0; e < 4; ++e) { const float c = cs[2 * e], s = cs[2 * e + 1];
                        x[e] = l16 < 8 ? x[e] * c - y[e] * s : y[e] * s + x[e] * c; }
                }
            }
            if (h < k.nh) {
                u32x2 o; o.x = cvt_pk_bf16(x[0] * k.scale, x[1] * k.scale); o.y = cvt_pk_bf16(x[2] * k.scale, x[3] * k.scale);
                bf16_t* d = k.keymajor == 1 ? k.dst + (((size_t)(b * k.nh + h)) * (KEYS / 32) + (pos >> 5)) * 2048 + (l16 >> 1) * 256 + (pos & 31) * 8 + 4 * (l16 & 1)
                          : k.keymajor == 2 ? k.dst + (((size_t)(b * k.nh + h)) * (KEYS / 64) + (pos >> 6)) * 4096 + (l16 >> 1) * 512 + (pos & 63) * 8 + 4 * (l16 & 1)
                                            : k.dst + (size_t)row * (k.nh * 64) + h * 64 + 4 * l16;
                *(u32x2*)d = o;
            }
        }
    }
}

struct TrKind { const bf16_t* src; int spitch, scol, nh; const float* rowscale; int rope; float scale; int decay; bf16_t* dst; bf16_t* dst2; float lgf2, lgr2; int tiled; };
__device__ __forceinline__ void tr_store_tiled32(LAS bf16_t* scr, bf16_t* img, int lane) {
    unsigned w[32];
#pragma unroll
    for (int t = 0; t < 32; ++t) w[t] = (unsigned)scr[(2 * t) * 72 + lane] | ((unsigned)scr[(2 * t + 1) * 72 + lane] << 16);
#pragma unroll
    for (int q = 0; q < 8; ++q) *(u32x4*)(img + (q >> 2) * 2048 + ((q & 3) * 64 + lane) * 8) = (u32x4){w[4 * q], w[4 * q + 1], w[4 * q + 2], w[4 * q + 3]};
}
__device__ __forceinline__ void tr_store_tiled(LAS bf16_t* scr, bf16_t* img, int lane) {
    unsigned w[32];
#pragma unroll
    for (int t = 0; t < 32; ++t) w[t] = (unsigned)scr[(2 * t) * 72 + lane] | ((unsigned)scr[(2 * t + 1) * 72 + lane] << 16);
#pragma unroll
    for (int q = 0; q < 8; ++q) *(u32x4*)(img + (q * 64 + lane) * 8) = (u32x4){w[4 * q], w[4 * q + 1], w[4 * q + 2], w[4 * q + 3]};
}
__device__ __forceinline__ void tr_store(LAS bf16_t* scr, bf16_t* dst, int lane) {
    unsigned w[32];
#pragma unroll
    for (int t = 0; t < 32; ++t) w[t] = (unsigned)scr[(2 * t) * 72 + lane] | ((unsigned)scr[(2 * t + 1) * 72 + lane] << 16);
#pragma unroll
    for (int q = 0; q < 8; ++q) *(u32x4*)(dst + (size_t)lane * KEYS + 8 * q) = (u32x4){w[4 * q], w[4 * q + 1], w[4 * q + 2], w[4 * q + 3]};
}
__device__ __forceinline__ void prep_transpose_unit(const Params& p, const TrKind& k, int b, int h, int tt, LAS bf16_t* scr, int lane) {
    const int p0 = 64 * tt, c8 = lane & 7;
    const bool latent = p0 < SEQ;
    float x[8][8];
#pragma unroll
    for (int i = 0; i < 8; ++i) {
        const int tok = (lane >> 3) + 8 * i, row = bp_row(b, p0 + tok);
        const u32x4 w = *(const u32x4*)(k.src + (size_t)row * k.spitch + k.scol + h * (k.nh > 0 ? 64 : 128) + 8 * c8);
        const float rs = (k.rowscale ? k.rowscale[row] : 1.0f) * k.scale;
        x[i][0] = bf_lo(w.x) * rs; x[i][1] = bf_hi(w.x) * rs; x[i][2] = bf_lo(w.y) * rs; x[i][3] = bf_hi(w.y) * rs;
        x[i][4] = bf_lo(w.z) * rs; x[i][5] = bf_hi(w.z) * rs; x[i][6] = bf_lo(w.w) * rs; x[i][7] = bf_hi(w.w) * rs;
        if (k.rope) {
            float y[8];
#pragma unroll
            for (int e = 0; e < 8; ++e) y[e] = shfl_idx(x[i][e], lane ^ 4);
            if (latent) {
                const float* cs = wsp<float>(p, WS_ROPE64) + ((size_t)(p0 + tok) * 32 + 8 * (c8 & 3)) * 2;
#pragma unroll
                for (int e = 0; e < 8; ++e) { const float c = cs[2 * e], s = cs[2 * e + 1]; x[i][e] = c8 < 4 ? x[i][e] * c - y[e] * s : y[e] * s + x[i][e] * c; }
            }
        }
    }
    const int nh = k.nh > 0 ? k.nh : -k.nh;
    for (int pass = 0; pass < (k.decay ? 2 : 1); ++pass) {
#pragma unroll
        for (int i = 0; i < 8; ++i) {
            const int tok = (lane >> 3) + 8 * i; float wgt = 1.0f;
            if (k.decay) { const int pc = (p0 + tok) & 127; wgt = pass == 0 ? fexp2(k.lgf2 * (float)(127 - pc)) : fexp2(k.lgr2 * (float)pc); }
            u32x4 o; o.x = cvt_pk_bf16(x[i][0] * wgt, x[i][1] * wgt); o.y = cvt_pk_bf16(x[i][2] * wgt, x[i][3] * wgt); o.z = cvt_pk_bf16(x[i][4] * wgt, x[i][5] * wgt); o.w = cvt_pk_bf16(x[i][6] * wgt, x[i][7] * wgt);
            *(LAS u32x4*)(scr + tok * 72 + 8 * c8) = o;
        }
        asm volatile("s_waitcnt lgkmcnt(0)" ::: "memory");
        if (k.tiled == 1) tr_store_tiled(scr, k.dst + ((size_t)(b * nh + h) * (KEYS / 64) + tt) * 4096, lane);
        else tr_store_tiled32(scr, (pass == 0 ? k.dst : k.dst2) + ((size_t)(b * nh + h) * (KEYS / 32) + 2 * tt) * 2048, lane);
        asm volatile("s_waitcnt lgkmcnt(0)" ::: "memory");
    }
}

struct MlaRegs { unsigned cq[3], ckv; u32x2 wk[4]; f32x4 rope[2]; };
__device__ __forceinline__ void prep_mla_load(const Params& p, int row, int lane, MlaRegs& R) {
    const bf16_t* prow = wsp<bf16_t>(p, WS_P) + (size_t)row * INCP;
    const int g = lane >> 5, l32 = lane & 31; const bool act = l32 < 24; const int d0 = 4 * l32;
#pragma unroll
    for (int j = 0; j < 3; ++j) R.cq[j] = *(const unsigned*)(prow + PC_BQ + 2 * (lane + 64 * j));
    R.ckv = *(const unsigned*)(prow + PC_BKV + 2 * lane);
    const int dd = act ? d0 : 0;
#pragma unroll
    for (int i = 0; i < 4; ++i) { const int h = 2 * i + g;
        R.wk[i] = l32 < 16 || !act ? *(const u32x2*)(wsp<bf16_t>(p, WS_UPRAW) + (size_t)row * 1792 + 768 + h * 128 + dd) : *(const u32x2*)(prow + PC_BKR + (d0 - 64)); }
    { const int pos = row < ML ? (row & (SEQ - 1)) : 0;
      const float* cs = wsp<float>(p, WS_ROPE32) + ((size_t)pos * 16 + (d0 >= 64 && act ? (d0 - 64) & 15 : 0)) * 2; R.rope[0] = *(const f32x4*)cs; R.rope[1] = *(const f32x4*)(cs + 4); }
}
__device__ __forceinline__ void prep_mla_compute(const Params& p, int l, int row, int lane, const MlaRegs& R, const f32x4 gq, const f32x4 gk) {
    int b, pos; row_bp(row, b, pos);
    float sq = 0.f, skv = 0.f;
    {
#pragma unroll
      for (int j = 0; j < 3; ++j) { const float a = bf_lo(R.cq[j]), c = bf_hi(R.cq[j]); sq += a * a + c * c; }
      const float a = bf_lo(R.ckv), c = bf_hi(R.ckv); skv = a * a + c * c; }
    sq = wave_sum(sq); skv = wave_sum(skv);
    const float rq = 1.0f / sqrtf(sq * (1.0f / 384.0f) + EPS), rkv = 1.0f / sqrtf(skv * (1.0f / 128.0f) + EPS);
    if (lane == 0) { wsp<float>(p, WS_RKV)[row] = rkv; wsp<float>(p, WS_RQ)[row] = rq; }
    const int g = lane >> 5, l32 = lane & 31; const bool act = l32 < 24; const int d0 = 4 * l32;
    const bool latent = row < ML;
    const float qscale = 0.10206207261596575f * LOG2E;
    const float cs[8] = {R.rope[0].x, R.rope[0].y, R.rope[0].z, R.rope[0].w, R.rope[1].x, R.rope[1].y, R.rope[1].z, R.rope[1].w};
    const int plane = (lane & 32) | (l32 < 20 ? l32 + 4 : l32 - 4);
#pragma unroll
    for (int i4 = 0; i4 < 4; ++i4) {
        const int h = 2 * i4 + g;
        { float x[4] = {0.f, 0.f, 0.f, 0.f};
          if (act) { const u32x2 w = R.wk[i4]; const float sc = l32 < 16 ? rkv : 1.0f; x[0] = bf_lo(w.x) * sc; x[1] = bf_hi(w.x) * sc; x[2] = bf_lo(w.y) * sc; x[3] = bf_hi(w.y) * sc; }
          float ss = (x[0] * x[0] + x[1] * x[1]) + (x[2] * x[2] + x[3] * x[3]);
          ss = row_sum16(ss); ss += shfl_idx(ss, lane ^ 16);
          const float r = 1.0f / sqrtf(ss * (1.0f / 96.0f) + EPS);
          if (act) { const f32x4 gn = gk; x[0] *= r * gn.x; x[1] *= r * gn.y; x[2] *= r * gn.z; x[3] *= r * gn.w; }
          float y[4];
#pragma unroll
          for (int e = 0; e < 4; ++e) y[e] = shfl_idx(x[e], plane);
          if (latent && l32 >= 16 && act) {
#pragma unroll
              for (int e = 0; e < 4; ++e) { const float c = cs[2 * e], s = cs[2 * e + 1]; x[e] = l32 < 20 ? x[e] * c - y[e] * s : y[e] * s + x[e] * c; } }
          if (act) { u32x2 o; o.x = cvt_pk_bf16(x[0], x[1]); o.y = cvt_pk_bf16(x[2], x[3]);
              *(u32x2*)(wsp<bf16_t>(p, WS_KB) + ((((size_t)(b * 8 + h)) * (KEYS / 64) + (pos >> 6)) * 12 + (d0 >> 3)) * 512 + (pos & 63) * 8 + (d0 & 7)) = o; } }
    }
}
__device__ __forceinline__ int permkey(int m) { const int a = m >> 3, h = (m >> 2) & 1, c = m & 3; return 16 * (a >> 1) + 8 * h + c + 4 * (a & 1); }
__device__ __forceinline__ bf16x8 pack8(const f32x16& s, int o) {
    u32x4 w; w.x = cvt_pk_bf16(s[o], s[o + 1]); w.y = cvt_pk_bf16(s[o + 2], s[o + 3]); w.z = cvt_pk_bf16(s[o + 4], s[o + 5]); w.w = cvt_pk_bf16(s[o + 6], s[o + 7]);
    return __builtin_bit_cast(bf16x8, w);
}
template <bool GAIN, bool ROPE>
__device__ __forceinline__ void load_q_prepped(const bf16_t* qrow, const float* gain, const float* rope, float scale, int hi, bf16x8 (&qf)[4]) {
    u32x4 raw[4]; f32x4 gn[4][2], cs[2][4];
#pragma unroll
    for (int d0 = 0; d0 < 4; ++d0) raw[d0] = *(const u32x4*)(qrow + 16 * d0 + 8 * hi);
    if constexpr (GAIN) {
#pragma unroll
        for (int d0 = 0; d0 < 4; ++d0) { gn[d0][0] = *(const f32x4*)(gain + 16 * d0 + 8 * hi); gn[d0][1] = *(const f32x4*)(gain + 16 * d0 + 8 * hi + 4); } }
    if constexpr (ROPE) {
#pragma unroll
        for (int dd = 0; dd < 2; ++dd)
#pragma unroll
            for (int j = 0; j < 4; ++j) cs[dd][j] = *(const f32x4*)(rope + (16 * dd + 8 * hi) * 2 + 4 * j); }
    float x[4][8];
#pragma unroll
    for (int d0 = 0; d0 < 4; ++d0) { x[d0][0] = bf_lo(raw[d0].x); x[d0][1] = bf_hi(raw[d0].x); x[d0][2] = bf_lo(raw[d0].y); x[d0][3] = bf_hi(raw[d0].y);
        x[d0][4] = bf_lo(raw[d0].z); x[d0][5] = bf_hi(raw[d0].z); x[d0][6] = bf_lo(raw[d0].w); x[d0][7] = bf_hi(raw[d0].w); }
    if constexpr (GAIN) {
        float ss = 0.f;
#pragma unroll
        for (int d0 = 0; d0 < 4; ++d0)
#pragma unroll
            for (int e = 0; e < 8; e += 2) ss += x[d0][e] * x[d0][e] + x[d0][e + 1] * x[d0][e + 1];
        ss = xhalf_sum(ss);
        const float r = 1.0f / sqrtf(ss * (1.0f / 64.0f) + EPS);
#pragma unroll
        for (int d0 = 0; d0 < 4; ++d0)
#pragma unroll
            for (int e = 0; e < 8; ++e) x[d0][e] *= r * gn[d0][e >> 2][e & 3];
    }
    if constexpr (ROPE) {
#pragma unroll
        for (int dd = 0; dd < 2; ++dd)
#pragma unroll
            for (int e = 0; e < 8; ++e) { const float c = cs[dd][e >> 1][2 * (e & 1)], s = cs[dd][e >> 1][2 * (e & 1) + 1]; const float lo = x[dd][e], up = x[dd + 2][e];
                x[dd][e] = lo * c - up * s; x[dd + 2][e] = lo * s + up * c; }
    }
#pragma unroll
    for (int d0 = 0; d0 < 4; ++d0) { u32x4 w; w.x = cvt_pk_bf16(x[d0][0] * scale, x[d0][1] * scale); w.y = cvt_pk_bf16(x[d0][2] * scale, x[d0][3] * scale);
        w.z = cvt_pk_bf16(x[d0][4] * scale, x[d0][5] * scale); w.w = cvt_pk_bf16(x[d0][6] * scale, x[d0][7] * scale); qf[d0] = __builtin_bit_cast(bf16x8, w); }
}
struct AttnArgs {
    const bf16_t* Q; int qpitch;
    const float* qgain; const float* qrope; float qscale;
    const bf16_t* K;
    const bf16_t* Vt;
    bf16_t* O; int opitch;
    int t0, t1, c0, c1;
    float sink2;
    int q0, qrow;
    const float* rpb;
};
template <int DQK, int MODE>
__device__ __forceinline__ void attn_wave(const AttnArgs& a, int lane) {
    constexpr int ND = DQK / 16;
    const int r32 = lane & 31, hi = lane >> 5;
    const float NEG = -__builtin_inff();
    bf16x8 qf[ND];
    load_q_prepped<true, MODE == 1>(a.Q + (size_t)r32 * a.qpitch, a.qgain, a.qrope + r32 * 64, a.qscale, hi, qf);
    static_assert(DQK == 64, "tiled 32-key images: K [8 chunks][32 rows][8], V^T [4 kc][64 d][8]");
    const bf16_t* kp = a.K + hi * 256 + permkey(r32) * 8;
    const bf16_t* vp = a.Vt + (hi * 64 + r32) * 8;
    f32x16 o0, o1; const float zr = opaque_zero();
#pragma unroll
    for (int r = 0; r < 16; ++r) { o0[r] = zr; o1[r] = zr; }
    float m_run = 0.f, l_run = 0.f;
    const int n1 = a.t1 - a.t0, n = n1 + (a.c1 - a.c0);
#define AW_TILE(ii) ((ii) < n1 ? a.t0 + (ii) : a.c0 + ((ii) - n1))
    bf16x8 kf[ND], vf[2][2], k1[ND], v1[2][2];
    { const int tA = AW_TILE(0), tB = AW_TILE(n > 1 ? 1 : 0);
#pragma unroll
      for (int d0 = 0; d0 < ND; ++d0) { kf[d0] = *(const bf16x8*)(kp + (size_t)tA * 2048 + d0 * 512); k1[d0] = *(const bf16x8*)(kp + (size_t)tB * 2048 + d0 * 512); }
#pragma unroll
      for (int d0 = 0; d0 < 2; ++d0)
#pragma unroll
          for (int s = 0; s < 2; ++s) { vf[d0][s] = *(const bf16x8*)(vp + (size_t)tA * 2048 + s * 1024 + d0 * 256); v1[d0][s] = *(const bf16x8*)(vp + (size_t)tB * 2048 + s * 1024 + d0 * 256); } }
    for (int i = 0; i < n; ++i) {
        const int cur = AW_TILE(i); const bool masked = i < n1;
        bf16x8 kn[ND], vn[2][2];
        { const int t2 = AW_TILE(i + 2 < n ? i + 2 : n - 1);
#pragma unroll
          for (int d0 = 0; d0 < ND; ++d0) kn[d0] = *(const bf16x8*)(kp + (size_t)t2 * 2048 + d0 * 512);
#pragma unroll
          for (int d0 = 0; d0 < 2; ++d0)
#pragma unroll
              for (int s = 0; s < 2; ++s) vn[d0][s] = *(const bf16x8*)(vp + (size_t)t2 * 2048 + s * 1024 + d0 * 256); }
        float bias[16];
        if (MODE == 2 && masked) {
            const int kr = cur >> 1, w = a.q0 + r32, cb = (cur & 1) * 32 + 8 * hi;
            const float* rp = a.rpb + (kr - a.qrow + 7) * 128 + (cb - w + 15 + 48);
#pragma unroll
            for (int r = 0; r < 16; ++r) bias[r] = rp[16 * (r >> 3) + (r & 7)];
        }
        f32x16 st;
#pragma unroll
        for (int r = 0; r < 16; ++r) st[r] = -m_run;
#pragma unroll
        for (int d0 = 0; d0 < ND; ++d0) st = __builtin_amdgcn_mfma_f32_32x32x16_bf16(kf[d0], qf[d0], st, 0, 0, 0);
        if (MODE == 1 && masked) {
            const int dt = cur * 32 - a.q0;
            if (dt <= -128 || dt >= 128) {
                const int dq = a.q0 + r32 - cur * 32 - 8 * hi;
#pragma unroll
                for (int r = 0; r < 16; ++r) { const int dd = dq - (16 * (r >> 3) + (r & 7)); if (dd > 128 || dd < -128) st[r] = NEG; }
            }
        }
        if (MODE == 2 && masked) {
            const int kr = cur >> 1, w = a.q0 + r32; const int cs = min(max(w - 8, 0), 48);
            const int cb = (cur & 1) * 32 + 8 * hi;
            const int c0 = cb - cs;
#pragma unroll
            for (int r = 0; r < 16; ++r) { const int o = 16 * (r >> 3) + (r & 7); st[r] = ((unsigned)(c0 + o) < 16u) ? st[r] + bias[r] : NEG; }
        }
        float mx = st[0];
#pragma unroll
        for (int r = 1; r < 16; ++r) mx = fmaxf(mx, st[r]);
        mx = xhalf_max(mx);
        if (__any(mx > 8.0f)) {
            const float d = fmaxf(mx, 0.f), f = fexp2(-d);
            m_run += d; l_run *= f;
#pragma unroll
            for (int r = 0; r < 16; ++r) { o0[r] *= f; o1[r] *= f; st[r] -= d; }
        }
        float ps = 0.f;
#pragma unroll
        for (int r = 0; r < 16; ++r) { st[r] = fexp2(st[r]); ps += st[r]; }
        l_run += ps;
        const bf16x8 p0 = pack8(st, 0), p1 = pack8(st, 8);
        o0 = __builtin_amdgcn_mfma_f32_32x32x16_bf16(vf[0][0], p0, o0, 0, 0, 0);
        o0 = __builtin_amdgcn_mfma_f32_32x32x16_bf16(vf[0][1], p1, o0, 0, 0, 0);
        o1 = __builtin_amdgcn_mfma_f32_32x32x16_bf16(vf[1][0], p0, o1, 0, 0, 0);
        o1 = __builtin_amdgcn_mfma_f32_32x32x16_bf16(vf[1][1], p1, o1, 0, 0, 0);
#pragma unroll
        for (int d0 = 0; d0 < ND; ++d0) { kf[d0] = k1[d0]; k1[d0] = kn[d0]; }
#pragma unroll
        for (int d0 = 0; d0 < 2; ++d0)
#pragma unroll
            for (int s = 0; s < 2; ++s) { vf[d0][s] = v1[d0][s]; v1[d0][s] = vn[d0][s]; }
    }
#undef AW_TILE
    l_run = xhalf_sum(l_run);
    if (a.sink2 != NEG) l_run += fexp2(a.sink2 - m_run);
    const float inv = 1.0f / l_run;
    bf16_t* orow = a.O + (size_t)r32 * a.opitch + 4 * hi;
#pragma unroll
    for (int g = 0; g < 4; ++g) {
        u32x2 w0, w1;
        w0.x = cvt_pk_bf16(o0[4 * g] * inv, o0[4 * g + 1] * inv); w0.y = cvt_pk_bf16(o0[4 * g + 2] * inv, o0[4 * g + 3] * inv);
        w1.x = cvt_pk_bf16(o1[4 * g] * inv, o1[4 * g + 1] * inv); w1.y = cvt_pk_bf16(o1[4 * g + 2] * inv, o1[4 * g + 3] * inv);
        *(u32x2*)(orow + 8 * g) = w0; *(u32x2*)(orow + 32 + 8 * g) = w1;
    }
}

__device__ __forceinline__ void ret_c1_unit(const Params& p, int chain, int c, int lane) {
    const int r32 = lane & 31, hi = lane >> 5, bh = chain >> 1, dir = chain & 1;
    const bf16_t* kw = wsp<bf16_t>(p, dir ? WS_KWR : WS_KWF) + ((size_t)bh * (KEYS / 32) + 4 * c) * 2048 + (hi * 64 + r32) * 8;
    const bf16_t* vt = wsp<bf16_t>(p, WS_VTC) + ((size_t)bh * (KEYS / 32) + 4 * c) * 2048 + (hi * 64 + r32) * 8;
    f32x16 acc[2][2]; const float zr = opaque_zero();
#pragma unroll
    for (int mi = 0; mi < 2; ++mi)
#pragma unroll
        for (int ni = 0; ni < 2; ++ni)
#pragma unroll
            for (int r = 0; r < 16; ++r) acc[mi][ni][r] = zr;
    bf16x8 af[8][2], bfr[8][2];
#pragma unroll
    for (int s = 0; s < 8; ++s)
#pragma unroll
        for (int mi = 0; mi < 2; ++mi) { af[s][mi] = *(const bf16x8*)(kw + (s >> 1) * 2048 + (s & 1) * 1024 + mi * 256); bfr[s][mi] = *(const bf16x8*)(vt + (s >> 1) * 2048 + (s & 1) * 1024 + mi * 256); }
#pragma unroll
    for (int s = 0; s < 8; ++s)
#pragma unroll
        for (int mi = 0; mi < 2; ++mi)
#pragma unroll
            for (int ni = 0; ni < 2; ++ni) acc[mi][ni] = __builtin_amdgcn_mfma_f32_32x32x16_bf16(af[s][mi], bfr[s][ni], acc[mi][ni], 0, 0, 0);
    float* out = wsp<float>(p, WS_KVST) + ((size_t)chain * 34 + c) * 4096;
#pragma unroll
    for (int mi = 0; mi < 2; ++mi)
#pragma unroll
        for (int ni = 0; ni < 2; ++ni)
#pragma unroll
            for (int g = 0; g < 4; ++g)
                *(f32x4*)(out + (size_t)(r32 + 32 * ni) * 64 + 32 * mi + 8 * g + 4 * hi) = (f32x4){acc[mi][ni][4 * g], acc[mi][ni][4 * g + 1], acc[mi][ni][4 * g + 2], acc[mi][ni][4 * g + 3]};
}
__device__ __forceinline__ void ret_c2(const Params& p, int l, int gtid, int gthreads) {
    for (int idx = gtid; idx < 64 * 4096; idx += gthreads) {
        const int chain = idx >> 12, e = idx & 4095, dir = chain & 1, h = (chain >> 1) & 7;
        const float lg = -__expf(p.in[I_CLD][(l * 2 + dir) * 8 + h]);
        const float dec = __expf(lg * 128.0f);
        const float* kv = wsp<float>(p, WS_KVST) + (size_t)chain * 34 * 4096 + e;
        bf16_t* sp = wsp<bf16_t>(p, WS_SPREV) + (size_t)chain * 34 * 4096 + e;
        float kvv[34];
#pragma unroll
        for (int st = 0; st < 34; ++st) { const int cc = dir == 0 ? (st < 2 ? 32 + st : st - 2) : 33 - st; kvv[st] = kv[(size_t)cc * 4096]; }
        float s = 0.f;
#pragma unroll
        for (int st = 0; st < 34; ++st) { const int cc = dir == 0 ? (st < 2 ? 32 + st : st - 2) : 33 - st; sp[(size_t)cc * 4096] = (bf16_t)(cvt_pk_bf16(s, 0.f) & 0xffffu); s = s * dec + kvv[st]; }
    }
}
__device__ __forceinline__ void ret_c3_unit(const Params& p, int l, int bh, int c, int qq, int lane) {
    const int r32 = lane & 31, hi = lane >> 5, b = bh >> 3, h = bh & 7;
    const int row0 = c < 32 ? b * SEQ + 128 * c + 32 * qq : ML + b * CTXL + 128 * (c - 32) + 32 * qq;
    const float lgf2 = -__expf(p.in[I_CLD][(l * 2 + 0) * 8 + h]) * LOG2E, lgr2 = -__expf(p.in[I_CLD][(l * 2 + 1) * 8 + h]) * LOG2E;
    bf16x8 qf[4];
    if (c < 32) load_q_prepped<false, true>(wsp<bf16_t>(p, WS_P) + (size_t)(row0 + r32) * INCP + PC_CQ + h * 64, nullptr, wsp<float>(p, WS_ROPE64) + (size_t)((row0 + r32) & (SEQ - 1)) * 64, 1.0f, hi, qf);
    else load_q_prepped<false, false>(wsp<bf16_t>(p, WS_P) + (size_t)(row0 + r32) * INCP + PC_CQ + h * 64, nullptr, nullptr, 1.0f, hi, qf);
    const bf16_t* kp = wsp<bf16_t>(p, WS_KC) + ((size_t)bh * (KEYS / 32) + 4 * c) * 2048 + hi * 256 + permkey(r32) * 8;
    const bf16_t* vp = wsp<bf16_t>(p, WS_VTC) + ((size_t)bh * (KEYS / 32) + 4 * c) * 2048 + (hi * 64 + r32) * 8;
    bf16x8 spa[2][2][4]; u32x2 gq0[4], gq1[4];
    { const bf16_t* gp0 = wsp<bf16_t>(p, WS_P) + (size_t)(row0 + r32) * INCP + PC_CG + h * 64 + 4 * hi;
#pragma unroll
      for (int dir = 0; dir < 2; ++dir) { const bf16_t* sp = wsp<bf16_t>(p, WS_SPREV) + (((size_t)(bh * 2 + dir)) * 34 + c) * 4096 + (size_t)r32 * 64 + 8 * hi;
#pragma unroll
          for (int s = 0; s < 4; ++s) { spa[dir][0][s] = *(const bf16x8*)(sp + 16 * s); spa[dir][1][s] = *(const bf16x8*)(sp + 32 * 64 + 16 * s); } }
#pragma unroll
      for (int g = 0; g < 4; ++g) { gq0[g] = *(const u32x2*)(gp0 + 8 * g); gq1[g] = *(const u32x2*)(gp0 + 32 + 8 * g); } }
    f32x16 o0, o1; const float zr = opaque_zero();
#pragma unroll
    for (int r = 0; r < 16; ++r) { o0[r] = zr; o1[r] = zr; }
    const int il = 32 * qq + r32;
#pragma unroll 1
    for (int kt = 0; kt < 4; ++kt) {
        f32x16 st;
#pragma unroll
        for (int r = 0; r < 16; ++r) st[r] = zr;
#pragma unroll
        for (int d0 = 0; d0 < 4; ++d0) { const bf16x8 kf = *(const bf16x8*)(kp + kt * 2048 + d0 * 512); st = __builtin_amdgcn_mfma_f32_32x32x16_bf16(kf, qf[d0], st, 0, 0, 0); }
        const int dq = il - 32 * kt - 8 * hi;
#pragma unroll
        for (int r = 0; r < 16; ++r) { const int dd = dq - (16 * (r >> 3) + (r & 7));
            const float dec = dd > 0 ? fexp2(lgf2 * (float)dd) : (dd == 0 ? 2.0f : fexp2(lgr2 * (float)(-dd)));
            st[r] *= dec; }
        const bf16x8 p0 = pack8(st, 0), p1 = pack8(st, 8);
        const bf16x8 v00 = *(const bf16x8*)(vp + kt * 2048), v01 = *(const bf16x8*)(vp + kt * 2048 + 1024), v10 = *(const bf16x8*)(vp + kt * 2048 + 256), v11 = *(const bf16x8*)(vp + kt * 2048 + 1024 + 256);
        o0 = __builtin_amdgcn_mfma_f32_32x32x16_bf16(v00, p0, o0, 0, 0, 0); o0 = __builtin_amdgcn_mfma_f32_32x32x16_bf16(v01, p1, o0, 0, 0, 0);
        o1 = __builtin_amdgcn_mfma_f32_32x32x16_bf16(v10, p0, o1, 0, 0, 0); o1 = __builtin_amdgcn_mfma_f32_32x32x16_bf16(v11, p1, o1, 0, 0, 0);
    }
#pragma unroll
    for (int dir = 0; dir < 2; ++dir) {
        f32x16 c0, c1;
#pragma unroll
        for (int r = 0; r < 16; ++r) { c0[r] = zr; c1[r] = zr; }
#pragma unroll
        for (int s = 0; s < 4; ++s) { c0 = __builtin_amdgcn_mfma_f32_32x32x16_bf16(spa[dir][0][s], qf[s], c0, 0, 0, 0); c1 = __builtin_amdgcn_mfma_f32_32x32x16_bf16(spa[dir][1][s], qf[s], c1, 0, 0, 0); }
        const float wgt = dir == 0 ? fexp2(lgf2 * (float)(il + 1)) : fexp2(lgr2 * (float)(128 - il));
#pragma unroll
        for (int r = 0; r < 16; ++r) { o0[r] += wgt * c0[r]; o1[r] += wgt * c1[r]; }
    }
    float ss = 0.f;
#pragma unroll
    for (int r = 0; r < 16; ++r) ss += o0[r] * o0[r] + o1[r] * o1[r];
    ss = xhalf_sum(ss);
    const float rstd = 1.0f / sqrtf(ss * (1.0f / 64.0f) + EPS);
    bf16_t* op = wsp<bf16_t>(p, WS_OCAT) + (size_t)(row0 + r32) * DM + 1024 + h * 64 + 4 * hi;
#pragma unroll
    for (int g = 0; g < 4; ++g) {
        const u32x2 g0 = gq0[g], g1 = gq1[g];
        u32x2 w0, w1;
        w0.x = cvt_pk_bf16(o0[4 * g] * rstd * silu_f(bf_lo(g0.x)), o0[4 * g + 1] * rstd * silu_f(bf_hi(g0.x))); w0.y = cvt_pk_bf16(o0[4 * g + 2] * rstd * silu_f(bf_lo(g0.y)), o0[4 * g + 3] * rstd * silu_f(bf_hi(g0.y)));
        w1.x = cvt_pk_bf16(o1[4 * g] * rstd * silu_f(bf_lo(g1.x)), o1[4 * g + 1] * rstd * silu_f(bf_hi(g1.x))); w1.y = cvt_pk_bf16(o1[4 * g + 2] * rstd * silu_f(bf_lo(g1.y)), o1[4 * g + 3] * rstd * silu_f(bf_hi(g1.y)));
        *(u32x2*)(op + 8 * g) = w0; *(u32x2*)(op + 32 + 8 * g) = w1;
    }
}
constexpr int MLA_KIMG = 12288, MLA_VIMG = 8192, MLA_NT = KEYS / 64, MLA_NS = 6, MLA_D = MLA_NS - 1, MLA_VOFF = MLA_NS * MLA_KIMG;
__device__ __forceinline__ void mla_dma_tile(const unsigned char* kimg, const unsigned char* vimg, LAS unsigned char* lds, int slot, int w, int lane) {
#pragma unroll
    for (int i = 0; i < 3; ++i) {
        const int j = w + 8 * i;
        if (j < 20) {
            const unsigned char* src = j < 12 ? kimg + j * 1024 + lane * 16 : vimg + (j - 12) * 1024 + lane * 16;
            LAS unsigned char* dst = j < 12 ? lds + slot * MLA_KIMG + j * 1024 : lds + MLA_VOFF + slot * MLA_VIMG + (j - 12) * 1024;
            __builtin_amdgcn_global_load_lds((const GAS unsigned*)src, (LAS unsigned*)dst, 16, 0, 0);
        }
    }
}
__device__ __forceinline__ void mla_unit(const Params& p, LAS unsigned char* lds, int bh, int qb, int tile0, int ntiles, int tid, const float* qgain  ) {
    const int lane = tid & 63, w = __builtin_amdgcn_readfirstlane(tid >> 6), r32 = lane & 31, hi = lane >> 5, b = bh >> 3, h = bh & 7;
    const bool late = w >= 4;
    const int row0 = (qb < 16 ? b * SEQ + 256 * qb : ML + b * CTXL) + 32 * w;
    const unsigned char* kimg = wsp<unsigned char>(p, WS_KB) + ((size_t)bh * MLA_NT + tile0) * MLA_KIMG;
    const unsigned char* vimg = wsp<unsigned char>(p, WS_VTB) + ((size_t)bh * MLA_NT + tile0) * MLA_VIMG;
    bf16x8 qf[6];
    { const bf16_t* qrow = wsp<bf16_t>(p, WS_UPRAW) + (size_t)(row0 + r32) * 1792 + h * 96 + 8 * hi;
      u32x4 raw[6]; f32x4 gn[6][2], cs[4];
#pragma unroll
      for (int d0 = 0; d0 < 6; ++d0) raw[d0] = *(const u32x4*)(qrow + 16 * d0);
      const float rq = wsp<float>(p, WS_RQ)[row0 + r32];
#pragma unroll
      for (int d0 = 0; d0 < 6; ++d0) { gn[d0][0] = *(const f32x4*)(qgain + 16 * d0 + 8 * hi); gn[d0][1] = *(const f32x4*)(qgain + 16 * d0 + 8 * hi + 4); }
      const bool latent = qb < 16;
      { const float* rp = wsp<float>(p, WS_ROPE32) + ((size_t)(latent ? ((row0 + r32) & (SEQ - 1)) : 0) * 16 + 8 * hi) * 2;
#pragma unroll
        for (int j = 0; j < 4; ++j) cs[j] = *(const f32x4*)(rp + 4 * j); }
      asm volatile("s_waitcnt vmcnt(0)" ::: "memory");
      float x[6][8]; float ss = 0.f;
#pragma unroll
      for (int d0 = 0; d0 < 6; ++d0) { x[d0][0] = bf_lo(raw[d0].x); x[d0][1] = bf_hi(raw[d0].x); x[d0][2] = bf_lo(raw[d0].y); x[d0][3] = bf_hi(raw[d0].y);
          x[d0][4] = bf_lo(raw[d0].z); x[d0][5] = bf_hi(raw[d0].z); x[d0][6] = bf_lo(raw[d0].w); x[d0][7] = bf_hi(raw[d0].w);
#pragma unroll
          for (int e = 0; e < 8; e += 2) ss += x[d0][e] * x[d0][e] + x[d0][e + 1] * x[d0][e + 1]; }
      ss = xhalf_sum(ss);
      const float r = rq / sqrtf(rq * rq * ss * (1.0f / 96.0f) + EPS);
#pragma unroll
      for (int d0 = 0; d0 < 6; ++d0)
#pragma unroll
          for (int e = 0; e < 8; ++e) x[d0][e] *= r * gn[d0][e >> 2][e & 3];
      if (latent) {
#pragma unroll
          for (int e = 0; e < 8; ++e) { const float c = cs[e >> 1][2 * (e & 1)], s = cs[e >> 1][2 * (e & 1) + 1]; const float lo = x[4][e], up = x[5][e];
              x[4][e] = lo * c - up * s; x[5][e] = lo * s + up * c; } }
      const float qscale = 0.10206207261596575f * LOG2E;
#pragma unroll
      for (int d0 = 0; d0 < 6; ++d0) { u32x4 w; w.x = cvt_pk_bf16(x[d0][0] * qscale, x[d0][1] * qscale); w.y = cvt_pk_bf16(x[d0][2] * qscale, x[d0][3] * qscale);
          w.z = cvt_pk_bf16(x[d0][4] * qscale, x[d0][5] * qscale); w.w = cvt_pk_bf16(x[d0][6] * qscale, x[d0][7] * qscale); qf[d0] = __builtin_bit_cast(bf16x8, w); }
    }
#pragma unroll
    for (int i = 0; i < MLA_D; ++i) if (i < ntiles) mla_dma_tile(kimg + (size_t)i * MLA_KIMG, vimg + (size_t)i * MLA_VIMG, lds, i, w, lane);
    f32x16 o0, o1; const float zr = opaque_zero();
#pragma unroll
    for (int r = 0; r < 16; ++r) { o0[r] = zr; o1[r] = zr; }
    float m_run = 0.f, l_run = 0.f;
    if (ntiles >= MLA_D) { if (!late) asm volatile("s_waitcnt vmcnt(12)" ::: "memory"); else asm volatile("s_waitcnt vmcnt(8)" ::: "memory"); }
    else asm volatile("s_waitcnt vmcnt(0)" ::: "memory");
    __builtin_amdgcn_s_barrier();
    const int koff = (hi * 64 + permkey(r32)) * 16;
    const int voff = (hi * 64 + r32) * 16;
    bf16x8 kf[12];
#pragma unroll
    for (int d0 = 0; d0 < 6; ++d0) { kf[2 * d0] = *(const LAS bf16x8*)(lds + koff + d0 * 2048); kf[2 * d0 + 1] = *(const LAS bf16x8*)(lds + koff + d0 * 2048 + 512); }
    int slot = 0;
#define MLA_SEAM(t) do { if ((t) + MLA_D - 1 < ntiles) { if (!late) asm volatile("s_waitcnt vmcnt(9) lgkmcnt(0)" ::: "memory"); else asm volatile("s_waitcnt vmcnt(6) lgkmcnt(0)" ::: "memory"); } \
        else asm volatile("s_waitcnt vmcnt(0) lgkmcnt(0)" ::: "memory"); \
        __builtin_amdgcn_s_barrier(); \
        if ((t) + MLA_D < ntiles) mla_dma_tile(kimg + (size_t)((t) + MLA_D) * MLA_KIMG, vimg + (size_t)((t) + MLA_D) * MLA_VIMG, lds, slot == 0 ? MLA_NS - 1 : slot - 1, w, lane); } while (0)
    for (int t = 0; t < ntiles; ++t) {
        if (late) MLA_SEAM(t);
        f32x16 s0, s1;
#pragma unroll
        for (int r = 0; r < 16; ++r) { s0[r] = -m_run; s1[r] = -m_run; }
        __builtin_amdgcn_sched_barrier(0);
#pragma unroll
        for (int d0 = 0; d0 < 6; ++d0) s0 = __builtin_amdgcn_mfma_f32_32x32x16_bf16(kf[2 * d0], qf[d0], s0, 0, 0, 0);
#pragma unroll
        for (int d0 = 0; d0 < 6; ++d0) s1 = __builtin_amdgcn_mfma_f32_32x32x16_bf16(kf[2 * d0 + 1], qf[d0], s1, 0, 0, 0);
        __builtin_amdgcn_sched_barrier(0);
        if (!late) MLA_SEAM(t);
        const LAS unsigned char* vs = lds + MLA_VOFF + slot * MLA_VIMG + voff;
        const LAS unsigned char* ks = lds + (slot + 1 == MLA_NS ? 0 : slot + 1) * MLA_KIMG + koff;
        bf16x8 vf[8];
#pragma unroll
        for (int d0 = 0; d0 < 2; ++d0)
#pragma unroll
            for (int q = 0; q < 4; ++q) vf[d0 * 4 + q] = *(const LAS bf16x8*)(vs + q * 2048 + d0 * 512);
        if (t + 1 < ntiles) {
#pragma unroll
            for (int d0 = 0; d0 < 6; ++d0) { kf[2 * d0] = *(const LAS bf16x8*)(ks + d0 * 2048); kf[2 * d0 + 1] = *(const LAS bf16x8*)(ks + d0 * 2048 + 512); }
        }
        __builtin_amdgcn_sched_barrier(0);
        float pq[4] = {0.f, 0.f, 0.f, 0.f};
#define MLA_GRP(S, O, G, VA, VB) do { _Pragma("unroll") for (int r = (O); r < (O) + 8; ++r) { S[r] = fexp2(S[r]); pq[G] += S[r]; } \
            const bf16x8 pg = pack8(S, O); \
            o0 = __builtin_amdgcn_mfma_f32_32x32x16_bf16(vf[VA], pg, o0, 0, 0, 0); o1 = __builtin_amdgcn_mfma_f32_32x32x16_bf16(vf[VB], pg, o1, 0, 0, 0); } while (0)
        { float mq[4] = {s0[0], s0[1], s0[2], s0[3]};
#pragma unroll
          for (int r = 4; r < 16; ++r) mq[r & 3] = fmaxf(mq[r & 3], s0[r]);
          const float mx = xhalf_max(fmaxf(fmaxf(mq[0], mq[1]), fmaxf(mq[2], mq[3])));
          if (__any(mx > 8.0f)) {
              const float d = fmaxf(mx, 0.f), f = fexp2(-d);
              m_run += d; l_run *= f;
#pragma unroll
              for (int r = 0; r < 16; ++r) { o0[r] *= f; o1[r] *= f; s0[r] -= d; s1[r] -= d; }
          } }
        MLA_GRP(s0, 0, 0, 0, 4); MLA_GRP(s0, 8, 1, 1, 5);
        l_run += pq[0] + pq[1];
        { float mq[4] = {s1[0], s1[1], s1[2], s1[3]};
#pragma unroll
          for (int r = 4; r < 16; ++r) mq[r & 3] = fmaxf(mq[r & 3], s1[r]);
          const float mx = xhalf_max(fmaxf(fmaxf(mq[0], mq[1]), fmaxf(mq[2], mq[3])));
          if (__any(mx > 8.0f)) {
              const float d = fmaxf(mx, 0.f), f = fexp2(-d);
              m_run += d; l_run *= f;
#pragma unroll
              for (int r = 0; r < 16; ++r) { o0[r] *= f; o1[r] *= f; s1[r] -= d; }
          } }
        MLA_GRP(s1, 0, 2, 2, 6); MLA_GRP(s1, 8, 3, 3, 7);
#undef MLA_GRP
        l_run += pq[2] + pq[3];
        slot = slot + 1 == MLA_NS ? 0 : slot + 1;
    }
#undef MLA_SEAM
    l_run = xhalf_sum(l_run);
    const float inv = 1.0f / l_run;
    bf16_t* orow = wsp<bf16_t>(p, WS_OCAT) + (size_t)(row0 + r32) * DM + 512 + h * 64 + 4 * hi;
#pragma unroll
    for (int g = 0; g < 4; ++g) {
        u32x2 w0, w1;
        w0.x = cvt_pk_bf16(o0[4 * g] * inv, o0[4 * g + 1] * inv); w0.y = cvt_pk_bf16(o0[4 * g + 2] * inv, o0[4 * g + 3] * inv);
        w1.x = cvt_pk_bf16(o1[4 * g] * inv, o1[4 * g + 1] * inv); w1.y = cvt_pk_bf16(o1[4 * g + 2] * inv, o1[4 * g + 3] * inv);
        *(u32x2*)(orow + 8 * g) = w0; *(u32x2*)(orow + 32 + 8 * g) = w1;
    }
    asm volatile("s_waitcnt vmcnt(0) lgkmcnt(0)" ::: "memory");
}
__device__ __forceinline__ void moe_tables(const Params& p, LAS int* tb, int tid) {
    if (tid < NEXP)
        tb[160 + tid] = (int)__hip_atomic_load(wsp<unsigned>(p, WS_CTL) + CW_ECNT + 64 * tid, __ATOMIC_RELAXED, __HIP_MEMORY_SCOPE_AGENT);
    __syncthreads();
    if (tid == 0) {
        int base = 0;
        for (int e = 0; e < NEXP; ++e) {
            const int cnt = tb[160 + e];
            const int nt = (cnt + 255) >> 8; tb[e] = base * 256;
            int ev = e; asm volatile("" : "+v"(ev));
#pragma clang loop vectorize(disable) unroll(disable)
            for (int t = 0; t < nt; ++t) tb[16 + base + t] = ev;
            base += nt;
        }
        tb[8] = base;
    }
    __syncthreads();
}

__device__ __forceinline__ int gemm_cus(int nwg, int G) { const int R = (nwg + G - 1) / G; const int g = (((nwg + R - 1) / R) + 7) & ~7; return g < G ? g : G; }

constexpr int NPHASE = 24;
constexpr int MAIN_RT = 2 * ML / 256;
constexpr int CONV_C1 = 0, CONV_C2 = CONV_C1 + 7168, CONV_CF = CONV_C2 + 0  , CONV_C3 = CONV_CF + (FFN2_FP8 ? 22528 : 21504), CONV_C4 = CONV_C3 + 9216;
constexpr int DI_GU_A = 5632;
constexpr int CONV_WQG = 544;
constexpr int CONV_C5 = CONV_C4 + 2 * CONV_WQG * 32;
static_assert(CONV_C5 <= NCONV, "conversion shares");
__global__ void __launch_bounds__(512, 2) fwd_kernel(Params pk) {
    const KArg ka0 = (KArg)__builtin_amdgcn_kernarg_segment_ptr(); (void)pk;
    Params p = load_params(ka0);
    extern __shared__ __attribute__((aligned(16))) unsigned char lds_raw[];
    LAS unsigned char* lds = (LAS unsigned char*)lds_raw;
    volatile LAS unsigned* MISC = (volatile LAS unsigned*)(lds + MISC_OFF);
    const int wave_o = __builtin_amdgcn_readfirstlane((int)threadIdx.x >> 6);
    const int G_o = gridDim.x; const int vcu_o = (G_o % 8 == 0) ? ((int)blockIdx.x % 8) * (G_o / 8) + (int)blockIdx.x / 8 : (int)blockIdx.x;
    { const int t0 = threadIdx.x; if (t0 < 256) MISC[t0] = 0u; }
    __syncthreads();
    XcdBarrier bar; bar.bar = wsp<unsigned>(p, WS_CTL) + CW_BAR; bar.x = 0; bar.st = MISC + 8;
#if MK_ONE_LAUNCH
    bar = xcd_barrier_post(wsp<unsigned>(p, WS_CTL) + CW_BAR, MISC + 8, wave_o == 0 && lane_id_asm() == 0);
#endif
    const int lo = p.ph_lo, hi = p.ph_hi;
#define IN(k) (lo <= (k) && (k) < hi)
#ifndef PH_MASK
#define PH_MASK 0xffffffffu
#endif
#define PHEN(k) (((PH_MASK) >> (k)) & 1u)
#ifndef REP_MASK
#define REP_MASK 0u
#endif
#ifndef REP_LAYER
#define REP_LAYER -1
#endif
#define REPS(k) (1 + (int)((((REP_MASK) >> (k)) & 1u) && (REP_LAYER < 0 || l == REP_LAYER)))
#if MK_ONE_LAUNCH
#define SEAM(k) do { if (IN(k) && IN((k) + 1)) xcd_barrier(bar, wave_o == 0 && lane_id_asm() == 0); } while (0)
#else
#define SEAM(k) do { } while (0)
#endif
#ifdef NO_LWS
#define LAUNDER_WS
#else
#define LAUNDER_WS asm volatile("" : "+s"(p.ws))
#endif
#define OPQ Params p = load_params(ka0); const int lane = lane_id_asm(), wave = lnd_s(wave_o), tid = wave * 64 + lane, bid = lnd_s((int)blockIdx.x), G = lnd_s(G_o), vcu = lnd_s(vcu_o), gw = vcu * 8 + wave, NGW = G * 8; \
    (void)tid; (void)bid; (void)gw; (void)NGW; LAUNDER_WS; if (REP_MASK) __syncthreads();
    LAS int* tb = (LAS int*)(lds + MISC_OFF + 256);

    if (PHEN(0) && IN(0)) for (int rep = 0, l = 1; rep < REPS(0); ++rep) { OPQ p0_prologue(p, lds, G, vcu, wave); }
    SEAM(0);

#pragma unroll
    for (int l = 0; l < 2; ++l) {
        const int pb = 1 + 12 * l;
        const float* mod = wsp<float>(p, WS_MOD) + (size_t)l * 5 * MODW;
        const int mrows = l == 0 ? MT : ML;
        if (PHEN(1) && IN(pb + 0)) for (int rep = 0; rep < REPS(1); ++rep) { OPQ
            for (int row = 2 * gw; row < MT; row += 2 * NGW) {
                const float* ma = mod + (size_t)(row < ML ? (row >> 12) : 4) * MODW;
                if (l == 0) norm_mod_row2<false, false>(row < ML ? p.in[I_X] + (size_t)row * DM : p.in[I_CTX] + (size_t)(row - ML) * DM, p.in[I_NMIX] + l * DM, ma, ma + DM, wsp<bf16_t>(p, WS_H) + (size_t)row * DM, DM, lane);
                else norm_mod_row2<false, true>(wsp<bf16_t>(p, WS_X1) + (size_t)row * DM, p.in[I_NMIX] + l * DM, ma, ma + DM, wsp<bf16_t>(p, WS_H) + (size_t)row * DM, DM, lane);
            }
        }
        SEAM(pb + 0);
        if (PHEN(2) && IN(pb + 1)) for (int rep = 0; rep < REPS(2); ++rep) { OPQ
            pg8::Gemm g{wsp<bf16_t>(p, WS_H), wsp<bf16_t>(p, WS_WIN) + (size_t)l * INCP * DM, DM, DM, 0, 0, 0};
            pg8::TileOrder S; S.init(MT / 256, INCP / 256, G, bid, nullptr);
            pg8::EpiBf16 E{wsp<bf16_t>(p, WS_P), INCP};
            pg8::gemm_phase<2>(lds, g, S, E, wave);
            { const int fi = S.first_idle(); const bool all = fi >= G;
              if (all || S.idle_last_round()) { const int wi = all ? gw : (bid - fi) * 8 + wave, nw = all ? NGW : (G - fi) * 8;
                  if (l == 0) dense_items(p, lds, wave, lane, 2 * DI_PER_L, 2 * DI_PER_L + DI_GU_A, wi, nw);
                  moe_convert_pipe(p, lds, wave, lane, l == 0 ? 0 : CONV_C3, l == 0 ? CONV_C1 : CONV_C4, wi, nw); } }
        }
        SEAM(pb + 1);
        if (PHEN(3) && IN(pb + 2)) for (int rep = 0; rep < REPS(3); ++rep) { OPQ
#ifndef NO_UPG
            { pg8::Gemm g{wsp<bf16_t>(p, WS_P) + PC_BQ, wsp<bf16_t>(p, WS_WUP) + (size_t)l * 1792 * 512, INCP, 512, 0, 0, 0};
              pg8::TileOrder S; S.init(MT / 256, 7, G, bid, nullptr);
              pg8::EpiBf16 E{wsp<bf16_t>(p, WS_UPRAW), 1792};
              pg8::gemm_phase<2>(lds, g, S, E, wave); }
#endif
            __syncthreads();
#ifndef NO_HEADS
            { const int l16h = lane & 15;
              const f32x4 g_ak = *(const f32x4*)(p.in[I_AKN] + l * 64 + 4 * l16h), g_dk = *(const f32x4*)(p.in[I_DKN] + l * 64 + 4 * l16h), g_no = {1.f, 1.f, 1.f, 1.f};
            for (int row = gw; row < MT; row += 2 * NGW) {
                const int rb = row + NGW < MT ? row + NGW : row;
                const HeadKind kak{PC_AK, 2, p.in[I_AKN] + l * 64, 1, 1.0f, wsp<bf16_t>(p, WS_KA), 1};
                const HeadKind kck{PC_CK, 8, nullptr, 1, 0.125f, wsp<bf16_t>(p, WS_KC), 1};
                const HeadKind kdk{PC_DK, 8, p.in[I_DKN] + l * 64, 0, 1.0f, wsp<bf16_t>(p, WS_KD), 1};
                u32x2 w1[2], w3[2], w5[2], u1[2], u3[2], u5[2];
                f32x4 ra[2], rbp[2];
                { const float* ca = wsp<float>(p, WS_ROPE64) + ((size_t)(row < ML ? (row & (SEQ - 1)) : 0) * 32 + 4 * (l16h & 7)) * 2; ra[0] = *(const f32x4*)ca; ra[1] = *(const f32x4*)(ca + 4);
                  const float* cb = wsp<float>(p, WS_ROPE64) + ((size_t)(rb < ML ? (rb & (SEQ - 1)) : 0) * 32 + 4 * (l16h & 7)) * 2; rbp[0] = *(const f32x4*)cb; rbp[1] = *(const f32x4*)(cb + 4); }
                prep_heads_load(p, kak, row, lane, w1); prep_heads_load(p, kck, row, lane, w3); prep_heads_load(p, kdk, row, lane, w5);
                prep_heads_load(p, kak, rb, lane, u1); prep_heads_load(p, kck, rb, lane, u3); prep_heads_load(p, kdk, rb, lane, u5);
                prep_heads_compute(p, kak, row, lane, w1, ra, g_ak); prep_heads_compute(p, kck, row, lane, w3, ra, g_no); prep_heads_compute(p, kdk, row, lane, w5, ra, g_dk);
                prep_heads_compute(p, kak, rb, lane, u1, rbp, g_ak); prep_heads_compute(p, kck, rb, lane, u3, rbp, g_no); prep_heads_compute(p, kdk, rb, lane, u5, rbp, g_dk);
            } }
#endif
#ifndef NO_TR
            LAS bf16_t* scr = (LAS bf16_t*)(lds + wave * 16384);
            for (int u = (gw + NGW / 2) % NGW; u < NB * 68 * 26; u += NGW) {
                const int b = u / (68 * 26), r = u % (68 * 26), tt = r / 26, hh = r % 26;
                if (hh < 2) { const TrKind k{wsp<bf16_t>(p, WS_P), INCP, PC_AV, 2, nullptr, 0, 1.0f, 0, wsp<bf16_t>(p, WS_VTA), nullptr, 0.f, 0.f, 2}; prep_transpose_unit(p, k, b, hh, tt, scr, lane); }
                else if (hh < 10) { const TrKind k{wsp<bf16_t>(p, WS_P), INCP, PC_CV, 8, nullptr, 0, 1.0f, 0, wsp<bf16_t>(p, WS_VTC), nullptr, 0.f, 0.f, 2}; prep_transpose_unit(p, k, b, hh - 2, tt, scr, lane); }
                else if (hh < 18) { const TrKind k{wsp<bf16_t>(p, WS_P), INCP, PC_DV, 8, nullptr, 0, 1.0f, 0, wsp<bf16_t>(p, WS_VTD), nullptr, 0.f, 0.f, 2}; prep_transpose_unit(p, k, b, hh - 10, tt, scr, lane); }
                else { const int h = hh - 18;
                    const float lgf2 = -__expf(p.in[I_CLD][(l * 2 + 0) * 8 + h]) * LOG2E, lgr2 = -__expf(p.in[I_CLD][(l * 2 + 1) * 8 + h]) * LOG2E;
                    const TrKind k{wsp<bf16_t>(p, WS_P), INCP, PC_CK, 8, nullptr, 1, 0.125f, 1, wsp<bf16_t>(p, WS_KWF), wsp<bf16_t>(p, WS_KWR), lgf2, lgr2, 2}; prep_transpose_unit(p, k, b, h, tt, scr, lane); }
            }
#endif
        }
        SEAM(pb + 2);
        if (PHEN(4) && IN(pb + 3)) for (int rep = 0; rep < REPS(4); ++rep) { OPQ
            { const int l32m = lane & 31, d0m = l32m < 24 ? 4 * l32m : 0;
              const f32x4 gq = *(const f32x4*)(p.in[I_BQN] + l * 96 + d0m), gk = *(const f32x4*)(p.in[I_BKN] + l * 96 + d0m);
            for (int row = gw; row < MT; row += 2 * NGW) {
                const int rb = row + NGW < MT ? row + NGW : row;
                MlaRegs Ra, Rb; prep_mla_load(p, row, lane, Ra); prep_mla_load(p, rb, lane, Rb);
                prep_mla_compute(p, l, row, lane, Ra, gq, gk); prep_mla_compute(p, l, rb, lane, Rb, gq, gk);
            } }
            for (int u = (gw + NGW / 2) % NGW; u < 64 * 34; u += NGW) ret_c1_unit(p, u / 34, u % 34, lane);
        }
        SEAM(pb + 3);
        if (PHEN(5) && IN(pb + 4)) for (int rep = 0; rep < REPS(5); ++rep) { OPQ
            LAS bf16_t* scr = (LAS bf16_t*)(lds + wave * 16384);
            for (int u = gw; u < NB * 68 * 8; u += NGW) {
                const int b = u / (68 * 8), r = u % (68 * 8), tt = r / 8, h = r % 8;
                const TrKind k{wsp<bf16_t>(p, WS_UPRAW), 1792, 768 + 64, -8, wsp<float>(p, WS_RKV), 0, 1.0f, 0, wsp<bf16_t>(p, WS_VTB), nullptr, 0.f, 0.f, 1};
                prep_transpose_unit(p, k, b, h, tt, scr, lane);
            }
            ret_c2(p, l, vcu * 512 + tid, G * 512);
        }
        SEAM(pb + 4);
        if (PHEN(6) && IN(pb + 5)) for (int rep = 0; rep < REPS(6); ++rep) { OPQ
#ifndef REP_MLA
#define REP_MLA 1
#endif
#ifndef REP_WQ
#define REP_WQ 1
#endif
            for (int rep2 = 0; rep2 < REP_MLA; ++rep2)
            { const int nmla = NB * 8 * 16 + (l == 0 ? NB * 8 : 0);
              for (int u = vcu; u < nmla; u += G) {
                  if (u < NB * 8 * 16) mla_unit(p, lds, u >> 4, u & 15, 0, MLA_NT, tid, p.in[I_BQN] + l * 96);
                  else mla_unit(p, lds, u - NB * 8 * 16, 16, SEQ / 64, CTXL / 64, tid, p.in[I_BQN] + l * 96);
                  __builtin_amdgcn_s_barrier();
              } }
            const int nq = l == 0 ? 136 : 128;
            const int gD = NB * 8 * (nq / 8), gA = NB * 2 * (nq / 2), gC = NB * 8 * ((l == 0 ? 34 : 32) / 2);
            const int total = gD + gA + gC;
            const float NEG = -__builtin_inff();
            for (int rep3 = 0; rep3 < REP_WQ; ++rep3) {
            unsigned qpend = 0u;
            if (tid == 0) qpend = __hip_atomic_fetch_add(wsp<unsigned>(p, WS_CTL) + CW_Q + 64 * (l + 2 * rep + 4 * rep3), 1u, __ATOMIC_RELAXED, __HIP_MEMORY_SCOPE_AGENT);
            for (;;) {
                __syncthreads();
                if (tid == 0) { MISC[16] = qpend; qpend = __hip_atomic_fetch_add(wsp<unsigned>(p, WS_CTL) + CW_Q + 64 * (l + 2 * rep + 4 * rep3), 1u, __ATOMIC_RELAXED, __HIP_MEMORY_SCOPE_AGENT); }
                __syncthreads();
                const int qi = (int)MISC[16];
                if (qi >= 4 * max((total + 2) / 3, CONV_WQG)) break;
                if ((qi & 3) == 3) {
                    if ((qi >> 2) < CONV_WQG && rep3 == 0 && rep == 0) { const int r0 = CONV_C4 + l * CONV_WQG * 32 + (qi >> 2) * 32 + wave * 4; moe_convert_pipe(p, lds, wave, lane, r0, r0 + 4, 0, 1); }
                    continue;
                }
                int gi = 3 * (qi >> 2) + (qi & 3);
                if (gi >= total) continue;
                if (gi < gD + gA) {
                    int mixer, b, h, qb;
                    if (gi < gD) { mixer = 3; const int rg = gi % (nq / 8), bh = gi / (nq / 8); b = bh >> 3; h = bh & 7; qb = 8 * rg + wave; }
                    else { gi -= gD; mixer = 0; const int qp = gi % (nq / 2), bg = gi / (nq / 2); b = bg >> 1; h = 4 * (bg & 1) + (wave & 3); qb = 2 * qp + (wave >> 2); }
                    const int bh = b * 8 + h;
                    const bool cq = qb >= 128;
                    const int row0 = cq ? ML + b * CTXL + 32 * (qb - 128) : b * SEQ + 32 * qb;
                    AttnArgs a; a.c0 = 128; a.c1 = 136; a.sink2 = NEG; a.q0 = 0; a.qrow = 0; a.rpb = nullptr; a.opitch = DM; a.t0 = 0; a.t1 = 0; a.qpitch = INCP; a.qscale = 0.125f * LOG2E; a.qrope = nullptr;
                    if (mixer == 0) {
                        a.Q = wsp<bf16_t>(p, WS_P) + (size_t)row0 * INCP + PC_AQ + h * 64; a.qgain = p.in[I_AQN] + l * 64; if (!cq) a.qrope = wsp<float>(p, WS_ROPE64) + (size_t)(32 * qb) * 64;
                        a.K = wsp<bf16_t>(p, WS_KA) + (size_t)(b * 2 + (h >> 2)) * KEYS * 64; a.Vt = wsp<bf16_t>(p, WS_VTA) + (size_t)(b * 2 + (h >> 2)) * 64 * KEYS;
                        a.O = wsp<bf16_t>(p, WS_OCAT) + (size_t)row0 * DM + h * 64; a.sink2 = p.in[I_ASINK][l * 8 + h] * LOG2E;
                        if (!cq) { a.t0 = max(0, qb - 4); a.t1 = min(128, qb + 5); a.q0 = 32 * qb; attn_wave<64, 1>(a, lane); } else attn_wave<64, 0>(a, lane);
                    } else {
                        a.Q = wsp<bf16_t>(p, WS_P) + (size_t)row0 * INCP + PC_DQ + h * 64; a.qgain = p.in[I_DQN] + l * 64;
                        a.K = wsp<bf16_t>(p, WS_KD) + (size_t)bh * KEYS * 64; a.Vt = wsp<bf16_t>(p, WS_VTD) + (size_t)bh * 64 * KEYS;
                        a.O = wsp<bf16_t>(p, WS_OCAT) + (size_t)row0 * DM + 1536 + h * 64;
                        if (!cq) { const int gr = qb >> 1, rs = min(max(gr - 4, 0), 56); a.t0 = 2 * rs; a.t1 = a.t0 + 16; a.q0 = (qb & 1) * 32; a.qrow = gr; a.rpb = wsp<float>(p, WS_RPB) + (size_t)(l * 8 + h) * 15 * 128;
                            attn_wave<64, 2>(a, lane); } else attn_wave<64, 0>(a, lane);
                    }
                } else {
                    gi -= gD + gA;
                    const int nch2 = (l == 0 ? 34 : 32) / 2;
                    const int c = 2 * (gi % nch2) + (wave >> 2), bh = gi / nch2;
                    ret_c3_unit(p, l, bh, c, wave & 3, lane);
                }
            }
            }
        }
        SEAM(pb + 5);
        if (PHEN(7) && IN(pb + 6)) for (int rep = 0; rep < REPS(7); ++rep) { OPQ
            pg8::Gemm g{wsp<bf16_t>(p, WS_OCAT), wsp<bf16_t>(p, WS_WOUT) + (size_t)l * DM * DM, DM, DM, 0, 0, 0};
            const int Gg = gemm_cus((mrows / 256) * (DM / 256), G);
            pg8::TileOrder S; S.init(mrows / 256, DM / 256, Gg, bid, nullptr);
            if (bid < Gg) {
                if (l == 0) { pg8::EpiResid<true> E{p.in[I_X], p.in[I_CTX], wsp<bf16_t>(p, WS_X1), mod + 2 * DM}; pg8::gemm_phase<2>(lds, g, S, E, wave); }
                else { pg8::EpiResid<false> E{wsp<bf16_t>(p, WS_X1), wsp<bf16_t>(p, WS_X1) + (size_t)ML * DM, wsp<bf16_t>(p, WS_X1), mod + 2 * DM}; pg8::gemm_phase<2>(lds, g, S, E, wave); }
            }
            if (l == 0) { if (Gg >= G) { dense_items(p, lds, wave, lane, 2 * DI_PER_L + DI_GU_A, DI_ALL, gw, NGW); moe_convert(p, lds, wave, lane, CONV_C1, CONV_C2, gw, NGW); }
              else if (bid >= Gg) { dense_items(p, lds, wave, lane, 2 * DI_PER_L + DI_GU_A, DI_ALL, (bid - Gg) * 8 + wave, (G - Gg) * 8);
                  moe_convert_pipe(p, lds, wave, lane, CONV_C1, CONV_C2, (bid - Gg) * 8 + wave, (G - Gg) * 8); } }
        }
        SEAM(pb + 6);
        if (PHEN(8) && IN(pb + 7)) for (int rep = 0; rep < REPS(8); ++rep) { OPQ
            if (l == 0) {
                for (int row = 2 * gw; row < MT; row += 2 * NGW) {
                    const float* ma = mod + (size_t)(row < ML ? (row >> 12) : 4) * MODW;
                    norm_mod_row2<(FFN1_FP8 != 0), true>(wsp<bf16_t>(p, WS_X1) + (size_t)row * DM, p.in[I_NFFN] + l * DM, ma + 3 * DM, ma + 4 * DM, wsp<bf16_t>(p, WS_H) + (size_t)row * (FFN1_FP8 ? DM / 2 : DM), FFN1_FP8 ? DM / 2 : DM, lane);
                }
            } else {
                LAS float* rt = (LAS float*)lds;
                LAS int* lcnt = (LAS int*)(lds + 65536);
                LAS int* rinfo = (LAS int*)(lds + 65536 + 64);
                for (int i = tid; i < DM * 8; i += 512) rt[i] = p.in[I_MR][i];
                if (tid < 16) lcnt[tid] = 0;
                __syncthreads();
                for (int grp = bid; grp < ML / 64; grp += G) {
                    const float* mv = mod + (size_t)((grp * 64) >> 12) * MODW;
                    const u32x2* xr = (const u32x2*)(wsp<bf16_t>(p, WS_X1) + (size_t)(grp * 64 + wave * 8) * DM);
                    u32x2 xn[8]; f32x4 m1[8], sq[8];
#pragma unroll
                    for (int j = 0; j < 8; ++j) xn[j] = xr[lane + 64 * j];
#pragma unroll
                    for (int j = 0; j < 8; ++j) { const int c = lane + 64 * j; const f32x4 gq = *((const f32x4*)(p.in[I_NFFN] + l * DM) + c), aq = *((const f32x4*)(mv + 4 * DM) + c);
                        sq[j] = *((const f32x4*)(mv + 3 * DM) + c); m1[j] = gq * (aq + 1.0f); }
#pragma nounroll
                    for (int rr = 0; rr < 8; ++rr) {
                        const int rl = wave * 8 + rr, row = grp * 64 + rl;
                        f32x4 v[8];
#pragma unroll
                        for (int j = 0; j < 8; ++j) v[j] = (f32x4){bf_lo(xn[j].x), bf_hi(xn[j].x), bf_lo(xn[j].y), bf_hi(xn[j].y)};
                        if (rr < 7) { xr += DM / 4;
#pragma unroll
                            for (int j = 0; j < 8; ++j) xn[j] = xr[lane + 64 * j]; }
                        { float ss = 0.f;
#pragma unroll
                          for (int j = 0; j < 8; ++j) ss += (v[j].x * v[j].x + v[j].y * v[j].y) + (v[j].z * v[j].z + v[j].w * v[j].w);
                          const float rstd = 1.0f / sqrtf(wave_sum(ss) * (1.0f / DM) + EPS);
                          unsigned* orow = (unsigned*)(wsp<unsigned char>(p, WS_H) + (size_t)row * DM);
#pragma unroll
                          for (int j = 0; j < 8; ++j) { v[j] = (v[j] * rstd) * m1[j] + sq[j]; orow[lane + 64 * j] = pack_fp8x4(v[j].x, v[j].y, v[j].z, v[j].w); } }
                        float lg[8];
#pragma unroll
                        for (int e = 0; e < 8; ++e) lg[e] = 0.f;
#pragma unroll
                        for (int j = 0; j < 8; ++j)
#pragma unroll
                            for (int c = 0; c < 4; ++c) { const int k = 4 * (lane + 64 * j) + c; const f32x4 r0 = *(const LAS f32x4*)(rt + k * 8), r1 = *(const LAS f32x4*)(rt + k * 8 + 4); const float x = v[j][c];
                                lg[0] += x * r0.x; lg[1] += x * r0.y; lg[2] += x * r0.z; lg[3] += x * r0.w; lg[4] += x * r1.x; lg[5] += x * r1.y; lg[6] += x * r1.z; lg[7] += x * r1.w; }
#pragma unroll
                        for (int e = 0; e < 8; ++e) lg[e] = wave_sum(lg[e]);
                        int e0 = 0; float l0 = lg[0];
#pragma unroll
                        for (int e = 1; e < 8; ++e) if (lg[e] > l0) { l0 = lg[e]; e0 = e; }
                        int e1 = -1; float l1 = -__builtin_inff();
#pragma unroll
                        for (int e = 0; e < 8; ++e) if (e != e0 && lg[e] > l1) { l1 = lg[e]; e1 = e; }
                        if (lane == 0) {
                            const float g0 = 1.0f / (1.0f + __expf(l1 - l0));
                            const int r0 = __hip_atomic_fetch_add(lcnt + e0, 1, __ATOMIC_RELAXED, __HIP_MEMORY_SCOPE_WORKGROUP), r1 = __hip_atomic_fetch_add(lcnt + e1, 1, __ATOMIC_RELAXED, __HIP_MEMORY_SCOPE_WORKGROUP);
                            rinfo[rl * 8 + 0] = e0; rinfo[rl * 8 + 1] = e1; rinfo[rl * 8 + 2] = r0; rinfo[rl * 8 + 3] = r1; rinfo[rl * 8 + 4] = __float_as_int(g0); rinfo[rl * 8 + 5] = __float_as_int(1.0f - g0);
                        }
                    }
                    __syncthreads();
                    if (tid < 8) lcnt[8 + tid] = (int)__hip_atomic_fetch_add(wsp<unsigned>(p, WS_CTL) + CW_ECNT + 64 * tid, (unsigned)lcnt[tid], __ATOMIC_RELAXED, __HIP_MEMORY_SCOPE_AGENT);
                    __syncthreads();
                    if (tid < 64) { int* ro = wsp<int>(p, WS_ROUTE) + (size_t)(grp * 64 + tid) * 8; const int e0 = rinfo[tid * 8], e1 = rinfo[tid * 8 + 1];
                        ro[0] = e0; ro[1] = e1; ro[2] = lcnt[8 + e0] + rinfo[tid * 8 + 2]; ro[3] = lcnt[8 + e1] + rinfo[tid * 8 + 3]; ro[4] = rinfo[tid * 8 + 4]; ro[5] = rinfo[tid * 8 + 5]; }
                    __syncthreads();
                    if (tid < 8) lcnt[tid] = 0;
                    __syncthreads();
                }
            }
        }
        SEAM(pb + 7);
        if (l == 0) {
            if (PHEN(9) && IN(pb + 8)) for (int rep = 0; rep < REPS(9); ++rep) { OPQ
                pg8::TileOrder S; S.init(MT / 256, 2 * DFF / 256, G, bid, nullptr);
#if FFN2_FP8
                pg8::EpiSwiGLU8 E{wsp<unsigned char>(p, WS_ACT), DFF};
#else
                pg8::EpiSwiGLU E{wsp<bf16_t>(p, WS_ACT), DFF};
#endif
#if FFN1_FP8
                pg8::Gemm g{wsp<unsigned char>(p, WS_H), wsp<unsigned char>(p, WS_WGU), DM, DM, 0, 0x7f7f7f7f, 0x77777777};
                pg8::gemm_phase<1>(lds, g, S, E, wave);
#else
                pg8::Gemm g{wsp<bf16_t>(p, WS_H), wsp<bf16_t>(p, WS_WGU), DM, DM, 0, 0, 0};
                pg8::gemm_phase<2>(lds, g, S, E, wave);
#endif
                { const int fi = S.first_idle(); if (fi >= G) moe_convert(p, lds, wave, lane, CONV_C2, CONV_CF, gw, NGW);
                  else if (S.idle_last_round()) moe_convert(p, lds, wave, lane, CONV_C2, CONV_CF, (bid - fi) * 8 + wave, (G - fi) * 8); }
            }
            SEAM(pb + 8);
            if (PHEN(10) && IN(pb + 9)) for (int rep = 0; rep < REPS(10); ++rep) { OPQ
                const int Gg = gemm_cus((MT / 256) * (DM / 256), G);
                pg8::TileOrder S; S.init(MT / 256, DM / 256, Gg, bid, nullptr);
                pg8::EpiResid<false> E{wsp<bf16_t>(p, WS_X1), wsp<bf16_t>(p, WS_X1) + (size_t)ML * DM, wsp<bf16_t>(p, WS_X1), mod + 5 * DM};
#if FFN2_FP8
                pg8::Gemm g{wsp<unsigned char>(p, WS_ACT), wsp<unsigned char>(p, WS_WD), DFF, DFF, 0, 0x7f7f7f7f, 0x77777777};
                if (bid < Gg) pg8::gemm_phase<1>(lds, g, S, E, wave);
#else
                pg8::Gemm g{wsp<bf16_t>(p, WS_ACT), wsp<bf16_t>(p, WS_WD), DFF, DFF, 0, 0, 0};
                if (bid < Gg) pg8::gemm_phase<2>(lds, g, S, E, wave);
#endif
                if (Gg >= G) { dense_items(p, lds, wave, lane, DI_PER_L, 2 * DI_PER_L, gw, NGW); moe_convert(p, lds, wave, lane, CONV_CF, CONV_C3, gw, NGW); }
                else if (bid >= Gg) { dense_items(p, lds, wave, lane, DI_PER_L, 2 * DI_PER_L, (bid - Gg) * 8 + wave, (G - Gg) * 8);
                    moe_convert_pipe(p, lds, wave, lane, CONV_CF, CONV_C3, (bid - Gg) * 8 + wave, (G - Gg) * 8); }
            }
            SEAM(pb + 9);
        } else {
            if (PHEN(9) && IN(pb + 8)) for (int rep = 0; rep < REPS(9); ++rep) { OPQ
                moe_convert(p, lds, wave, lane, CONV_C5, NCONV, gw, NGW);
                __syncthreads();
                moe_tables(p, tb, tid);
                for (int row = gw; row < ML; row += 4 * NGW) {
                    i32x4r rt4[4]; u32x4 v4[4][2];
#pragma unroll
                    for (int q = 0; q < 4; ++q) { const int rw = min(row + q * NGW, ML - 1);
                        rt4[q] = *(const i32x4r*)(wsp<int>(p, WS_ROUTE) + (size_t)rw * 8);
                        const u32x4* src = (const u32x4*)(wsp<unsigned char>(p, WS_H) + (size_t)rw * DM);
                        v4[q][0] = src[lane]; v4[q][1] = src[lane + 64]; }
#pragma unroll
                    for (int q = 0; q < 4; ++q) { const int rw = row + q * NGW;
                        if (rw < ML) {
                            int* ro = wsp<int>(p, WS_ROUTE) + (size_t)rw * 8;
                            const int s0 = tb[rt4[q].x] + rt4[q].z, s1 = tb[rt4[q].y] + rt4[q].w;
                            if (lane == 0) { ro[6] = s0; ro[7] = s1; }
                            u32x4* d0 = (u32x4*)(wsp<unsigned char>(p, WS_HS) + (size_t)s0 * DM); u32x4* d1 = (u32x4*)(wsp<unsigned char>(p, WS_HS) + (size_t)s1 * DM);
                            d0[lane] = v4[q][0]; d1[lane] = v4[q][0]; d0[lane + 64] = v4[q][1]; d1[lane + 64] = v4[q][1];
                        } }
                }
            }
            SEAM(pb + 8);
            if (PHEN(10) && IN(pb + 9)) for (int rep = 0; rep < REPS(10); ++rep) { OPQ
                if (!MK_ONE_LAUNCH) moe_tables(p, tb, tid);
                pg8::Gemm g{wsp<unsigned char>(p, WS_HS), wsp<unsigned char>(p, WS_MGU), DM, DM, (size_t)2 * DFF * DM, 0x7f7f7f7f, 0x77777777};
                pg8::TileOrder S; S.init(__builtin_amdgcn_readfirstlane(tb[8]), 2 * DFF / 256, G, bid, tb + 16);
                pg8::EpiSwiGLU8 E{wsp<unsigned char>(p, WS_ACT), DFF};
                pg8::gemm_phase<1>(lds, g, S, E, wave);
            }
            SEAM(pb + 9);
            if (PHEN(11) && IN(pb + 10)) { OPQ
                if (!MK_ONE_LAUNCH) moe_tables(p, tb, tid);
                { pg8::Gemm g{wsp<unsigned char>(p, WS_ACT), wsp<unsigned char>(p, WS_MD), DFF, DFF, (size_t)DM * DFF, 0x7f7f7f7f, 0x77777777};
                  pg8::TileOrder S; S.init(MAIN_RT, DM / 256, G, bid, tb + 16);
                  pg8::EpiBf16 E{wsp<bf16_t>(p, WS_YS), DM, 0};
                  pg8::gemm_phase<1>(lds, g, S, E, wave); }
                SEAM(pb + 10);
                const int ntail = (__builtin_amdgcn_readfirstlane(tb[8]) - MAIN_RT) * 8;
                if (bid < 2 * ntail) {
                    const int half = bid >= ntail ? 1 : 0, t = bid - half * ntail, pm = t >> 3;
                    const pg8::OneUnit S{pm, t & 7, __builtin_amdgcn_readfirstlane(tb[16 + MAIN_RT + pm]), 1};
                    const pg8::Gemm g{wsp<unsigned char>(p, WS_ACT) + (size_t)MAIN_RT * 256 * DFF + half * (DFF / 2), wsp<unsigned char>(p, WS_MD) + half * (DFF / 2), DFF, DFF / 2, (size_t)DM * DFF, 0x7f7f7f7f, 0x77777777, DFF};
                    float* P = wsp<float>(p, WS_SPLIT) + (size_t)t * 65536; unsigned* fl = wsp<unsigned>(p, WS_CTL) + CW_SPLIT + 64 * t;
                    if (half == 0) { pg8::EpiPartial E{P, fl}; pg8::gemm_phase<1>(lds, g, S, E, wave); }
                    else { pg8::EpiBf16Add E{wsp<bf16_t>(p, WS_YS) + (size_t)MAIN_RT * 256 * DM, DM, P, fl}; pg8::gemm_phase<1>(lds, g, S, E, wave);
                        if (tid == 0) __hip_atomic_fetch_add(wsp<unsigned>(p, WS_CTL) + CW_TAIL, 1u, __ATOMIC_RELAXED, __HIP_MEMORY_SCOPE_AGENT); }
                }
            }
            if (PHEN(12) && IN(pb + 11)) { OPQ
                if (!MK_ONE_LAUNCH) moe_tables(p, tb, tid);
                const int ntail = (__builtin_amdgcn_readfirstlane(tb[8]) - MAIN_RT) * 8;
                const int c0 = 2 * ntail <= G / 2 ? 2 * ntail : 0;
                if (bid >= c0) {
                    const int NGWf = (G - c0) * 8, gwf = (bid - c0) * 8 + wave;
#pragma nounroll
                    for (int pass = 0; pass < 2; ++pass) {
                        int nblk = 0;
                        if (pass) {
                            while ((int)__builtin_amdgcn_readfirstlane(__hip_atomic_load(wsp<unsigned>(p, WS_CTL) + CW_TAIL, __ATOMIC_RELAXED, __HIP_MEMORY_SCOPE_AGENT)) < min(ntail, G)) __builtin_amdgcn_s_sleep(16);
                            __builtin_amdgcn_fence(__ATOMIC_ACQUIRE, "agent");
                        }
                for (int row0 = gwf; row0 < ML; row0 += 8 * NGWf) {
                    i32x4r rt8[8];
#pragma unroll
                    for (int q = 0; q < 8; ++q) rt8[q] = *(const i32x4r*)(wsp<int>(p, WS_ROUTE) + (size_t)min(row0 + q * NGWf, ML - 1) * 8 + 4);
#pragma unroll
                    for (int q = 0; q < 8; ++q) { const int row = row0 + q * NGWf;
                        const int s0 = __builtin_amdgcn_readfirstlane(rt8[q].z), s1 = __builtin_amdgcn_readfirstlane(rt8[q].w);
                        const int blk = (row < ML && (s0 >= MAIN_RT * 256 || s1 >= MAIN_RT * 256)) ? 1 : 0; nblk += blk;
                        if (row < ML && blk == pass) {
                    const float g0 = __int_as_float(rt8[q].x), g1 = __int_as_float(rt8[q].y);
                    const u32x4* y0 = (const u32x4*)(wsp<bf16_t>(p, WS_YS) + (size_t)s0 * DM); const u32x4* y1 = (const u32x4*)(wsp<bf16_t>(p, WS_YS) + (size_t)s1 * DM);
                    const float* gv = mod + (size_t)(row >> 12) * MODW + 5 * DM;
                    const u32x4* xr = (const u32x4*)(wsp<bf16_t>(p, WS_X1) + (size_t)row * DM); float* orow = p.out + (size_t)row * DM;
#pragma unroll
                    for (int j = 0; j < 4; ++j) { const int c = lane + 64 * j; const u32x4 a = y0[c], bq = y1[c];
                        const u32x4 xw = xr[c]; const f32x4 x0 = (f32x4){bf_lo(xw.x), bf_hi(xw.x), bf_lo(xw.y), bf_hi(xw.y)}, x1 = (f32x4){bf_lo(xw.z), bf_hi(xw.z), bf_lo(xw.w), bf_hi(xw.w)}, gg0 = *((const f32x4*)gv + 2 * c), gg1 = *((const f32x4*)gv + 2 * c + 1);
                        f32x4 r0, r1;
                        r0.x = x0.x + gg0.x * (g0 * bf_lo(a.x) + g1 * bf_lo(bq.x)); r0.y = x0.y + gg0.y * (g0 * bf_hi(a.x) + g1 * bf_hi(bq.x));
                        r0.z = x0.z + gg0.z * (g0 * bf_lo(a.y) + g1 * bf_lo(bq.y)); r0.w = x0.w + gg0.w * (g0 * bf_hi(a.y) + g1 * bf_hi(bq.y));
                        r1.x = x1.x + gg1.x * (g0 * bf_lo(a.z) + g1 * bf_lo(bq.z)); r1.y = x1.y + gg1.y * (g0 * bf_hi(a.z) + g1 * bf_hi(bq.z));
                        r1.z = x1.z + gg1.z * (g0 * bf_lo(a.w) + g1 * bf_lo(bq.w)); r1.w = x1.w + gg1.w * (g0 * bf_hi(a.w) + g1 * bf_hi(bq.w));
                        *((f32x4*)orow + 2 * c) = r0; *((f32x4*)orow + 2 * c + 1) = r1; }
                        } }
                }
                        if (nblk == 0) break;
                    }
                }
            }
        }
    }
#undef IN
#undef SEAM
}

extern "C" void kernel_launch(void* const* d_in, const int* in_sizes, int n_in, void* d_out, int out_size, void* d_ws, size_t ws_size, hipStream_t stream) {
    static int grid = 0;
    if (grid == 0) {
        if (n_in != 28 || out_size != ML * DM || ws_size < WS_END) { fprintf(stderr, "kernel_launch: unexpected problem (n_in %d, out %d, ws %zu < %zu)\n", n_in, out_size, ws_size, (size_t)WS_END); grid = -1; return; }
        int dev = 0, cus = 0, per_cu = 0;
        if (hipGetDevice(&dev) != hipSuccess || hipDeviceGetAttribute(&cus, hipDeviceAttributeMultiprocessorCount, dev) != hipSuccess) { grid = -1; return; }
        if (hipFuncSetAttribute((const void*)fwd_kernel, hipFuncAttributeMaxDynamicSharedMemorySize, LDS_BYTES) != hipSuccess) { fprintf(stderr, "kernel_launch: hipFuncSetAttribute failed\n"); grid = -1; return; }
        if (hipOccupancyMaxActiveBlocksPerMultiprocessor(&per_cu, (const void*)fwd_kernel, 512, LDS_BYTES) != hipSuccess || per_cu < 1) { fprintf(stderr, "kernel_launch: occupancy query says %d\n", per_cu); }
        (void)hipGetLastError();
        grid = cus;
    }
    if (grid < 0) return;
    (void)hipMemsetAsync((char*)d_ws + WS_CTL, 0, CTL_BYTES, stream);
    Params prm{};
    for (int i = 0; i < 28; ++i) prm.in[i] = (const float*)d_in[i];
    prm.out = (float*)d_out; prm.ws = (unsigned char*)d_ws;
#if MK_ONE_LAUNCH
    prm.ph_lo = 0; prm.ph_hi = NPHASE + 1;
    hipLaunchKernelGGL(fwd_kernel, dim3(grid), dim3(512), LDS_BYTES, stream, prm);
#else
    for (int ph = 0; ph <= NPHASE; ++ph) {
        if (ph == 11 || ph == 12) continue;
        prm.ph_lo = ph; prm.ph_hi = ph + 1;
        hipLaunchKernelGGL(fwd_kernel, dim3(grid), dim3(512), LDS_BYTES, stream, prm);
    }
#endif
}
```

```cpp
#include <hip/hip_runtime.h>
#include <cstdio>
#include <cstdint>

#define LAS __attribute__((address_space(3)))
#define GAS __attribute__((address_space(1)))
typedef unsigned short bf16_t;
typedef short bf16x8 __attribute__((ext_vector_type(8)));
typedef float f32x2 __attribute__((ext_vector_type(2)));
typedef float f32x4 __attribute__((ext_vector_type(4)));
typedef float f32x16 __attribute__((ext_vector_type(16)));
typedef unsigned u32x2 __attribute__((ext_vector_type(2)));
typedef unsigned u32x4 __attribute__((ext_vector_type(4)));
typedef GAS unsigned gu32;
typedef int i32x4r __attribute__((ext_vector_type(4)));

#ifndef FFN1_FP8
#define FFN1_FP8 1
#endif
#ifndef FFN2_FP8
#define FFN2_FP8 1
#endif
#ifndef MK_ONE_LAUNCH
#define MK_ONE_LAUNCH 1
#endif

constexpr int DM = 2048, NB = 4, SEQ = 4096, CTXL = 256, KEYS = SEQ + CTXL;
constexpr int ML = NB * SEQ, MC = NB * CTXL, MT = ML + MC;
constexpr int INC = 4896, INCP = 5120, DFF = 7168, NEXP = 8, MODW = 6 * DM;
constexpr int MSLOT = 2 * ML + NEXP * 256;
constexpr float EPS = 1e-6f, LOG2E = 1.4426950408889634f;
constexpr int PC_AQ = 0, PC_AK = 512, PC_AV = 640, PC_BQ = 768, PC_BKV = 1152, PC_CQ = 1280, PC_CK = 1792, PC_CV = 2304, PC_CG = 2816,
              PC_DQ = 3328, PC_DK = 3840, PC_DV = 4352, PC_BKR = 4864;

constexpr size_t al256(size_t x) { return (x + 255) & ~(size_t)255; }
constexpr size_t WS_CTL = 0, CTL_BYTES = 1u << 20;
constexpr size_t WS_MOD = WS_CTL + CTL_BYTES;
constexpr size_t WS_ROPE64 = WS_MOD + al256((size_t)2 * 5 * MODW * 4);
constexpr size_t WS_ROPE32 = WS_ROPE64 + al256((size_t)SEQ * 32 * 2 * 4);
constexpr size_t WS_RKV = WS_ROPE32 + al256((size_t)SEQ * 16 * 2 * 4);
constexpr size_t WS_RPB = WS_RKV + al256((size_t)MT * 4);
constexpr size_t WS_ROUTE = WS_RPB + al256((size_t)2 * 8 * 15 * 128 * 4);
constexpr size_t WS_WIN = WS_ROUTE + al256((size_t)ML * 32);
constexpr size_t WS_WOUT = WS_WIN + al256((size_t)2 * INCP * DM * 2);
constexpr size_t WS_WUP = WS_WOUT + al256((size_t)2 * DM * DM * 2);
constexpr size_t WS_WGU = WS_WUP + al256((size_t)2 * 1792 * 512 * 2);
constexpr size_t WS_WD = WS_WGU + al256((size_t)2 * DFF * DM * 2);
constexpr size_t WS_MGU = WS_WD + al256((size_t)DM * DFF * 2);
constexpr size_t WS_MD = WS_MGU + al256((size_t)NEXP * 2 * DFF * DM * 2);
constexpr size_t WS_X1 = WS_MD + al256((size_t)NEXP * DM * DFF * 2);
constexpr size_t WS_H = WS_X1 + al256((size_t)MT * DM * 4);
constexpr size_t WS_P = WS_H + al256((size_t)MT * DM * 2);
constexpr size_t WS_UPRAW = WS_P + al256((size_t)MT * INCP * 2);
constexpr size_t WS_QA = WS_UPRAW + al256((size_t)MT * 1792 * 2);
constexpr size_t WS_KA = WS_QA + al256((size_t)MT * 512 * 2);
constexpr size_t WS_VTA = WS_KA + al256((size_t)NB * 2 * KEYS * 64 * 2);
constexpr size_t WS_QB = WS_VTA + al256((size_t)NB * 2 * KEYS * 64 * 2);
constexpr size_t WS_KB = WS_QB + al256((size_t)MT * 768 * 2);
constexpr size_t WS_VTB = WS_KB + al256((size_t)NB * 8 * KEYS * 96 * 2);
constexpr size_t HB64 = al256((size_t)NB * 8 * KEYS * 64 * 2);
constexpr size_t WS_QC = WS_VTB + HB64;
constexpr size_t WS_KC = WS_QC + al256((size_t)MT * 512 * 2);
constexpr size_t WS_KWF = WS_KC + HB64, WS_KWR = WS_KWF + HB64, WS_VTC = WS_KWR + HB64;
constexpr size_t WS_QD = WS_VTC + HB64;
constexpr size_t WS_KD = WS_QD + al256((size_t)MT * 512 * 2), WS_VTD = WS_KD + HB64;
constexpr size_t WS_KVST = WS_VTD + HB64;
constexpr size_t WS_SPREV = WS_KVST + al256((size_t)64 * 34 * 4096 * 4);
constexpr size_t WS_OCAT = WS_SPREV + al256((size_t)64 * 34 * 4096 * 2);
constexpr size_t WS_ACT = WS_OCAT + al256((size_t)MT * DM * 2);
constexpr size_t WS_HS = WS_ACT + al256((size_t)MSLOT * DFF * 2);
constexpr size_t WS_YS = WS_HS + al256((size_t)MSLOT * DM * 2);
constexpr size_t WS_SPLIT = WS_YS + al256((size_t)MSLOT * DM * 2);
constexpr size_t WS_RQ = WS_SPLIT + (size_t)64 * 65536 * 4;
constexpr size_t WS_END = WS_RQ + al256((size_t)MT * 4);
constexpr int CW_BAR = 4096;
constexpr int CW_Q = 8192;
constexpr int CW_ECNT = 16384;
constexpr int CW_SPLIT = 36864;
constexpr int CW_TAIL = 32768;

constexpr int RING_BYTES = 131072;
constexpr int MISC_OFF = 146432;
constexpr int LDS_BYTES = 147456;

__device__ __forceinline__ unsigned cvt_pk_bf16(float lo, float hi) { unsigned r; asm volatile("v_cvt_pk_bf16_f32 %0, %1, %2" : "=v"(r) : "v"(lo), "v"(hi)); return r; }
__device__ __forceinline__ float bf_lo(unsigned w) { return __uint_as_float(w << 16); }
__device__ __forceinline__ float bf_hi(unsigned w) { return __uint_as_float(w & 0xffff0000u); }
__device__ __forceinline__ float bf2f(bf16_t h) { return __uint_as_float((unsigned)h << 16); }
__device__ __forceinline__ float fexp2(float x) { return __builtin_amdgcn_exp2f(x); }
__device__ __forceinline__ float frcp(float x) { return __builtin_amdgcn_rcpf(x); }
__device__ __forceinline__ float silu_f(float g) { return g * frcp(1.0f + fexp2(-g * LOG2E)); }
__device__ __forceinline__ unsigned pack_fp8x4(float a, float b, float c, float d) {
    a = __builtin_amdgcn_fmed3f(a, -448.f, 448.f); b = __builtin_amdgcn_fmed3f(b, -448.f, 448.f); c = __builtin_amdgcn_fmed3f(c, -448.f, 448.f); d = __builtin_amdgcn_fmed3f(d, -448.f, 448.f);
    int w = 0; w = __builtin_amdgcn_cvt_pk_fp8_f32(a, b, w, false); w = __builtin_amdgcn_cvt_pk_fp8_f32(c, d, w, true); return (unsigned)w; }
#if 1
__device__ __forceinline__ float opaque_zero() { return 0.f; }
#else
__device__ __forceinline__ float opaque_zero() { float z; asm volatile("v_mov_b32 %0, 0" : "=v"(z)); return z; }
#endif
__device__ __forceinline__ float xhalf_max(float m) { const auto rr = __builtin_amdgcn_permlane32_swap(__float_as_uint(m), __float_as_uint(m), false, false); return fmaxf(__uint_as_float(rr[0]), __uint_as_float(rr[1])); }
__device__ __forceinline__ float xhalf_sum(float m) { const auto rr = __builtin_amdgcn_permlane32_swap(__float_as_uint(m), __float_as_uint(m), false, false); return __uint_as_float(rr[0]) + __uint_as_float(rr[1]); }
__device__ __forceinline__ int lnd_s(int x) { asm volatile("" : "+s"(x)); return x; }
__device__ __forceinline__ float shfl_idx(float x, int src) { return __int_as_float(__builtin_amdgcn_ds_bpermute(src << 2, __float_as_int(x))); }
__device__ __forceinline__ int lane_id_asm() { int l; asm volatile("v_mbcnt_lo_u32_b32 %0, -1, 0\n\tv_mbcnt_hi_u32_b32 %0, -1, %0" : "=v"(l)); return l; }
template <int N> __device__ __forceinline__ float dpp_ror(float v) { return __int_as_float(__builtin_amdgcn_update_dpp(0, __float_as_int(v), 0x120 + N, 0xf, 0xf, false)); }
__device__ __forceinline__ float row_sum16(float v) { v += dpp_ror<8>(v); v += dpp_ror<4>(v); v += dpp_ror<2>(v); v += dpp_ror<1>(v); return v; }
__device__ __forceinline__ float wave_sum(float v) {
    v = row_sum16(v);
    const float a = __int_as_float(__builtin_amdgcn_readlane(__float_as_int(v), 0)), b = __int_as_float(__builtin_amdgcn_readlane(__float_as_int(v), 16));
    const float c = __int_as_float(__builtin_amdgcn_readlane(__float_as_int(v), 32)), d = __int_as_float(__builtin_amdgcn_readlane(__float_as_int(v), 48));
    return (a + b) + (c + d);
}
__device__ __forceinline__ void row_bp(int row, int& b, int& p) { if (row < ML) { b = row >> 12; p = row & (SEQ - 1); } else { const int r = row - ML; b = r >> 8; p = SEQ + (r & (CTXL - 1)); } }
__device__ __forceinline__ int bp_row(int b, int p) { return p < SEQ ? b * SEQ + p : ML + b * CTXL + (p - SEQ); }
namespace pg8 {
constexpr int BM = 256, BK = 64, HALF = 128, HTB = HALF * BK * 2  , STAGE_BYTES = 8 * HTB, NXCD = 8, WGM = 8;
__host__ __device__ __forceinline__ int lds_byte(int r, int c) { const int st = (r >> 4) * 2 + (c >> 5), rr = r & 15, cc = c & 31, ob = rr * 64 + cc * 2; return st * 1024 + (ob ^ (((ob >> 9) & 1) << 5)); }
__host__ __device__ __forceinline__ void stage_rc(int b, int& R, int& C) { const int st = b / 1024, sb = b % 1024, swz = sb ^ (((sb >> 9) & 1) << 5); R = (st >> 1) * 16 + swz / 64; C = (st & 1) * 32 + (swz % 64) / 2; }
__host__ __device__ __forceinline__ int perm32(int rho) { const int n = rho >> 4, i = rho & 15; return 8 * (i >> 2) + 4 * n + (i & 3); }

struct Unit { int pm, pn, eb; };
struct Gemm { const void* A; const void* Bt; int lda, K; size_t bstride; int scaleA, scaleB; int ldb; };
typedef int i32x8 __attribute__((ext_vector_type(8)));
typedef int i32x4 __attribute__((ext_vector_type(4)));
__device__ __forceinline__ i32x8 cat8(bf16x8 lo, bf16x8 hi) { return __builtin_shufflevector(__builtin_bit_cast(i32x4, lo), __builtin_bit_cast(i32x4, hi), 0, 1, 2, 3, 4, 5, 6, 7); }

struct TileOrder {
    int nM, nN, nwg, G, c; const LAS int* tile_e;
    __device__ void init(int nM_, int nN_, int G_, int c_, const LAS int* te) { nM = nM_; nN = nN_; nwg = nM * nN; G = G_; c = c_; tile_e = te; }
    __device__ bool idle_last_round() const { const int R = (nwg + G - 1) / G; return c + (R - 1) * G >= nwg; }
    __device__ int first_idle() const { const int R = (nwg + G - 1) / G; return nwg - (R - 1) * G; }
    __device__ bool next(int i, Unit& u) const {
        const long L = (long)i * G + c; if (L >= nwg) return false;
        int wgid = (int)L; { const int q = nwg / NXCD, r = nwg % NXCD, xcd = wgid % NXCD, off = wgid / NXCD; wgid = (xcd < r ? xcd * (q + 1) : r * (q + 1) + (xcd - r) * q) + off; }
        const int nig = WGM * nN, gid = wgid / nig, fm = gid * WGM, gsz = (nM - fm) < WGM ? (nM - fm) : WGM;
        u.pm = fm + ((wgid % nig) % gsz); u.pn = (wgid % nig) / gsz; u.eb = tile_e ? __builtin_amdgcn_readfirstlane(tile_e[u.pm]) : 0; return true;
    }
};

struct EpiBf16 {
    static constexpr bool PERM = true;
    bf16_t* O; int ldc; int wt;
    __device__ __forceinline__ void operator()(const f32x4 (&acc)[2][2][4][2], const Unit& u, int wr, int wc, int fr, int fq) const {
        const int row0 = u.pm * BM + wr * 64 + fr, col0 = u.pn * BM + wc * 32 + 8 * fq;
        if (wt) {
            const __amdgpu_buffer_rsrc_t rs = __builtin_amdgcn_make_buffer_rsrc((void*)O, 0, 0x7ffffff0, 0x00020000);
#pragma unroll
            for (int ai = 0; ai < 2; ++ai)
#pragma unroll
                for (int m = 0; m < 4; ++m) { const int ob = ((row0 + ai * HALF + m * 16) * ldc + col0) * 2;
#pragma unroll
                    for (int bj = 0; bj < 2; ++bj) { const f32x4 v0 = acc[ai][bj][m][0], v1 = acc[ai][bj][m][1];
                        u32x4 w; w.x = cvt_pk_bf16(v0[0], v0[1]); w.y = cvt_pk_bf16(v0[2], v0[3]); w.z = cvt_pk_bf16(v1[0], v1[1]); w.w = cvt_pk_bf16(v1[2], v1[3]);
                        __builtin_amdgcn_raw_buffer_store_b128(w, rs, ob + bj * HALF * 2, 0, 16); } }
            return;
        }
#pragma unroll
        for (int ai = 0; ai < 2; ++ai)
#pragma unroll
            for (int m = 0; m < 4; ++m) { bf16_t* rowp = O + (size_t)(row0 + ai * HALF + m * 16) * ldc + col0;
#pragma unroll
                for (int bj = 0; bj < 2; ++bj) { const f32x4 v0 = acc[ai][bj][m][0], v1 = acc[ai][bj][m][1];
                    u32x4 w; w.x = cvt_pk_bf16(v0[0], v0[1]); w.y = cvt_pk_bf16(v0[2], v0[3]); w.z = cvt_pk_bf16(v1[0], v1[1]); w.w = cvt_pk_bf16(v1[2], v1[3]);
                    *(u32x4*)(rowp + bj * HALF) = w; } }
    }
};
struct EpiSwiGLU {
    static constexpr bool PERM = true;
    bf16_t* O; int ldc;
    __device__ __forceinline__ void operator()(const f32x4 (&acc)[2][2][4][2], const Unit& u, int wr, int wc, int fr, int fq) const {
        const int row0 = u.pm * BM + wr * 64 + fr, col0 = u.pn * HALF + wc * 32 + 8 * fq;
#pragma unroll
        for (int ai = 0; ai < 2; ++ai)
#pragma unroll
            for (int m = 0; m < 4; ++m) { bf16_t* rowp = O + (size_t)(row0 + ai * HALF + m * 16) * ldc + col0;
                float o[8];
#pragma unroll
                for (int n = 0; n < 2; ++n)
#pragma unroll
                    for (int j = 0; j < 4; ++j) o[n * 4 + j] = silu_f(acc[ai][0][m][n][j]) * acc[ai][1][m][n][j];
                u32x4 w; w.x = cvt_pk_bf16(o[0], o[1]); w.y = cvt_pk_bf16(o[2], o[3]); w.z = cvt_pk_bf16(o[4], o[5]); w.w = cvt_pk_bf16(o[6], o[7]);
                *(u32x4*)rowp = w; asm volatile("" ::: "memory"); }
    }
};
struct EpiSwiGLU8 {
    static constexpr bool PERM = true;
    unsigned char* O; int ldc;
    __device__ __forceinline__ void operator()(const f32x4 (&acc)[2][2][4][2], const Unit& u, int wr, int wc, int fr, int fq) const {
        const int row0 = u.pm * BM + wr * 64 + fr, col0 = u.pn * HALF + wc * 32 + 8 * fq;
#pragma unroll
        for (int ai = 0; ai < 2; ++ai)
#pragma unroll
            for (int m = 0; m < 4; ++m) { unsigned char* rowp = O + (size_t)(row0 + ai * HALF + m * 16) * ldc + col0;
                float o[8];
#pragma unroll
                for (int n = 0; n < 2; ++n)
#pragma unroll
                    for (int j = 0; j < 4; ++j) o[n * 4 + j] = silu_f(acc[ai][0][m][n][j]) * acc[ai][1][m][n][j];
                u32x2 w; w.x = pack_fp8x4(o[0], o[1], o[2], o[3]); w.y = pack_fp8x4(o[4], o[5], o[6], o[7]);
                *(u32x2*)rowp = w; asm volatile("" ::: "memory"); }
    }
};
template <bool BF32>
struct EpiResid {
    static constexpr bool PERM = true;
    const void* base_lat; const void* base_ctx; bf16_t* out; const float* gate;
    __device__ __forceinline__ void operator()(const f32x4 (&acc)[2][2][4][2], const Unit& u, int wr, int wc, int fr, int fq) const {
        const bool isctx = u.pm >= ML / BM;
        const char* base = isctx ? (const char*)base_ctx - (size_t)ML * DM * (BF32 ? 4 : 2) : (const char*)base_lat;
        const float* gv = gate + (size_t)(isctx ? 4 : (u.pm >> 4)) * MODW;
        const int col0 = u.pn * BM + wc * 32 + 8 * fq;
        f32x4 g[2][2];
#pragma unroll
        for (int bj = 0; bj < 2; ++bj)
#pragma unroll
            for (int n = 0; n < 2; ++n) g[bj][n] = *(const f32x4*)(gv + col0 + bj * HALF + n * 4);
        f32x4 bsf[BF32 ? 3 : 1][2][2]; u32x4 bsb[BF32 ? 1 : 3][2];
        const size_t off0 = (size_t)(u.pm * BM + wr * 64 + fr) * DM + col0;
#define ER_LOAD(q) do { const size_t off_ = off0 + (size_t)(((q) >> 2) * HALF + ((q) & 3) * 16) * DM; _Pragma("unroll") for (int bj = 0; bj < 2; ++bj) { \
            if constexpr (BF32) { _Pragma("unroll") for (int n = 0; n < 2; ++n) bsf[(q) % 3][bj][n] = *(const f32x4*)((const float*)base + off_ + bj * HALF + n * 4); } \
            else bsb[(q) % 3][bj] = *(const u32x4*)((const bf16_t*)base + off_ + bj * HALF); } } while (0)
        ER_LOAD(0); ER_LOAD(1);
#pragma unroll
        for (int q = 0; q < 8; ++q) {
            if (q + 2 < 8) ER_LOAD(q + 2);
            const int ai = q >> 2, m = q & 3; const size_t off = off0 + (size_t)(ai * HALF + m * 16) * DM;
#pragma unroll
            for (int bj = 0; bj < 2; ++bj) {
                f32x4 b0, b1;
                if constexpr (BF32) { b0 = bsf[q % 3][bj][0]; b1 = bsf[q % 3][bj][1]; }
                else { const u32x4 w = bsb[q % 3][bj]; b0 = (f32x4){bf_lo(w.x), bf_hi(w.x), bf_lo(w.y), bf_hi(w.y)}; b1 = (f32x4){bf_lo(w.z), bf_hi(w.z), bf_lo(w.w), bf_hi(w.w)}; }
                const f32x4 r0 = b0 + g[bj][0] * acc[ai][bj][m][0], r1 = b1 + g[bj][1] * acc[ai][bj][m][1];
                u32x4 o; o.x = cvt_pk_bf16(r0[0], r0[1]); o.y = cvt_pk_bf16(r0[2], r0[3]); o.z = cvt_pk_bf16(r1[0], r1[1]); o.w = cvt_pk_bf16(r1[2], r1[3]);
                *(u32x4*)(out + off + bj * HALF) = o; }
            asm volatile("" ::: "memory");
        }
#undef ER_LOAD
    }
};

struct OneUnit { int pm, pn, eb, valid; __device__ bool next(int i, Unit& u) const { if (i > 0 || !valid) return false; u.pm = pm; u.pn = pn; u.eb = eb; return true; } };
struct EpiPartial {
    static constexpr bool PERM = true;
    float* P; unsigned* flag;
    __device__ __forceinline__ void operator()(const f32x4 (&acc)[2][2][4][2], const Unit& u, int wr, int wc, int fr, int fq) const {
        const int wv = wr * 4 + wc, ln = fq * 16 + fr;
        const __amdgpu_buffer_rsrc_t rs = __builtin_amdgcn_make_buffer_rsrc((void*)P, 0, 65536 * 4, 0x00020000);
#pragma unroll
        for (int ai = 0; ai < 2; ++ai)
#pragma unroll
            for (int bj = 0; bj < 2; ++bj)
#pragma unroll
                for (int m = 0; m < 4; ++m)
#pragma unroll
                    for (int n = 0; n < 2; ++n) { const int gi = ((ai * 2 + bj) * 4 + m) * 2 + n;
                        __builtin_amdgcn_raw_buffer_store_b128(__builtin_bit_cast(u32x4, acc[ai][bj][m][n]), rs, ((wv * 32 + gi) * 64 + ln) * 16, 0, 16); }
        asm volatile("s_waitcnt vmcnt(0)" ::: "memory");
        if (ln == 0) __hip_atomic_fetch_add(flag, 1u, __ATOMIC_RELAXED, __HIP_MEMORY_SCOPE_AGENT);
    }
};
struct EpiBf16Add {
    static constexpr bool PERM = true;
    bf16_t* O; int ldc; const float* P; unsigned* flag;
    __device__ __forceinline__ void operator()(const f32x4 (&acc)[2][2][4][2], const Unit& u, int wr, int wc, int fr, int fq) const {
        const int wv = wr * 4 + wc, ln = fq * 16 + fr;
        while (__builtin_amdgcn_readfirstlane(__hip_atomic_load(flag, __ATOMIC_RELAXED, __HIP_MEMORY_SCOPE_AGENT)) < 8u) __builtin_amdgcn_s_sleep(4);
        __builtin_amdgcn_fence(__ATOMIC_ACQUIRE, "agent");
        const f32x4* pp = (const f32x4*)P + (size_t)(wv * 32) * 64 + ln;
        const int row0 = u.pm * BM + wr * 64 + fr, col0 = u.pn * BM + wc * 32 + 8 * fq;
        const __amdgpu_buffer_rsrc_t rs = __builtin_amdgcn_make_buffer_rsrc((void*)O, 0, 0x7ffffff0, 0x00020000);
        f32x4 q[3][2][2];
#define EA_LOAD(g_) do { _Pragma("unroll") for (int bj = 0; bj < 2; ++bj) _Pragma("unroll") for (int n = 0; n < 2; ++n) \
            q[(g_) % 3][bj][n] = pp[(((((g_) >> 2) * 2 + bj) * 4 + ((g_) & 3)) * 2 + n) * 64]; } while (0)
        EA_LOAD(0); EA_LOAD(1);
#pragma unroll
        for (int g_ = 0; g_ < 8; ++g_) {
            if (g_ + 2 < 8) EA_LOAD(g_ + 2);
            const int ai = g_ >> 2, m = g_ & 3; const int ob = ((row0 + ai * HALF + m * 16) * ldc + col0) * 2;
#pragma unroll
            for (int bj = 0; bj < 2; ++bj) { const f32x4 v0 = acc[ai][bj][m][0] + q[g_ % 3][bj][0], v1 = acc[ai][bj][m][1] + q[g_ % 3][bj][1];
                u32x4 w; w.x = cvt_pk_bf16(v0[0], v0[1]); w.y = cvt_pk_bf16(v0[2], v0[3]); w.z = cvt_pk_bf16(v1[0], v1[1]); w.w = cvt_pk_bf16(v1[2], v1[3]);
                __builtin_amdgcn_raw_buffer_store_b128(w, rs, ob + bj * HALF * 2, 0, 16); }
            asm volatile("" ::: "memory");
        }
#undef EA_LOAD
    }
};

template <int ES  , class Epi, class Sched>
__device__ __forceinline__ void gemm_phase(LAS unsigned char* lds, const Gemm g, const Sched& S, const Epi& E, int wid) {
    const int lane = lane_id_asm(), tid = wid * 64 + lane, wr = wid >> 2, wc = wid & 3, fr = lane & 15, fq = lane >> 4;
    const int K = g.K, nt = K * ES / (BK * 2), lda = g.lda, ldb = g.ldb ? g.ldb : g.K;
    int sclA = g.scaleA, sclB = g.scaleB; asm volatile("" : "+v"(sclA), "+v"(sclB));
    unsigned voffA[2], voffB[2];
#pragma unroll
    for (int i = 0; i < 2; ++i) { int R, C; stage_rc(tid * 16 + i * 8192, R, C); const int Rb = Epi::PERM ? ((R & ~31) + perm32(R & 31)) : R;
        voffA[i] = (unsigned)(R * lda * ES + C * 2); voffB[i] = (unsigned)(Rb * ldb * ES + C * 2); }
    const size_t kstep = (size_t)(BK * 2);
    const size_t hstepA = (size_t)HALF * lda * ES, hstepB = (size_t)HALF * ldb * ES;
    const size_t tstepA = 2 * hstepA, tstepB = 2 * hstepB;
    const unsigned ldsw = (unsigned)wid * 1024u;
    const int aoff = lds_byte(wr * 64 + fr, fq * 8), boff = lds_byte(wc * 32 + fr, fq * 8);
#define PG8_SA(b, h) (((b) * 2 + (h)) * HTB)
#define PG8_SB(b, h) ((4 + (b) * 2 + (h)) * HTB)
#define PG8_STAGE(bufoff, gbase, voff) do { _Pragma("unroll") for (int _i = 0; _i < 2; ++_i) \
        __builtin_amdgcn_global_load_lds((const GAS unsigned*)((const char*)(gbase) + (voff)[_i]), (LAS unsigned*)(lds + (bufoff) + ldsw + _i * 8192), 16, 0, 0); } while (0)
#define PG8_LDA(dst, b, h) do { _Pragma("unroll") for (int m = 0; m < 4; ++m) _Pragma("unroll") for (int k = 0; k < 2; ++k) dst[m][k] = *(const LAS bf16x8*)(lds + PG8_SA(b, h) + aoff + m * 2048 + k * 1024); } while (0)
#define PG8_LDB(dst, b, h) do { _Pragma("unroll") for (int n = 0; n < 2; ++n) _Pragma("unroll") for (int k = 0; k < 2; ++k) dst[n][k] = *(const LAS bf16x8*)(lds + PG8_SB(b, h) + boff + n * 2048 + k * 1024); } while (0)
#define PG8_MMA(ai, bj, At, Bt) do { __builtin_amdgcn_s_setprio(1); _Pragma("unroll") for (int m = 0; m < 4; ++m) _Pragma("unroll") for (int n = 0; n < 2; ++n) { \
        if constexpr (ES == 2) { _Pragma("unroll") for (int k = 0; k < 2; ++k) acc[ai][bj][m][n] = __builtin_amdgcn_mfma_f32_16x16x32_bf16(Bt[n][k], At[m][k], acc[ai][bj][m][n], 0, 0, 0); } \
        else { const i32x8 _a = cat8(Bt[n][0], Bt[n][1]), _b = cat8(At[m][0], At[m][1]); \
               asm volatile("v_mfma_scale_f32_16x16x128_f8f6f4 %0, %1, %2, %0, %3, %4 op_sel_hi:[0,0,0]" : "+v"(acc[ai][bj][m][n]) : "v"(_a), "v"(_b), "v"(sclB), "v"(sclA)); } } \
        __builtin_amdgcn_s_setprio(0); } while (0)
#define PG8_WAIT_V(n) asm volatile("s_waitcnt vmcnt(" #n ")" ::: "memory")
#define PG8_WAIT_L(n) asm volatile("s_waitcnt lgkmcnt(" #n ")" ::: "memory")
#define PG8_BAR __builtin_amdgcn_s_barrier()
#define PG8_SCHED __builtin_amdgcn_sched_barrier(0)
    Unit cur, nxt; int ui = 0;
    if (!S.next(0, cur)) return;
    f32x4 acc[2][2][4][2];
    float zr = opaque_zero();
#pragma unroll
    for (int a = 0; a < 2; ++a)
#pragma unroll
        for (int b = 0; b < 2; ++b)
#pragma unroll
            for (int m = 0; m < 4; ++m)
#pragma unroll
                for (int n = 0; n < 2; ++n) acc[a][b][m][n] = (f32x4){zr, zr, zr, zr};
    bf16x8 At[4][2], B0[2][2], B1[2][2];
    const char* cA = (const char*)g.A + (size_t)cur.pm * tstepA; const char* cB = (const char*)g.Bt + ((size_t)cur.eb * g.bstride) * ES + (size_t)cur.pn * tstepB;
    PG8_STAGE(PG8_SB(0, 0), cB, voffB); PG8_STAGE(PG8_SB(0, 1), cB + hstepB, voffB); PG8_STAGE(PG8_SA(0, 0), cA, voffA); PG8_STAGE(PG8_SA(0, 1), cA + hstepA, voffA);
    if (wr == 1) PG8_BAR;
    PG8_WAIT_V(2); PG8_BAR;
    PG8_STAGE(PG8_SB(1, 0), cB + kstep, voffB); PG8_STAGE(PG8_SA(1, 0), cA + kstep, voffA); PG8_STAGE(PG8_SB(1, 1), cB + hstepB + kstep, voffB);
    PG8_WAIT_V(6); PG8_BAR;
    for (;;) {
        const bool has_next = S.next(ui + 1, nxt);
        const char* nA = has_next ? (const char*)g.A + (size_t)nxt.pm * tstepA : cA;
        const char* nB = has_next ? (const char*)g.Bt + ((size_t)nxt.eb * g.bstride) * ES + (size_t)nxt.pn * tstepB : cB;
#pragma nounroll
        for (int t = 0; t < nt; t += 2) {
            const bool last = (t == nt - 2);
            const char* a1 = cA + (size_t)(t + 1) * kstep;
            const char* a2 = last ? nA : cA + (size_t)(t + 2) * kstep; const char* b2 = last ? nB : cB + (size_t)(t + 2) * kstep;
            const char* a3 = a2 + kstep; const char* b3 = b2 + kstep;
            PG8_LDB(B0, 0, 0); PG8_LDB(B1, 0, 1); PG8_SCHED; PG8_LDA(At, 0, 0); PG8_STAGE(PG8_SA(1, 1), a1 + hstepA, voffA);
            PG8_WAIT_V(8); PG8_WAIT_L(0); PG8_BAR; PG8_MMA(0, 0, At, B0); PG8_MMA(0, 1, At, B1); PG8_BAR; PG8_SCHED;
            PG8_LDA(At, 0, 1); PG8_STAGE(PG8_SB(0, 0), b2, voffB); PG8_STAGE(PG8_SB(0, 1), b2 + hstepB, voffB); PG8_STAGE(PG8_SA(0, 0), a2, voffA);
            PG8_WAIT_V(8); PG8_WAIT_L(0); PG8_BAR; PG8_MMA(1, 0, At, B0); PG8_MMA(1, 1, At, B1); PG8_BAR; PG8_SCHED;
            PG8_LDB(B0, 1, 0); PG8_LDB(B1, 1, 1); PG8_SCHED; PG8_LDA(At, 1, 0); PG8_STAGE(PG8_SA(0, 1), a2 + hstepA, voffA);
            PG8_WAIT_V(8); PG8_WAIT_L(0); PG8_BAR; PG8_MMA(0, 0, At, B0); PG8_MMA(0, 1, At, B1); PG8_BAR; PG8_SCHED;
            PG8_LDA(At, 1, 1); PG8_STAGE(PG8_SB(1, 0), b3, voffB); PG8_STAGE(PG8_SB(1, 1), b3 + hstepB, voffB); PG8_STAGE(PG8_SA(1, 0), a3, voffA);
            PG8_WAIT_V(8); PG8_WAIT_L(0); PG8_BAR; PG8_MMA(1, 0, At, B0); PG8_MMA(1, 1, At, B1); PG8_BAR; PG8_SCHED;
        }
        if (wr == 0) PG8_BAR;
        if constexpr (ES == 1) asm volatile("s_nop 15\n\ts_nop 15" ::: "memory");
        E(acc, cur, wr, wc, fr, fq);
        if (!has_next) break;
        zr = opaque_zero();
#pragma unroll
        for (int a = 0; a < 2; ++a)
#pragma unroll
            for (int b = 0; b < 2; ++b)
#pragma unroll
                for (int m = 0; m < 4; ++m)
#pragma unroll
                    for (int n = 0; n < 2; ++n) acc[a][b][m][n] = (f32x4){zr, zr, zr, zr};
        cur = nxt; cA = nA; cB = nB; ++ui;
        if (wr == 1) PG8_BAR;
    }
    PG8_WAIT_V(0);
    PG8_BAR;
#undef PG8_SA
#undef PG8_SB
#undef PG8_STAGE
#undef PG8_LDA
#undef PG8_LDB
#undef PG8_MMA
#undef PG8_WAIT_V
#undef PG8_WAIT_L
#undef PG8_BAR
#undef PG8_SCHED
}
}
#define XB_TMO      128
#define XB_XCNT(j)  (256  + 64 * (j))
#define XB_XSUB(j)  (1280 + 64 * (j))
#define XB_XGEN(j)  (2304 + 64 * (j))
#define XB_TOP      3328
#define XB_TOPGEN   3392
#define XCD_BAR_WORDS 3456
#define XB_SPIN_CAP (1u << 18)
__device__ __forceinline__ unsigned xb_ld(unsigned* p)              { return __hip_atomic_load(p, __ATOMIC_RELAXED, __HIP_MEMORY_SCOPE_AGENT); }
__device__ __forceinline__ unsigned xb_add(unsigned* p, unsigned v) { return __hip_atomic_fetch_add(p, v, __ATOMIC_RELAXED, __HIP_MEMORY_SCOPE_AGENT); }
__device__ __forceinline__ unsigned xb_xcc_id() { return (unsigned)__builtin_amdgcn_s_getreg((3 << 11) | 20) & 0xFu; }
#define XB_SPIN(cond, bar) do { unsigned _sp = 0; while (cond) { __builtin_amdgcn_s_sleep(1); \
    if ((++_sp & 255u) == 0u) { if (xb_ld(&(bar)[XB_TMO])) break; if (_sp > XB_SPIN_CAP) { atomicAdd(&(bar)[XB_TMO], 1u); break; } } } } while (0)
struct XcdBarrier { unsigned* bar; unsigned x; volatile LAS unsigned* st; };
__device__ __forceinline__ XcdBarrier xcd_barrier_post(unsigned* bar, volatile LAS unsigned* st, bool leader) {
    XcdBarrier b; b.bar = bar; b.x = xb_xcc_id(); b.st = st;
    if (leader) (void)xb_add(&bar[XB_XCNT(b.x)], 1u);
    return b;
}
__device__ __forceinline__ void xcd_barrier_complete(unsigned* bar, unsigned x, unsigned& nloc, unsigned& nx) {
    const unsigned G = gridDim.x * gridDim.y * gridDim.z;
    unsigned sum, cnt, mine, sp = 0u;
    for (;;) {
        sum = 0u; cnt = 0u; mine = 0u;
#pragma unroll
        for (unsigned j = 0; j < 16; ++j) { const unsigned c = xb_ld(&bar[XB_XCNT(j)]); sum += c; cnt += (c > 0u) ? 1u : 0u; mine = (j == x) ? c : mine; }
        if (sum == G) break;
        __builtin_amdgcn_s_sleep(1);
        if ((++sp & 255u) == 0u) { if (xb_ld(&bar[XB_TMO])) break; if (sp > XB_SPIN_CAP) { atomicAdd(&bar[XB_TMO], 1u); break; } }
    }
    nloc = mine > 0u ? mine : 1u; nx = cnt > 0u ? cnt : 1u;
}
__device__ __forceinline__ void xcd_barrier(const XcdBarrier& b, bool leader) {
    asm volatile("s_waitcnt vmcnt(0)" ::: "memory");
    __syncthreads();
    if (leader) {
        unsigned* bar = b.bar; unsigned bx = b.x;
        asm volatile("" : "+s"(bar), "+s"(bx));
        __builtin_amdgcn_s_waitcnt(0);
        unsigned nloc = b.st[0], nx = b.st[1];
        if (nloc == 0u) { xcd_barrier_complete(bar, bx, nloc, nx); b.st[0] = nloc; b.st[1] = nx; }
        const unsigned old = xb_add(&bar[XB_XSUB(bx)], 1u);
        const unsigned gen = old / nloc;
        if (old + 1u == (gen + 1u) * nloc) {
            __builtin_amdgcn_fence(__ATOMIC_RELEASE, "agent");
            asm volatile("s_waitcnt vmcnt(0)" ::: "memory");
            const unsigned og = xb_add(&bar[XB_TOP], 1u);
            const unsigned tg = og / nx;
            if (og + 1u == (tg + 1u) * nx) xb_add(&bar[XB_TOPGEN], 1u);
            else XB_SPIN(xb_ld(&bar[XB_TOPGEN]) == tg, bar);
            __builtin_amdgcn_fence(__ATOMIC_ACQUIRE, "agent");
            xb_add(&bar[XB_XGEN(bx)], 1u);
            asm volatile("s_waitcnt vmcnt(0)" ::: "memory");
        } else {
            XB_SPIN(xb_ld(&bar[XB_XGEN(bx)]) == gen, bar);
            __builtin_amdgcn_fence(__ATOMIC_ACQUIRE, "agent");
            asm volatile("s_waitcnt vmcnt(0)" ::: "memory");
        }
    }
    __syncthreads();
}

struct Params { const float* in[28]; float* out; unsigned char* ws; int ph_lo, ph_hi; };
enum { I_X = 0, I_C, I_CTX, I_CCTX, I_WADA, I_BADA, I_NMIX, I_NFFN, I_WIN, I_WOUT, I_AQN, I_AKN, I_ASINK, I_BQAN, I_BKVAN, I_BWUQ, I_BWUKV, I_BQN, I_BKN,
       I_CLD, I_DQN, I_DKN, I_DRPB, I_FGU, I_FD, I_MR, I_MGU, I_MD };
template <class T> __device__ __forceinline__ T* wsp(const Params& p, size_t off) { return (T*)(p.ws + off); }
typedef const __attribute__((address_space(4))) Params* KArg;
__device__ __forceinline__ Params load_params(KArg k) {
    asm volatile("" : "+s"(k));
    Params p;
#pragma unroll
    for (int i = 0; i < 28; ++i) p.in[i] = k->in[i];
    p.out = k->out; p.ws = k->ws; p.ph_lo = k->ph_lo; p.ph_hi = k->ph_hi; return p;
}

__device__ __forceinline__ int q_next(const Params& p, int q, int lane) {
    unsigned v = 0;
    if (lane == 0) v = __hip_atomic_fetch_add(wsp<unsigned>(p, WS_CTL) + CW_Q + 64 * q, 1u, __ATOMIC_RELAXED, __HIP_MEMORY_SCOPE_AGENT);
    return (int)__builtin_amdgcn_readfirstlane(v);
}

template <class RMap>
__device__ __forceinline__ void transpose_item(const float* W, int K, int N, bf16_t* WT, int ldt, const float* kgain, LAS float* scr, int item, int lane, RMap rmap) {
    const int nblk = N / 32, kb = item / nblk, nb = item % nblk, k0 = 64 * kb, n0 = 32 * nb;
#pragma unroll
    for (int i = 0; i < 32; ++i) { const int kk = 2 * i + (lane >> 5); float v = W[(size_t)(k0 + kk) * N + n0 + (lane & 31)]; if (kgain) v *= kgain[k0 + kk]; scr[kk * 33 + (lane & 31)] = v; }
    asm volatile("s_waitcnt lgkmcnt(0)" ::: "memory");
    const int c = lane & 7; const int drow = rmap(n0);
#pragma unroll
    for (int j = 0; j < 4; ++j) { const int n = (lane >> 3) + 8 * j; const LAS float* s = scr + (8 * c) * 33 + n;
        u32x4 o; o.x = cvt_pk_bf16(s[0 * 33], s[1 * 33]); o.y = cvt_pk_bf16(s[2 * 33], s[3 * 33]); o.z = cvt_pk_bf16(s[4 * 33], s[5 * 33]); o.w = cvt_pk_bf16(s[6 * 33], s[7 * 33]);
        *(u32x4*)(WT + (size_t)(drow + n) * ldt + k0 + 8 * c) = o; }
    asm volatile("s_waitcnt lgkmcnt(0)" ::: "memory");
}
template <class RMap>
__device__ __forceinline__ void transpose_item_fp8(const float* W, int K, int N, unsigned char* WT, LAS float* scr, int item, int lane, RMap rmap) {
    const int nblk = N / 32, kb = item / nblk, nb = item % nblk, k0 = 64 * kb, n0 = 32 * nb;
#pragma unroll 8
    for (int i = 0; i < 32; ++i) { const int kk = 2 * i + (lane >> 5); scr[kk * 33 + (lane & 31)] = W[(size_t)(k0 + kk) * N + n0 + (lane & 31)] * 256.0f; }
    asm volatile("s_waitcnt lgkmcnt(0)" ::: "memory");
    const int c = lane & 7; const int drow = rmap(n0);
#pragma unroll
    for (int j = 0; j < 4; ++j) { const int n = (lane >> 3) + 8 * j; const LAS float* s = scr + (8 * c) * 33 + n;
        u32x2 o; o.x = pack_fp8x4(s[0 * 33], s[1 * 33], s[2 * 33], s[3 * 33]); o.y = pack_fp8x4(s[4 * 33], s[5 * 33], s[6 * 33], s[7 * 33]);
        *(u32x2*)(WT + (size_t)(drow + n) * K + k0 + 8 * c) = o; }
    asm volatile("s_waitcnt lgkmcnt(0)" ::: "memory");
}
template <bool FP8, class RMap>
__device__ __forceinline__ void transpose_item64(const float* W, int K, int N, void* WT, LAS float* scr, int item, int lane, RMap rmap) {
    const int nblk = N / 64, kb = item / nblk, nb = item % nblk, k0 = 64 * kb, n0 = 64 * nb;
    f32x4 v[16];
    const float* src = W + (size_t)(k0 + (lane >> 4)) * N + n0 + 4 * (lane & 15);
#pragma unroll
    for (int i = 0; i < 16; ++i) v[i] = __builtin_nontemporal_load((const f32x4*)(src + (size_t)(4 * i) * N));
#pragma unroll
    for (int i = 0; i < 16; ++i) { LAS float* d = scr + ((lane >> 4) + 4 * i) * 65 + 4 * (lane & 15); d[0] = v[i].x; d[1] = v[i].y; d[2] = v[i].z; d[3] = v[i].w; }
    asm volatile("s_waitcnt lgkmcnt(0)" ::: "memory");
    const int c = lane & 7; const int drow = rmap(n0);
#pragma unroll
    for (int j = 0; j < 8; ++j) { const int n = (lane >> 3) + 8 * j; const LAS float* s = scr + (8 * c) * 65 + n;
        if constexpr (FP8) { u32x2 o; o.x = pack_fp8x4(s[0] * 256.f, s[65] * 256.f, s[130] * 256.f, s[195] * 256.f); o.y = pack_fp8x4(s[260] * 256.f, s[325] * 256.f, s[390] * 256.f, s[455] * 256.f);
            *(u32x2*)((unsigned char*)WT + (size_t)(drow + n) * K + k0 + 8 * c) = o; }
        else { u32x4 o; o.x = cvt_pk_bf16(s[0], s[65]); o.y = cvt_pk_bf16(s[130], s[195]); o.z = cvt_pk_bf16(s[260], s[325]); o.w = cvt_pk_bf16(s[390], s[455]);
            *(u32x4*)((bf16_t*)WT + (size_t)(drow + n) * K + k0 + 8 * c) = o; } }
    asm volatile("s_waitcnt lgkmcnt(0)" ::: "memory");
}
struct RmIdent { __device__ int operator()(int n0) const { return n0; } };
struct RmWin { __device__ int operator()(int n0) const { return n0 < 1280 ? n0 : (n0 < 1312 ? n0 - 1280 + PC_BKR : n0 - 32); } };
struct RmGateUp { __device__ int operator()(int n0) const { const int u = n0 < DFF ? n0 : n0 - DFF; return 256 * (u >> 7) + (n0 < DFF ? 0 : 128) + (u & 127); } };

constexpr int DI_IN = (DM / 64) * (INC / 32), DI_OUT = (DM / 64) * (DM / 32), DI_UQ = (384 / 64) * (768 / 32), DI_UKV = (128 / 64) * (1024 / 32);
constexpr int DI_GU = (DM / 64) * (2 * DFF / 64), DI_DN = (DFF / 64) * (DM / 64);
constexpr int DI_PER_L = DI_IN + DI_OUT + DI_UQ + DI_UKV, DI_ALL = 2 * DI_PER_L + DI_GU + DI_DN;
__device__ __forceinline__ void dense_items(const Params& p, LAS unsigned char* lds, int wave, int lane, int lo, int hi, int wi, int nw) {
    LAS float* scr = (LAS float*)(lds + wave * 16896);
    constexpr int I_IN = DI_IN, I_OUT = DI_OUT, I_UQ = DI_UQ, I_GU = DI_GU, I_DN = DI_DN, PER_L = DI_PER_L;
    for (int it = lo + wi; it < hi; it += nw) {
        int r = it;
        if (r < 2 * PER_L) { const int l = r / PER_L; r -= l * PER_L;
            if (r < I_IN) { transpose_item(p.in[I_WIN] + (size_t)l * DM * INC, DM, INC, wsp<bf16_t>(p, WS_WIN) + (size_t)l * INCP * DM, DM, nullptr, scr, r, lane, RmWin()); continue; } r -= I_IN;
            if (r < I_OUT) { transpose_item(p.in[I_WOUT] + (size_t)l * DM * DM, DM, DM, wsp<bf16_t>(p, WS_WOUT) + (size_t)l * DM * DM, DM, nullptr, scr, r, lane, RmIdent()); continue; } r -= I_OUT;
            if (r < I_UQ) { transpose_item(p.in[I_BWUQ] + (size_t)l * 384 * 768, 384, 768, wsp<bf16_t>(p, WS_WUP) + (size_t)l * 1792 * 512, 512, p.in[I_BQAN] + l * 384, scr, r, lane, RmIdent()); continue; } r -= I_UQ;
            transpose_item(p.in[I_BWUKV] + (size_t)l * 128 * 1024, 128, 1024, wsp<bf16_t>(p, WS_WUP) + (size_t)l * 1792 * 512 + (size_t)768 * 512 + 384, 512, p.in[I_BKVAN] + l * 128, scr, r, lane, RmIdent()); continue; }
        r -= 2 * PER_L;
        if (r < I_GU) { transpose_item64<(FFN1_FP8 != 0)>(p.in[I_FGU], DM, 2 * DFF, wsp<unsigned char>(p, WS_WGU), scr, r, lane, RmGateUp()); continue; } r -= I_GU;
#if FFN2_FP8
        if (r < I_DN) { transpose_item64<true>(p.in[I_FD], DFF, DM, wsp<unsigned char>(p, WS_WD), scr, r, lane, RmIdent()); continue; } r -= I_DN;
#else
        if (r < I_DN) { transpose_item64<false>(p.in[I_FD], DFF, DM, wsp<bf16_t>(p, WS_WD), scr, r, lane, RmIdent()); continue; } r -= I_DN;
#endif
    }
}
__device__ __forceinline__ void p0_prologue(const Params& p, LAS unsigned char* lds, int G, int vcu, int wave) {
    const int lane = lane_id_asm(), tid = wave * 64 + lane;
    {
        LAS float* sv = (LAS float*)lds;
        LAS float* red = (LAS float*)(lds + 5 * DM * 4);
        bool loaded = false;
        for (int u = blockIdx.x; u < 2 * (MODW / 128); u += G) {
            if (!loaded) { for (int i = tid; i < 5 * DM; i += 512) { const int v = i / DM, k = i % DM; const float cv = v < 4 ? p.in[I_C][v * DM + k] : p.in[I_CCTX][k]; sv[i] = cv / (1.0f + __expf(-cv)); } loaded = true; __syncthreads(); }
            const int l = u / (MODW / 128), n0 = (u % (MODW / 128)) * 128;
            int hi = lane >> 5, c4 = lane & 31; asm volatile("" : "+v"(hi), "+v"(c4));
            const float* W = p.in[I_WADA] + (size_t)l * DM * MODW + n0 + 4 * c4 + (size_t)hi * MODW;
            float a[5][4];
#pragma unroll
            for (int v = 0; v < 5; ++v) { a[v][0] = 0.f; a[v][1] = 0.f; a[v][2] = 0.f; a[v][3] = 0.f; }
#pragma unroll 16
            for (int k = wave * 256; k < wave * 256 + 256; k += 2) { const f32x4 w = __builtin_nontemporal_load((const f32x4*)(W + (size_t)k * MODW));
#pragma unroll
                for (int v = 0; v < 5; ++v) { const float s = sv[v * DM + k + hi]; a[v][0] += s * w.x; a[v][1] += s * w.y; a[v][2] += s * w.z; a[v][3] += s * w.w; } }
#pragma unroll
            for (int v = 0; v < 5; ++v) {
#pragma unroll
                for (int j = 0; j < 4; ++j) a[v][j] = xhalf_sum(a[v][j]);
                if (hi == 0) *(LAS f32x4*)(red + (wave * 5 + v) * 128 + 4 * c4) = (f32x4){a[v][0], a[v][1], a[v][2], a[v][3]}; }
            __syncthreads();
            for (int i = tid; i < 5 * 128; i += 512) { const int v = i / 128, n = i % 128; float s = 0.f;
#pragma unroll
                for (int w = 0; w < 8; ++w) s += red[(w * 5 + v) * 128 + n];
                wsp<float>(p, WS_MOD)[((size_t)l * 5 + v) * MODW + n0 + n] = s + p.in[I_BADA][(size_t)l * MODW + n0 + n]; }
            __syncthreads();
        }
        __syncthreads();
    }
    const int gw = vcu * 8 + wave, NGW = G * 8;
    const unsigned zu = __float_as_uint(opaque_zero());
    for (int i = gw * 64 + lane; i < SEQ * 48; i += NGW * 64) {
        const int t = i / 48, j = i % 48; const float rw = (float)(t >> 6), cl = (float)(t & 63);
        if (j < 32) { const float fr = __powf(10000.0f, -(float)(j & 15) / 16.0f); const float ang = (j < 16 ? rw : cl) * fr; const float s = __sinf(ang), c = __cosf(ang);
            wsp<float>(p, WS_ROPE64)[(t * 32 + j) * 2] = c; wsp<float>(p, WS_ROPE64)[(t * 32 + j) * 2 + 1] = s; }
        else { const int jj = j - 32; const float fr = __powf(10000.0f, -(float)(jj & 7) / 8.0f); const float ang = (jj < 8 ? rw : cl) * fr; const float s = __sinf(ang), c = __cosf(ang);
            wsp<float>(p, WS_ROPE32)[(t * 16 + jj) * 2] = c; wsp<float>(p, WS_ROPE32)[(t * 16 + jj) * 2 + 1] = s; }
    }
    for (int i = gw * 64 + lane; i < 2 * 8 * 15 * 128; i += NGW * 64) {
        const int lh = i / (15 * 128), r = i % (15 * 128), dr = r >> 7, dc = (r & 127) - 48;
        wsp<float>(p, WS_RPB)[i] = (dc >= 0 && dc < 31) ? p.in[I_DRPB][(size_t)lh * 15 * 31 + dr * 31 + dc] * LOG2E : 0.f;
    }
    for (int i = gw * 64 + lane; i < 2 * (INCP - INC) * DM / 8; i += NGW * 64) {
        const int l = i / ((INCP - INC) * DM / 8), r = i % ((INCP - INC) * DM / 8);
        *(u32x4*)(wsp<bf16_t>(p, WS_WIN) + ((size_t)l * INCP + INC) * DM + (size_t)r * 8) = (u32x4){zu, zu, zu, zu};
    }
    for (int i = gw * 64 + lane; i < 2 * (768 * 16 + 1024 * 48); i += NGW * 64) {
        const int l = i / (768 * 16 + 1024 * 48), r = i % (768 * 16 + 1024 * 48);
        bf16_t* base = wsp<bf16_t>(p, WS_WUP) + (size_t)l * 1792 * 512;
        bf16_t* d = r < 768 * 16 ? base + (size_t)(r / 16) * 512 + 384 + (r % 16) * 8 : base + (size_t)(768 + (r - 768 * 16) / 48) * 512 + ((r - 768 * 16) % 48) * 8;
        *(u32x4*)d = (u32x4){zu, zu, zu, zu};
    }
    dense_items(p, lds, wave, lane, 0, DI_PER_L, gw, NGW);
}

constexpr int CONV_GU = (DM / 64) * (2 * DFF / 64), CONV_DN = (DFF / 64) * (DM / 64), NCONV = NEXP * (CONV_GU + CONV_DN);
struct ConvItem { const float* src; unsigned char* dst; int N, K; };
__device__ __forceinline__ void moe_item_load(const Params& p, int r, int lane, ConvItem& it, f32x4 (&v)[16]) {
    const int e = r / (CONV_GU + CONV_DN); r -= e * (CONV_GU + CONV_DN);
    const bool gu = r < CONV_GU; const int item = gu ? r : r - CONV_GU;
    const int N = gu ? 2 * DFF : DM, K = gu ? DM : DFF;
    const float* W = gu ? p.in[I_MGU] + (size_t)e * DM * 2 * DFF : p.in[I_MD] + (size_t)e * DFF * DM;
    unsigned char* WT = gu ? wsp<unsigned char>(p, WS_MGU) + (size_t)e * 2 * DFF * DM : wsp<unsigned char>(p, WS_MD) + (size_t)e * DM * DFF;
    const int nblk = N / 64, kb = item / nblk, nb = item % nblk, k0 = 64 * kb, n0 = 64 * nb;
    const int drow = gu ? RmGateUp()(n0) : n0;
    it.src = W + (size_t)(k0 + (lane >> 4)) * N + n0 + 4 * (lane & 15); it.N = N; it.K = K;
    it.dst = WT + (size_t)drow * K + k0 + 8 * (lane & 7);
#pragma unroll
    for (int i = 0; i < 16; ++i) v[i] = __builtin_nontemporal_load((const f32x4*)(it.src + (size_t)(4 * i) * N));
}
__device__ __forceinline__ void moe_item_finish(const ConvItem& it, const f32x4 (&v)[16], LAS float* scr, int lane) {
#pragma unroll
    for (int i = 0; i < 16; ++i) { LAS float* d = scr + ((lane >> 4) + 4 * i) * 65 + 4 * (lane & 15); d[0] = v[i].x; d[1] = v[i].y; d[2] = v[i].z; d[3] = v[i].w; }
    asm volatile("s_waitcnt lgkmcnt(0)" ::: "memory");
    const int c = lane & 7;
#pragma unroll
    for (int j = 0; j < 8; ++j) { const int n = (lane >> 3) + 8 * j; const LAS float* s = scr + (8 * c) * 65 + n;
        u32x2 o; o.x = pack_fp8x4(s[0] * 256.f, s[65] * 256.f, s[130] * 256.f, s[195] * 256.f); o.y = pack_fp8x4(s[260] * 256.f, s[325] * 256.f, s[390] * 256.f, s[455] * 256.f);
        *(u32x2*)(it.dst + (size_t)n * it.K) = o; }
    asm volatile("s_waitcnt lgkmcnt(0)" ::: "memory");
}
__device__ __forceinline__ void moe_convert_pipe(const Params& p, LAS unsigned char* lds, int wave, int lane, int lo, int hi, int wi, int nw) {
    LAS float* scr = (LAS float*)(lds + wave * 16896);
    int r = lo + wi;
    if (r >= hi) return;
    ConvItem ia, ib; f32x4 va[16], vb[16];
    moe_item_load(p, r, lane, ia, va);
    for (;;) {
        const int rb = r + nw;
        if (rb < hi) moe_item_load(p, rb, lane, ib, vb);
        moe_item_finish(ia, va, scr, lane);
        if (rb >= hi) break;
        const int ra = rb + nw;
        if (ra < hi) moe_item_load(p, ra, lane, ia, va);
        moe_item_finish(ib, vb, scr, lane);
        if (ra >= hi) break;
        r = ra;
    }
}

__device__ __forceinline__ void moe_convert_item(const Params& p, LAS float* scr, int r, int lane) {
    const int e = r / (CONV_GU + CONV_DN); r -= e * (CONV_GU + CONV_DN);
    if (r < CONV_GU) transpose_item64<true>(p.in[I_MGU] + (size_t)e * DM * 2 * DFF, DM, 2 * DFF, wsp<unsigned char>(p, WS_MGU) + (size_t)e * 2 * DFF * DM, scr, r, lane, RmGateUp());
    else transpose_item64<true>(p.in[I_MD] + (size_t)e * DFF * DM, DFF, DM, wsp<unsigned char>(p, WS_MD) + (size_t)e * DM * DFF, scr, r - CONV_GU, lane, RmIdent());
}
__device__ __forceinline__ void moe_convert(const Params& p, LAS unsigned char* lds, int wave, int lane, int lo, int hi, int wi, int nw) {
    LAS float* scr = (LAS float*)(lds + wave * 16896);
    for (int r = lo + wi; r < hi; r += nw) moe_convert_item(p, scr, r, lane);
}

__device__ __forceinline__ f32x4 ldx4(const void* row, int c, bool xb) {
    if (xb) { const u32x2 w = *((const u32x2*)row + c); return (f32x4){bf_lo(w.x), bf_hi(w.x), bf_lo(w.y), bf_hi(w.y)}; }
    return *((const f32x4*)row + c);
}
template <bool FP8 = false, bool XB = false>
__device__ __forceinline__ void norm_mod_row(const void* xrow, const float* gain, const float* sh, const float* sc, bf16_t* orow, int lane, f32x4 (&v)[8]) {
    float ss = 0.f;
    f32x4 gq[8], aq[8], sq[8];
#pragma unroll
    for (int j = 0; j < 8; ++j) { const int c = lane + 64 * j; v[j] = ldx4(xrow, c, XB); gq[j] = *((const f32x4*)gain + c); aq[j] = *((const f32x4*)sc + c); sq[j] = *((const f32x4*)sh + c); }
#pragma unroll
    for (int j = 0; j < 8; ++j) ss += (v[j].x * v[j].x + v[j].y * v[j].y) + (v[j].z * v[j].z + v[j].w * v[j].w);
    const float rstd = 1.0f / sqrtf(wave_sum(ss) * (1.0f / DM) + EPS);
#pragma unroll
    for (int j = 0; j < 8; ++j) { const int c = lane + 64 * j; const f32x4 g = gq[j], a = aq[j], s = sq[j];
        v[j] = (v[j] * rstd * g) * (a + 1.0f) + s;
        if constexpr (FP8) { *((unsigned*)orow + c) = pack_fp8x4(v[j].x, v[j].y, v[j].z, v[j].w); }
        else { u32x2 w; w.x = cvt_pk_bf16(v[j].x, v[j].y); w.y = cvt_pk_bf16(v[j].z, v[j].w); *((u32x2*)orow + c) = w; } }
}
template <bool FP8 = false, bool XB = false>
__device__ __forceinline__ void norm_mod_row2(const void* xa, const float* gain, const float* sh, const float* sc, bf16_t* oa, int opitch_elems, int lane) {
    f32x4 va[8], vb[8], g[8], a[8], s[8];
#pragma unroll
    for (int j = 0; j < 8; ++j) { const int c = lane + 64 * j; va[j] = ldx4(xa, c, XB); vb[j] = ldx4((const char*)xa + (size_t)DM * (XB ? 2 : 4), c, XB);
        g[j] = *((const f32x4*)gain + c); a[j] = *((const f32x4*)sc + c); s[j] = *((const f32x4*)sh + c); }
    float sa = 0.f, sb = 0.f;
#pragma unroll
    for (int j = 0; j < 8; ++j) { sa += (va[j].x * va[j].x + va[j].y * va[j].y) + (va[j].z * va[j].z + va[j].w * va[j].w); sb += (vb[j].x * vb[j].x + vb[j].y * vb[j].y) + (vb[j].z * vb[j].z + vb[j].w * vb[j].w); }
    const float ra = 1.0f / sqrtf(wave_sum(sa) * (1.0f / DM) + EPS), rb = 1.0f / sqrtf(wave_sum(sb) * (1.0f / DM) + EPS);
    bf16_t* ob = oa + opitch_elems;
#pragma unroll
    for (int j = 0; j < 8; ++j) { const int c = lane + 64 * j; const f32x4 m1 = g[j] * (a[j] + 1.0f);
        const f32x4 ya = (va[j] * ra) * m1 + s[j], yb = (vb[j] * rb) * m1 + s[j];
        if constexpr (FP8) { *((unsigned*)oa + c) = pack_fp8x4(ya.x, ya.y, ya.z, ya.w); *((unsigned*)ob + c) = pack_fp8x4(yb.x, yb.y, yb.z, yb.w); }
        else { u32x2 w; w.x = cvt_pk_bf16(ya.x, ya.y); w.y = cvt_pk_bf16(ya.z, ya.w); *((u32x2*)oa + c) = w; w.x = cvt_pk_bf16(yb.x, yb.y); w.y = cvt_pk_bf16(yb.z, yb.w); *((u32x2*)ob + c) = w; } }
}
struct HeadKind { int src, nh; const float* gain; int rope; float scale; bf16_t* dst; int keymajor; };
__device__ __forceinline__ void prep_heads_load(const Params& p, const HeadKind& k, int row, int lane, u32x2 (&w)[2]) {
    const int g = lane >> 4, l16 = lane & 15;
    const bf16_t* prow = wsp<bf16_t>(p, WS_P) + (size_t)row * INCP + k.src + 4 * l16;
#pragma unroll
    for (int it = 0; it < 2; ++it) { const int h = min(4 * it + g, k.nh - 1); w[it] = *(const u32x2*)(prow + h * 64); }
}
__device__ __forceinline__ void prep_heads_compute(const Params& p, const HeadKind& k, int row, int lane, const u32x2 (&w)[2], const f32x4 (&rope)[2], const f32x4 gn) {
    const int g = lane >> 4, l16 = lane & 15;
    int b, pos; row_bp(row, b, pos);
    const bool dorope = k.rope && row < ML;
#pragma unroll
    for (int it = 0; it < 2; ++it) {
        const int h = 4 * it + g;
        if (4 * it < k.nh) {
            float x[4] = {bf_lo(w[it].x), bf_hi(w[it].x), bf_lo(w[it].y), bf_hi(w[it].y)};
            if (k.gain) {
                float ss = (x[0] * x[0] + x[1] * x[1]) + (x[2] * x[2] + x[3] * x[3]);
                ss = row_sum16(ss);
                const float r = 1.0f / sqrtf(ss * (1.0f / 64.0f) + EPS);
                x[0] *= r * gn.x; x[1] *= r * gn.y; x[2] *= r * gn.z; x[3] *= r * gn.w;
            }
            if (k.rope) {
                float y[4];
#pragma unroll
                for (int e = 0; e < 4; ++e) y[e] = dpp_ror<8>(x[e]);
                if (dorope) {
                    const float cs[8] = {rope[0].x, rope[0].y, rope[0].z, rope[0].w, rope[1].x, rope[1].y, rope[1].z, rope[1].w};
#pragma unroll
                    for (int e = 0; e < 4; ++e) { const float c = cs[2 * e], s = cs[2 * e + 1];
                        x[e] = l16 < 8 ? x[e] * c - y[e] * s : y[e] * s + x[e] * c; }
                }
            }
            if (h < k.nh) {
                u32x2 o; o.x = cvt_pk_bf16(x[0] * k.scale, x[1] * k.scale); o.y = cvt_pk_bf16(x[2] * k.scale, x[3] * k.scale);
                bf16_t* d = k.keymajor == 1 ? k.dst + (((size_t)(b * k.nh + h)) * (KEYS / 32) + (pos >> 5)) * 2048 + (l16 >> 1) * 256 + (pos & 31) * 8 + 4 * (l16 & 1)
                          : k.keymajor == 2 ? k.dst + (((size_t)(b * k.nh + h)) * (KEYS / 64) + (pos >> 6)) * 4096 + (l16 >> 1) * 512 + (pos & 63) * 8 + 4 * (l16 & 1)
                                            : k.dst + (size_t)row * (k.nh * 64) + h * 64 + 4 * l16;
                *(u32x2*)d = o;
            }
        }
    }
}

struct TrKind { const bf16_t* src; int spitch, scol, nh; const float* rowscale; int rope; float scale; int decay; bf16_t* dst; bf16_t* dst2; float lgf2, lgr2; int tiled; };
__device__ __forceinline__ void tr_store_tiled32(LAS bf16_t* scr, bf16_t* img, int lane) {
    unsigned w[32];
#pragma unroll
    for (int t = 0; t < 32; ++t) w[t] = (unsigned)scr[(2 * t) * 72 + lane] | ((unsigned)scr[(2 * t + 1) * 72 + lane] << 16);
#pragma unroll
    for (int q = 0; q < 8; ++q) *(u32x4*)(img + (q >> 2) * 2048 + ((q & 3) * 64 + lane) * 8) = (u32x4){w[4 * q], w[4 * q + 1], w[4 * q + 2], w[4 * q + 3]};
}
__device__ __forceinline__ void tr_store_tiled(LAS bf16_t* scr, bf16_t* img, int lane) {
    unsigned w[32];
#pragma unroll
    for (int t = 0; t < 32; ++t) w[t] = (unsigned)scr[(2 * t) * 72 + lane] | ((unsigned)scr[(2 * t + 1) * 72 + lane] << 16);
#pragma unroll
    for (int q = 0; q < 8; ++q) *(u32x4*)(img + (q * 64 + lane) * 8) = (u32x4){w[4 * q], w[4 * q + 1], w[4 * q + 2], w[4 * q + 3]};
}
__device__ __forceinline__ void tr_store(LAS bf16_t* scr, bf16_t* dst, int lane) {
    unsigned w[32];
#pragma unroll
    for (int t = 0; t < 32; ++t) w[t] = (unsigned)scr[(2 * t) * 72 + lane] | ((unsigned)scr[(2 * t + 1) * 72 + lane] << 16);
#pragma unroll
    for (int q = 0; q < 8; ++q) *(u32x4*)(dst + (size_t)lane * KEYS + 8 * q) = (u32x4){w[4 * q], w[4 * q + 1], w[4 * q + 2], w[4 * q + 3]};
}
__device__ __forceinline__ void prep_transpose_unit(const Params& p, const TrKind& k, int b, int h, int tt, LAS bf16_t* scr, int lane) {
    const int p0 = 64 * tt, c8 = lane & 7;
    const bool latent = p0 < SEQ;
    float x[8][8];
#pragma unroll
    for (int i = 0; i < 8; ++i) {
        const int tok = (lane >> 3) + 8 * i, row = bp_row(b, p0 + tok);
        const u32x4 w = *(const u32x4*)(k.src + (size_t)row * k.spitch + k.scol + h * (k.nh > 0 ? 64 : 128) + 8 * c8);
        const float rs = (k.rowscale ? k.rowscale[row] : 1.0f) * k.scale;
        x[i][0] = bf_lo(w.x) * rs; x[i][1] = bf_hi(w.x) * rs; x[i][2] = bf_lo(w.y) * rs; x[i][3] = bf_hi(w.y) * rs;
        x[i][4] = bf_lo(w.z) * rs; x[i][5] = bf_hi(w.z) * rs; x[i][6] = bf_lo(w.w) * rs; x[i][7] = bf_hi(w.w) * rs;
        if (k.rope) {
            float y[8];
#pragma unroll
            for (int e = 0; e < 8; ++e) y[e] = shfl_idx(x[i][e], lane ^ 4);
            if (latent) {
                const float* cs = wsp<float>(p, WS_ROPE64) + ((size_t)(p0 + tok) * 32 + 8 * (c8 & 3)) * 2;
#pragma unroll
                for (int e = 0; e < 8; ++e) { const float c = cs[2 * e], s = cs[2 * e + 1]; x[i][e] = c8 < 4 ? x[i][e] * c - y[e] * s : y[e] * s + x[i][e] * c; }
            }
        }
    }
    const int nh = k.nh > 0 ? k.nh : -k.nh;
    for (int pass = 0; pass < (k.decay ? 2 : 1); ++pass) {
#pragma unroll
        for (int i = 0; i < 8; ++i) {
            const int tok = (lane >> 3) + 8 * i; float wgt = 1.0f;
            if (k.decay) { const int pc = (p0 + tok) & 127; wgt = pass == 0 ? fexp2(k.lgf2 * (float)(127 - pc)) : fexp2(k.lgr2 * (float)pc); }
            u32x4 o; o.x = cvt_pk_bf16(x[i][0] * wgt, x[i][1] * wgt); o.y = cvt_pk_bf16(x[i][2] * wgt, x[i][3] * wgt); o.z = cvt_pk_bf16(x[i][4] * wgt, x[i][5] * wgt); o.w = cvt_pk_bf16(x[i][6] * wgt, x[i][7] * wgt);
            *(LAS u32x4*)(scr + tok * 72 + 8 * c8) = o;
        }
        asm volatile("s_waitcnt lgkmcnt(0)" ::: "memory");
        if (k.tiled == 1) tr_store_tiled(scr, k.dst + ((size_t)(b * nh + h) * (KEYS / 64) + tt) * 4096, lane);
        else tr_store_tiled32(scr, (pass == 0 ? k.dst : k.dst2) + ((size_t)(b * nh + h) * (KEYS / 32) + 2 * tt) * 2048, lane);
        asm volatile("s_waitcnt lgkmcnt(0)" ::: "memory");
    }
}

struct MlaRegs { unsigned cq[3], ckv; u32x2 wk[4]; f32x4 rope[2]; };
__device__ __forceinline__ void prep_mla_load(const Params& p, int row, int lane, MlaRegs& R) {
    const bf16_t* prow = wsp<bf16_t>(p, WS_P) + (size_t)row * INCP;
    const int g = lane >> 5, l32 = lane & 31; const bool act = l32 < 24; const int d0 = 4 * l32;
#pragma unroll
    for (int j = 0; j < 3; ++j) R.cq[j] = *(const unsigned*)(prow + PC_BQ + 2 * (lane + 64 * j));
    R.ckv = *(const unsigned*)(prow + PC_BKV + 2 * lane);
    const int dd = act ? d0 : 0;
#pragma unroll
    for (int i = 0; i < 4; ++i) { const int h = 2 * i + g;
        R.wk[i] = l32 < 16 || !act ? *(const u32x2*)(wsp<bf16_t>(p, WS_UPRAW) + (size_t)row * 1792 + 768 + h * 128 + dd) : *(const u32x2*)(prow + PC_BKR + (d0 - 64)); }
    { const int pos = row < ML ? (row & (SEQ - 1)) : 0;
      const float* cs = wsp<float>(p, WS_ROPE32) + ((size_t)pos * 16 + (d0 >= 64 && act ? (d0 - 64) & 15 : 0)) * 2; R.rope[0] = *(const f32x4*)cs; R.rope[1] = *(const f32x4*)(cs + 4); }
}
__device__ __forceinline__ void prep_mla_compute(const Params& p, int l, int row, int lane, const MlaRegs& R, const f32x4 gq, const f32x4 gk) {
    int b, pos; row_bp(row, b, pos);
    float sq = 0.f, skv = 0.f;
    {
#pragma unroll
      for (int j = 0; j < 3; ++j) { const float a = bf_lo(R.cq[j]), c = bf_hi(R.cq[j]); sq += a * a + c * c; }
      const float a = bf_lo(R.ckv), c = bf_hi(R.ckv); skv = a * a + c * c; }
    sq = wave_sum(sq); skv = wave_sum(skv);
    const float rq = 1.0f / sqrtf(sq * (1.0f / 384.0f) + EPS), rkv = 1.0f / sqrtf(skv * (1.0f / 128.0f) + EPS);
    if (lane == 0) { wsp<float>(p, WS_RKV)[row] = rkv; wsp<float>(p, WS_RQ)[row] = rq; }
    const int g = lane >> 5, l32 = lane & 31; const bool act = l32 < 24; const int d0 = 4 * l32;
    const bool latent = row < ML;
    const float qscale = 0.10206207261596575f * LOG2E;
    const float cs[8] = {R.rope[0].x, R.rope[0].y, R.rope[0].z, R.rope[0].w, R.rope[1].x, R.rope[1].y, R.rope[1].z, R.rope[1].w};
    const int plane = (lane & 32) | (l32 < 20 ? l32 + 4 : l32 - 4);
#pragma unroll
    for (int i4 = 0; i4 < 4; ++i4) {
        const int h = 2 * i4 + g;
        { float x[4] = {0.f, 0.f, 0.f, 0.f};
          if (act) { const u32x2 w = R.wk[i4]; const float sc = l32 < 16 ? rkv : 1.0f; x[0] = bf_lo(w.x) * sc; x[1] = bf_hi(w.x) * sc; x[2] = bf_lo(w.y) * sc; x[3] = bf_hi(w.y) * sc; }
          float ss = (x[0] * x[0] + x[1] * x[1]) + (x[2] * x[2] + x[3] * x[3]);
          ss = row_sum16(ss); ss += shfl_idx(ss, lane ^ 16);
          const float r = 1.0f / sqrtf(ss * (1.0f / 96.0f) + EPS);
          if (act) { const f32x4 gn = gk; x[0] *= r * gn.x; x[1] *= r * gn.y; x[2] *= r * gn.z; x[3] *= r * gn.w; }
          float y[4];
#pragma unroll
          for (int e = 0; e < 4; ++e) y[e] = shfl_idx(x[e], plane);
          if (latent && l32 >= 16 && act) {
#pragma unroll
              for (int e = 0; e < 4; ++e) { const float c = cs[2 * e], s = cs[2 * e + 1]; x[e] = l32 < 20 ? x[e] * c - y[e] * s : y[e] * s + x[e] * c; } }
          if (act) { u32x2 o; o.x = cvt_pk_bf16(x[0], x[1]); o.y = cvt_pk_bf16(x[2], x[3]);
              *(u32x2*)(wsp<bf16_t>(p, WS_KB) + ((((size_t)(b * 8 + h)) * (KEYS / 64) + (pos >> 6)) * 12 + (d0 >> 3)) * 512 + (pos & 63) * 8 + (d0 & 7)) = o; } }
    }
}
__device__ __forceinline__ int permkey(int m) { const int a = m >> 3, h = (m >> 2) & 1, c = m & 3; return 16 * (a >> 1) + 8 * h + c + 4 * (a & 1); }
__device__ __forceinline__ bf16x8 pack8(const f32x16& s, int o) {
    u32x4 w; w.x = cvt_pk_bf16(s[o], s[o + 1]); w.y = cvt_pk_bf16(s[o + 2], s[o + 3]); w.z = cvt_pk_bf16(s[o + 4], s[o + 5]); w.w = cvt_pk_bf16(s[o + 6], s[o + 7]);
    return __builtin_bit_cast(bf16x8, w);
}
template <bool GAIN, bool ROPE>
__device__ __forceinline__ void load_q_prepped(const bf16_t* qrow, const float* gain, const float* rope, float scale, int hi, bf16x8 (&qf)[4]) {
    u32x4 raw[4]; f32x4 gn[4][2], cs[2][4];
#pragma unroll
    for (int d0 = 0; d0 < 4; ++d0) raw[d0] = *(const u32x4*)(qrow + 16 * d0 + 8 * hi);
    if constexpr (GAIN) {
#pragma unroll
        for (int d0 = 0; d0 < 4; ++d0) { gn[d0][0] = *(const f32x4*)(gain + 16 * d0 + 8 * hi); gn[d0][1] = *(const f32x4*)(gain + 16 * d0 + 8 * hi + 4); } }
    if constexpr (ROPE) {
#pragma unroll
        for (int dd = 0; dd < 2; ++dd)
#pragma unroll
            for (int j = 0; j < 4; ++j) cs[dd][j] = *(const f32x4*)(rope + (16 * dd + 8 * hi) * 2 + 4 * j); }
    float x[4][8];
#pragma unroll
    for (int d0 = 0; d0 < 4; ++d0) { x[d0][0] = bf_lo(raw[d0].x); x[d0][1] = bf_hi(raw[d0].x); x[d0][2] = bf_lo(raw[d0].y); x[d0][3] = bf_hi(raw[d0].y);
        x[d0][4] = bf_lo(raw[d0].z); x[d0][5] = bf_hi(raw[d0].z); x[d0][6] = bf_lo(raw[d0].w); x[d0][7] = bf_hi(raw[d0].w); }
    if constexpr (GAIN) {
        float ss = 0.f;
#pragma unroll
        for (int d0 = 0; d0 < 4; ++d0)
#pragma unroll
            for (int e = 0; e < 8; e += 2) ss += x[d0][e] * x[d0][e] + x[d0][e + 1] * x[d0][e + 1];
        ss = xhalf_sum(ss);
        const float r = 1.0f / sqrtf(ss * (1.0f / 64.0f) + EPS);
#pragma unroll
        for (int d0 = 0; d0 < 4; ++d0)
#pragma unroll
            for (int e = 0; e < 8; ++e) x[d0][e] *= r * gn[d0][e >> 2][e & 3];
    }
    if constexpr (ROPE) {
#pragma unroll
        for (int dd = 0; dd < 2; ++dd)
#pragma unroll
            for (int e = 0; e < 8; ++e) { const float c = cs[dd][e >> 1][2 * (e & 1)], s = cs[dd][e >> 1][2 * (e & 1) + 1]; const float lo = x[dd][e], up = x[dd + 2][e];
                x[dd][e] = lo * c - up * s; x[dd + 2][e] = lo * s + up * c; }
    }
#pragma unroll
    for (int d0 = 0; d0 < 4; ++d0) { u32x4 w; w.x = cvt_pk_bf16(x[d0][0] * scale, x[d0][1] * scale); w.y = cvt_pk_bf16(x[d0][2] * scale, x[d0][3] * scale);
        w.z = cvt_pk_bf16(x[d0][4] * scale, x[d0][5] * scale); w.w = cvt_pk_bf16(x[d0][6] * scale, x[d0][7] * scale); qf[d0] = __builtin_bit_cast(bf16x8, w); }
}
struct AttnArgs {
    const bf16_t* Q; int qpitch;
    const float* qgain; const float* qrope; float qscale;
    const bf16_t* K;
    const bf16_t* Vt;
    bf16_t* O; int opitch;
    int t0, t1, c0, c1;
    float sink2;
    int q0, qrow;
    const float* rpb;
};
template <int DQK, int MODE>
__device__ __forceinline__ void attn_wave(const AttnArgs& a, int lane) {
    constexpr int ND = DQK / 16;
    const int r32 = lane & 31, hi = lane >> 5;
    const float NEG = -__builtin_inff();
    bf16x8 qf[ND];
    load_q_prepped<true, MODE == 1>(a.Q + (size_t)r32 * a.qpitch, a.qgain, a.qrope + r32 * 64, a.qscale, hi, qf);
    static_assert(DQK == 64, "tiled 32-key images: K [8 chunks][32 rows][8], V^T [4 kc][64 d][8]");
    const __amdgpu_buffer_rsrc_t krs = __builtin_amdgcn_make_buffer_rsrc((void*)a.K, 0, 0x7ffffff0, 0x00020000), vrs = __builtin_amdgcn_make_buffer_rsrc((void*)a.Vt, 0, 0x7ffffff0, 0x00020000);
    const int klo = (hi * 256 + permkey(r32) * 8) * 2, vlo = ((hi * 64 + r32) * 8) * 2;
#define AW_K(t, d0) __builtin_bit_cast(bf16x8, __builtin_amdgcn_raw_buffer_load_b128(krs, klo, (t) * 4096 + (d0) * 1024, 0))
#define AW_V(t, s, d0) __builtin_bit_cast(bf16x8, __builtin_amdgcn_raw_buffer_load_b128(vrs, vlo, (t) * 4096 + (s) * 2048 + (d0) * 512, 0))
    f32x16 o0, o1; const float zr = opaque_zero();
#pragma unroll
    for (int r = 0; r < 16; ++r) { o0[r] = zr; o1[r] = zr; }
    float m_run = 0.f, l_run = 0.f;
    const int n1 = a.t1 - a.t0, n = n1 + (a.c1 - a.c0);
#define AW_TILE(ii) ((ii) < n1 ? a.t0 + (ii) : a.c0 + ((ii) - n1))
    bf16x8 kf[ND], vf[2][2], k1[ND], v1[2][2], k2[ND];
    { const int tA = AW_TILE(0), tB = AW_TILE(n > 1 ? 1 : 0), tC = AW_TILE(n > 2 ? 2 : n - 1);
#pragma unroll
      for (int d0 = 0; d0 < ND; ++d0) { kf[d0] = AW_K(tA, d0); k1[d0] = AW_K(tB, d0); k2[d0] = AW_K(tC, d0); }
#pragma unroll
      for (int d0 = 0; d0 < 2; ++d0)
#pragma unroll
          for (int s = 0; s < 2; ++s) { vf[d0][s] = AW_V(tA, s, d0); v1[d0][s] = AW_V(tB, s, d0); } }
    for (int i = 0; i < n; ++i) {
        const int cur = AW_TILE(i); const bool masked = i < n1;
        bf16x8 kn[ND], vn[2][2];
        { const int t2 = AW_TILE(i + 2 < n ? i + 2 : n - 1), t3 = AW_TILE(i + 3 < n ? i + 3 : n - 1);
#pragma unroll
          for (int d0 = 0; d0 < ND; ++d0) kn[d0] = AW_K(t3, d0);
#pragma unroll
          for (int d0 = 0; d0 < 2; ++d0)
#pragma unroll
              for (int s = 0; s < 2; ++s) vn[d0][s] = AW_V(t2, s, d0); }
        float bias[16];
        if (MODE == 2 && masked) {
            const int kr = cur >> 1, w = a.q0 + r32, cb = (cur & 1) * 32 + 8 * hi;
            const float* rp = a.rpb + (kr - a.qrow + 7) * 128 + (cb - w + 15 + 48);
#pragma unroll
            for (int r = 0; r < 16; ++r) bias[r] = rp[16 * (r >> 3) + (r & 7)];
        }
        f32x16 st;
#pragma unroll
        for (int r = 0; r < 16; ++r) st[r] = -m_run;
#pragma unroll
        for (int d0 = 0; d0 < ND; ++d0) st = __builtin_amdgcn_mfma_f32_32x32x16_bf16(kf[d0], qf[d0], st, 0, 0, 0);
        if (MODE == 1 && masked) {
            const int dt = cur * 32 - a.q0;
            if (dt <= -128 || dt >= 128) {
                const int dq = a.q0 + r32 - cur * 32 - 8 * hi;
#pragma unroll
                for (int r = 0; r < 16; ++r) { const int dd = dq - (16 * (r >> 3) + (r & 7)); if (dd > 128 || dd < -128) st[r] = NEG; }
            }
        }
        if (MODE == 2 && masked) {
            const int kr = cur >> 1, w = a.q0 + r32; const int cs = min(max(w - 8, 0), 48);
            const int cb = (cur & 1) * 32 + 8 * hi;
            const int c0 = cb - cs;
#pragma unroll
            for (int r = 0; r < 16; ++r) { const int o = 16 * (r >> 3) + (r & 7); st[r] = ((unsigned)(c0 + o) < 16u) ? st[r] + bias[r] : NEG; }
        }
        float mx = st[0];
#pragma unroll
        for (int r = 1; r < 16; ++r) mx = fmaxf(mx, st[r]);
        mx = xhalf_max(mx);
        if (__any(mx > 8.0f)) {
            const float d = fmaxf(mx, 0.f), f = fexp2(-d);
            m_run += d; l_run *= f;
#pragma unroll
            for (int r = 0; r < 16; ++r) { o0[r] *= f; o1[r] *= f; st[r] -= d; }
        }
        float ps = 0.f;
#pragma unroll
        for (int r = 0; r < 16; ++r) { st[r] = fexp2(st[r]); ps += st[r]; }
        l_run += ps;
        const bf16x8 p0 = pack8(st, 0), p1 = pack8(st, 8);
        o0 = __builtin_amdgcn_mfma_f32_32x32x16_bf16(vf[0][0], p0, o0, 0, 0, 0);
        o0 = __builtin_amdgcn_mfma_f32_32x32x16_bf16(vf[0][1], p1, o0, 0, 0, 0);
        o1 = __builtin_amdgcn_mfma_f32_32x32x16_bf16(vf[1][0], p0, o1, 0, 0, 0);
        o1 = __builtin_amdgcn_mfma_f32_32x32x16_bf16(vf[1][1], p1, o1, 0, 0, 0);
#pragma unroll
        for (int d0 = 0; d0 < ND; ++d0) { kf[d0] = k1[d0]; k1[d0] = k2[d0]; k2[d0] = kn[d0]; }
#pragma unroll
        for (int d0 = 0; d0 < 2; ++d0)
#pragma unroll
            for (int s = 0; s < 2; ++s) { vf[d0][s] = v1[d0][s]; v1[d0][s] = vn[d0][s]; }
    }
#undef AW_TILE
#undef AW_K
#undef AW_V
    l_run = xhalf_sum(l_run);
    if (a.sink2 != NEG) l_run += fexp2(a.sink2 - m_run);
    const float inv = 1.0f / l_run;
    bf16_t* orow = a.O + (size_t)r32 * a.opitch + 4 * hi;
#pragma unroll
    for (int g = 0; g < 4; ++g) {
        u32x2 w0, w1;
        w0.x = cvt_pk_bf16(o0[4 * g] * inv, o0[4 * g + 1] * inv); w0.y = cvt_pk_bf16(o0[4 * g + 2] * inv, o0[4 * g + 3] * inv);
        w1.x = cvt_pk_bf16(o1[4 * g] * inv, o1[4 * g + 1] * inv); w1.y = cvt_pk_bf16(o1[4 * g + 2] * inv, o1[4 * g + 3] * inv);
        *(u32x2*)(orow + 8 * g) = w0; *(u32x2*)(orow + 32 + 8 * g) = w1;
    }
}

__device__ __forceinline__ void ret_c1_unit(const Params& p, int chain, int c, int lane) {
    const int r32 = lane & 31, hi = lane >> 5, bh = chain >> 1, dir = chain & 1;
    const bf16_t* kw = wsp<bf16_t>(p, dir ? WS_KWR : WS_KWF) + ((size_t)bh * (KEYS / 32) + 4 * c) * 2048 + (hi * 64 + r32) * 8;
    const bf16_t* vt = wsp<bf16_t>(p, WS_VTC) + ((size_t)bh * (KEYS / 32) + 4 * c) * 2048 + (hi * 64 + r32) * 8;
    f32x16 acc[2][2]; const float zr = opaque_zero();
#pragma unroll
    for (int mi = 0; mi < 2; ++mi)
#pragma unroll
        for (int ni = 0; ni < 2; ++ni)
#pragma unroll
            for (int r = 0; r < 16; ++r) acc[mi][ni][r] = zr;
    bf16x8 af[8][2], bfr[8][2];
#pragma unroll
    for (int s = 0; s < 8; ++s)
#pragma unroll
        for (int mi = 0; mi < 2; ++mi) { af[s][mi] = *(const bf16x8*)(kw + (s >> 1) * 2048 + (s & 1) * 1024 + mi * 256); bfr[s][mi] = *(const bf16x8*)(vt + (s >> 1) * 2048 + (s & 1) * 1024 + mi * 256); }
#pragma unroll
    for (int s = 0; s < 8; ++s)
#pragma unroll
        for (int mi = 0; mi < 2; ++mi)
#pragma unroll
            for (int ni = 0; ni < 2; ++ni) acc[mi][ni] = __builtin_amdgcn_mfma_f32_32x32x16_bf16(af[s][mi], bfr[s][ni], acc[mi][ni], 0, 0, 0);
    float* out = wsp<float>(p, WS_KVST) + ((size_t)chain * 34 + c) * 4096;
#pragma unroll
    for (int mi = 0; mi < 2; ++mi)
#pragma unroll
        for (int ni = 0; ni < 2; ++ni)
#pragma unroll
            for (int g = 0; g < 4; ++g)
                *(f32x4*)(out + (size_t)(r32 + 32 * ni) * 64 + 32 * mi + 8 * g + 4 * hi) = (f32x4){acc[mi][ni][4 * g], acc[mi][ni][4 * g + 1], acc[mi][ni][4 * g + 2], acc[mi][ni][4 * g + 3]};
}
__device__ __forceinline__ void ret_c2(const Params& p, int l, int gtid, int gthreads) {
    for (int idx = gtid; idx < 64 * 4096; idx += gthreads) {
        const int chain = idx >> 12, e = idx & 4095, dir = chain & 1, h = (chain >> 1) & 7;
        const float lg = -__expf(p.in[I_CLD][(l * 2 + dir) * 8 + h]);
        const float dec = __expf(lg * 128.0f);
        const float* kv = wsp<float>(p, WS_KVST) + (size_t)chain * 34 * 4096 + e;
        bf16_t* sp = wsp<bf16_t>(p, WS_SPREV) + (size_t)chain * 34 * 4096 + e;
        float kvv[34];
#pragma unroll
        for (int st = 0; st < 34; ++st) { const int cc = dir == 0 ? (st < 2 ? 32 + st : st - 2) : 33 - st; kvv[st] = kv[(size_t)cc * 4096]; }
        float s = 0.f;
#pragma unroll
        for (int st = 0; st < 34; ++st) { const int cc = dir == 0 ? (st < 2 ? 32 + st : st - 2) : 33 - st; sp[(size_t)cc * 4096] = (bf16_t)(cvt_pk_bf16(s, 0.f) & 0xffffu); s = s * dec + kvv[st]; }
    }
}
__device__ __forceinline__ void ret_c3_unit(const Params& p, int l, int bh, int c, int qq, int lane) {
    const int r32 = lane & 31, hi = lane >> 5, b = bh >> 3, h = bh & 7;
    const int row0 = c < 32 ? b * SEQ + 128 * c + 32 * qq : ML + b * CTXL + 128 * (c - 32) + 32 * qq;
    const float lgf2 = -__expf(p.in[I_CLD][(l * 2 + 0) * 8 + h]) * LOG2E, lgr2 = -__expf(p.in[I_CLD][(l * 2 + 1) * 8 + h]) * LOG2E;
    bf16x8 qf[4];
    if (c < 32) load_q_prepped<false, true>(wsp<bf16_t>(p, WS_P) + (size_t)(row0 + r32) * INCP + PC_CQ + h * 64, nullptr, wsp<float>(p, WS_ROPE64) + (size_t)((row0 + r32) & (SEQ - 1)) * 64, 1.0f, hi, qf);
    else load_q_prepped<false, false>(wsp<bf16_t>(p, WS_P) + (size_t)(row0 + r32) * INCP + PC_CQ + h * 64, nullptr, nullptr, 1.0f, hi, qf);
    const bf16_t* kp = wsp<bf16_t>(p, WS_KC) + ((size_t)bh * (KEYS / 32) + 4 * c) * 2048 + hi * 256 + permkey(r32) * 8;
    const bf16_t* vp = wsp<bf16_t>(p, WS_VTC) + ((size_t)bh * (KEYS / 32) + 4 * c) * 2048 + (hi * 64 + r32) * 8;
    bf16x8 spa[2][2][4]; u32x2 gq0[4], gq1[4];
    { const bf16_t* gp0 = wsp<bf16_t>(p, WS_P) + (size_t)(row0 + r32) * INCP + PC_CG + h * 64 + 4 * hi;
#pragma unroll
      for (int dir = 0; dir < 2; ++dir) { const bf16_t* sp = wsp<bf16_t>(p, WS_SPREV) + (((size_t)(bh * 2 + dir)) * 34 + c) * 4096 + (size_t)r32 * 64 + 8 * hi;
#pragma unroll
          for (int s = 0; s < 4; ++s) { spa[dir][0][s] = *(const bf16x8*)(sp + 16 * s); spa[dir][1][s] = *(const bf16x8*)(sp + 32 * 64 + 16 * s); } }
#pragma unroll
      for (int g = 0; g < 4; ++g) { gq0[g] = *(const u32x2*)(gp0 + 8 * g); gq1[g] = *(const u32x2*)(gp0 + 32 + 8 * g); } }
    f32x16 o0, o1; const float zr = opaque_zero();
#pragma unroll
    for (int r = 0; r < 16; ++r) { o0[r] = zr; o1[r] = zr; }
    const int il = 32 * qq + r32;
#pragma unroll 1
    for (int kt = 0; kt < 4; ++kt) {
        f32x16 st;
#pragma unroll
        for (int r = 0; r < 16; ++r) st[r] = zr;
#pragma unroll
        for (int d0 = 0; d0 < 4; ++d0) { const bf16x8 kf = *(const bf16x8*)(kp + kt * 2048 + d0 * 512); st = __builtin_amdgcn_mfma_f32_32x32x16_bf16(kf, qf[d0], st, 0, 0, 0); }
        const int dq = il - 32 * kt - 8 * hi;
#pragma unroll
        for (int r = 0; r < 16; ++r) { const int dd = dq - (16 * (r >> 3) + (r & 7));
            const float dec = dd > 0 ? fexp2(lgf2 * (float)dd) : (dd == 0 ? 2.0f : fexp2(lgr2 * (float)(-dd)));
            st[r] *= dec; }
        const bf16x8 p0 = pack8(st, 0), p1 = pack8(st, 8);
        const bf16x8 v00 = *(const bf16x8*)(vp + kt * 2048), v01 = *(const bf16x8*)(vp + kt * 2048 + 1024), v10 = *(const bf16x8*)(vp + kt * 2048 + 256), v11 = *(const bf16x8*)(vp + kt * 2048 + 1024 + 256);
        o0 = __builtin_amdgcn_mfma_f32_32x32x16_bf16(v00, p0, o0, 0, 0, 0); o0 = __builtin_amdgcn_mfma_f32_32x32x16_bf16(v01, p1, o0, 0, 0, 0);
        o1 = __builtin_amdgcn_mfma_f32_32x32x16_bf16(v10, p0, o1, 0, 0, 0); o1 = __builtin_amdgcn_mfma_f32_32x32x16_bf16(v11, p1, o1, 0, 0, 0);
    }
#pragma unroll
    for (int dir = 0; dir < 2; ++dir) {
        f32x16 c0, c1;
#pragma unroll
        for (int r = 0; r < 16; ++r) { c0[r] = zr; c1[r] = zr; }
#pragma unroll
        for (int s = 0; s < 4; ++s) { c0 = __builtin_amdgcn_mfma_f32_32x32x16_bf16(spa[dir][0][s], qf[s], c0, 0, 0, 0); c1 = __builtin_amdgcn_mfma_f32_32x32x16_bf16(spa[dir][1][s], qf[s], c1, 0, 0, 0); }
        const float wgt = dir == 0 ? fexp2(lgf2 * (float)(il + 1)) : fexp2(lgr2 * (float)(128 - il));
#pragma unroll
        for (int r = 0; r < 16; ++r) { o0[r] += wgt * c0[r]; o1[r] += wgt * c1[r]; }
    }
    float ss = 0.f;
#pragma unroll
    for (int r = 0; r < 16; ++r) ss += o0[r] * o0[r] + o1[r] * o1[r];
    ss = xhalf_sum(ss);
    const float rstd = 1.0f / sqrtf(ss * (1.0f / 64.0f) + EPS);
    bf16_t* op = wsp<bf16_t>(p, WS_OCAT) + (size_t)(row0 + r32) * DM + 1024 + h * 64 + 4 * hi;
#pragma unroll
    for (int g = 0; g < 4; ++g) {
        const u32x2 g0 = gq0[g], g1 = gq1[g];
        u32x2 w0, w1;
        w0.x = cvt_pk_bf16(o0[4 * g] * rstd * silu_f(bf_lo(g0.x)), o0[4 * g + 1] * rstd * silu_f(bf_hi(g0.x))); w0.y = cvt_pk_bf16(o0[4 * g + 2] * rstd * silu_f(bf_lo(g0.y)), o0[4 * g + 3] * rstd * silu_f(bf_hi(g0.y)));
        w1.x = cvt_pk_bf16(o1[4 * g] * rstd * silu_f(bf_lo(g1.x)), o1[4 * g + 1] * rstd * silu_f(bf_hi(g1.x))); w1.y = cvt_pk_bf16(o1[4 * g + 2] * rstd * silu_f(bf_lo(g1.y)), o1[4 * g + 3] * rstd * silu_f(bf_hi(g1.y)));
        *(u32x2*)(op + 8 * g) = w0; *(u32x2*)(op + 32 + 8 * g) = w1;
    }
}
constexpr int MLA_KIMG = 12288, MLA_VIMG = 8192, MLA_NT = KEYS / 64, MLA_NS = 6, MLA_D = MLA_NS - 1, MLA_VOFF = MLA_NS * MLA_KIMG;
__device__ __forceinline__ void mla_dma_tile(const unsigned char* kimg, const unsigned char* vimg, LAS unsigned char* lds, int slot, int w, int lane) {
#pragma unroll
    for (int i = 0; i < 3; ++i) {
        const int j = w + 8 * i;
        if (j < 20) {
            const unsigned char* src = j < 12 ? kimg + j * 1024 + lane * 16 : vimg + (j - 12) * 1024 + lane * 16;
            LAS unsigned char* dst = j < 12 ? lds + slot * MLA_KIMG + j * 1024 : lds + MLA_VOFF + slot * MLA_VIMG + (j - 12) * 1024;
            __builtin_amdgcn_global_load_lds((const GAS unsigned*)src, (LAS unsigned*)dst, 16, 0, 0);
        }
    }
}
__device__ __forceinline__ void mla_unit(const Params& p, LAS unsigned char* lds, int bh, int qb, int tile0, int ntiles, int tid, const float* qgain  ) {
    const int lane = tid & 63, w = __builtin_amdgcn_readfirstlane(tid >> 6), r32 = lane & 31, hi = lane >> 5, b = bh >> 3, h = bh & 7;
    const bool late = w >= 4;
    const int row0 = (qb < 16 ? b * SEQ + 256 * qb : ML + b * CTXL) + 32 * w;
    const unsigned char* kimg = wsp<unsigned char>(p, WS_KB) + ((size_t)bh * MLA_NT + tile0) * MLA_KIMG;
    const unsigned char* vimg = wsp<unsigned char>(p, WS_VTB) + ((size_t)bh * MLA_NT + tile0) * MLA_VIMG;
    bf16x8 qf[6];
    { const bf16_t* qrow = wsp<bf16_t>(p, WS_UPRAW) + (size_t)(row0 + r32) * 1792 + h * 96 + 8 * hi;
      u32x4 raw[6]; f32x4 gn[6][2], cs[4];
#pragma unroll
      for (int d0 = 0; d0 < 6; ++d0) raw[d0] = *(const u32x4*)(qrow + 16 * d0);
      const float rq = wsp<float>(p, WS_RQ)[row0 + r32];
#pragma unroll
      for (int d0 = 0; d0 < 6; ++d0) { gn[d0][0] = *(const f32x4*)(qgain + 16 * d0 + 8 * hi); gn[d0][1] = *(const f32x4*)(qgain + 16 * d0 + 8 * hi + 4); }
      const bool latent = qb < 16;
      { const float* rp = wsp<float>(p, WS_ROPE32) + ((size_t)(latent ? ((row0 + r32) & (SEQ - 1)) : 0) * 16 + 8 * hi) * 2;
#pragma unroll
        for (int j = 0; j < 4; ++j) cs[j] = *(const f32x4*)(rp + 4 * j); }
      asm volatile("s_waitcnt vmcnt(0)" ::: "memory");
      float x[6][8]; float ss = 0.f;
#pragma unroll
      for (int d0 = 0; d0 < 6; ++d0) { x[d0][0] = bf_lo(raw[d0].x); x[d0][1] = bf_hi(raw[d0].x); x[d0][2] = bf_lo(raw[d0].y); x[d0][3] = bf_hi(raw[d0].y);
          x[d0][4] = bf_lo(raw[d0].z); x[d0][5] = bf_hi(raw[d0].z); x[d0][6] = bf_lo(raw[d0].w); x[d0][7] = bf_hi(raw[d0].w);
#pragma unroll
          for (int e = 0; e < 8; e += 2) ss += x[d0][e] * x[d0][e] + x[d0][e + 1] * x[d0][e + 1]; }
      ss = xhalf_sum(ss);
      const float r = rq / sqrtf(rq * rq * ss * (1.0f / 96.0f) + EPS);
#pragma unroll
      for (int d0 = 0; d0 < 6; ++d0)
#pragma unroll
          for (int e = 0; e < 8; ++e) x[d0][e] *= r * gn[d0][e >> 2][e & 3];
      if (latent) {
#pragma unroll
          for (int e = 0; e < 8; ++e) { const float c = cs[e >> 1][2 * (e & 1)], s = cs[e >> 1][2 * (e & 1) + 1]; const float lo = x[4][e], up = x[5][e];
              x[4][e] = lo * c - up * s; x[5][e] = lo * s + up * c; } }
      const float qscale = 0.10206207261596575f * LOG2E;
#pragma unroll
      for (int d0 = 0; d0 < 6; ++d0) { u32x4 w; w.x = cvt_pk_bf16(x[d0][0] * qscale, x[d0][1] * qscale); w.y = cvt_pk_bf16(x[d0][2] * qscale, x[d0][3] * qscale);
          w.z = cvt_pk_bf16(x[d0][4] * qscale, x[d0][5] * qscale); w.w = cvt_pk_bf16(x[d0][6] * qscale, x[d0][7] * qscale); qf[d0] = __builtin_bit_cast(bf16x8, w); }
    }
#pragma unroll
    for (int i = 0; i < MLA_D; ++i) if (i < ntiles) mla_dma_tile(kimg + (size_t)i * MLA_KIMG, vimg + (size_t)i * MLA_VIMG, lds, i, w, lane);
    f32x16 o0, o1; const float zr = opaque_zero();
#pragma unroll
    for (int r = 0; r < 16; ++r) { o0[r] = zr; o1[r] = zr; }
    float m_run = 0.f, l_run = 0.f;
    if (ntiles >= MLA_D) { if (!late) asm volatile("s_waitcnt vmcnt(12)" ::: "memory"); else asm volatile("s_waitcnt vmcnt(8)" ::: "memory"); }
    else asm volatile("s_waitcnt vmcnt(0)" ::: "memory");
    __builtin_amdgcn_s_barrier();
    const int koff = (hi * 64 + permkey(r32)) * 16;
    const int voff = (hi * 64 + r32) * 16;
    bf16x8 kf[12];
#pragma unroll
    for (int d0 = 0; d0 < 6; ++d0) { kf[2 * d0] = *(const LAS bf16x8*)(lds + koff + d0 * 2048); kf[2 * d0 + 1] = *(const LAS bf16x8*)(lds + koff + d0 * 2048 + 512); }
    int slot = 0;
#define MLA_SEAM(t) do { if ((t) + MLA_D - 1 < ntiles) { if (!late) asm volatile("s_waitcnt vmcnt(9) lgkmcnt(0)" ::: "memory"); else asm volatile("s_waitcnt vmcnt(6) lgkmcnt(0)" ::: "memory"); } \
        else asm volatile("s_waitcnt vmcnt(0) lgkmcnt(0)" ::: "memory"); \
        __builtin_amdgcn_s_barrier(); \
        if ((t) + MLA_D < ntiles) mla_dma_tile(kimg + (size_t)((t) + MLA_D) * MLA_KIMG, vimg + (size_t)((t) + MLA_D) * MLA_VIMG, lds, slot == 0 ? MLA_NS - 1 : slot - 1, w, lane); } while (0)
    for (int t = 0; t < ntiles; ++t) {
        if (late) MLA_SEAM(t);
        f32x16 s0, s1;
#pragma unroll
        for (int r = 0; r < 16; ++r) { s0[r] = -m_run; s1[r] = -m_run; }
        __builtin_amdgcn_sched_barrier(0);
#pragma unroll
        for (int d0 = 0; d0 < 6; ++d0) {
            s0 = __builtin_amdgcn_mfma_f32_32x32x16_bf16(kf[2 * d0], qf[d0], s0, 0, 0, 0);
            s1 = __builtin_amdgcn_mfma_f32_32x32x16_bf16(kf[2 * d0 + 1], qf[d0], s1, 0, 0, 0);
        }
        __builtin_amdgcn_sched_barrier(0);
        if (!late) MLA_SEAM(t);
        const LAS unsigned char* vs = lds + MLA_VOFF + slot * MLA_VIMG + voff;
        const LAS unsigned char* ks = lds + (slot + 1 == MLA_NS ? 0 : slot + 1) * MLA_KIMG + koff;
        bf16x8 vf[8];
#pragma unroll
        for (int d0 = 0; d0 < 2; ++d0)
#pragma unroll
            for (int q = 0; q < 4; ++q) vf[d0 * 4 + q] = *(const LAS bf16x8*)(vs + q * 2048 + d0 * 512);
        if (t + 1 < ntiles) {
#pragma unroll
            for (int d0 = 0; d0 < 6; ++d0) { kf[2 * d0] = *(const LAS bf16x8*)(ks + d0 * 2048); kf[2 * d0 + 1] = *(const LAS bf16x8*)(ks + d0 * 2048 + 512); }
        }
        __builtin_amdgcn_sched_barrier(0);
        float mq[4];
#pragma unroll
        for (int r = 0; r < 4; ++r) mq[r] = fmaxf(s0[r], s1[r]);
#pragma unroll
        for (int r = 4; r < 16; ++r) mq[r & 3] = fmaxf(fmaxf(mq[r & 3], s0[r]), s1[r]);
        float mx = fmaxf(fmaxf(mq[0], mq[1]), fmaxf(mq[2], mq[3]));
        mx = xhalf_max(mx);
        if (__any(mx > 8.0f)) {
            const float d = fmaxf(mx, 0.f), f = fexp2(-d);
            m_run += d; l_run *= f;
#pragma unroll
            for (int r = 0; r < 16; ++r) { o0[r] *= f; o1[r] *= f; s0[r] -= d; s1[r] -= d; }
        }
        float pq[4] = {0.f, 0.f, 0.f, 0.f};
#define MLA_GRP(S, O, G, VA, VB) do { _Pragma("unroll") for (int r = (O); r < (O) + 8; ++r) { S[r] = fexp2(S[r]); pq[G] += S[r]; } \
            const bf16x8 pg = pack8(S, O); \
            o0 = __builtin_amdgcn_mfma_f32_32x32x16_bf16(vf[VA], pg, o0, 0, 0, 0); o1 = __builtin_amdgcn_mfma_f32_32x32x16_bf16(vf[VB], pg, o1, 0, 0, 0); } while (0)
        MLA_GRP(s0, 0, 0, 0, 4); MLA_GRP(s0, 8, 1, 1, 5); MLA_GRP(s1, 0, 2, 2, 6); MLA_GRP(s1, 8, 3, 3, 7);
#undef MLA_GRP
        l_run += (pq[0] + pq[1]) + (pq[2] + pq[3]);
        slot = slot + 1 == MLA_NS ? 0 : slot + 1;
    }
#undef MLA_SEAM
    l_run = xhalf_sum(l_run);
    const float inv = 1.0f / l_run;
    bf16_t* orow = wsp<bf16_t>(p, WS_OCAT) + (size_t)(row0 + r32) * DM + 512 + h * 64 + 4 * hi;
#pragma unroll
    for (int g = 0; g < 4; ++g) {
        u32x2 w0, w1;
        w0.x = cvt_pk_bf16(o0[4 * g] * inv, o0[4 * g + 1] * inv); w0.y = cvt_pk_bf16(o0[4 * g + 2] * inv, o0[4 * g + 3] * inv);
        w1.x = cvt_pk_bf16(o1[4 * g] * inv, o1[4 * g + 1] * inv); w1.y = cvt_pk_bf16(o1[4 * g + 2] * inv, o1[4 * g + 3] * inv);
        *(u32x2*)(orow + 8 * g) = w0; *(u32x2*)(orow + 32 + 8 * g) = w1;
    }
    asm volatile("s_waitcnt vmcnt(0) lgkmcnt(0)" ::: "memory");
}
__device__ __forceinline__ void moe_tables(const Params& p, LAS int* tb, int tid) {
    if (tid < NEXP)
        tb[160 + tid] = (int)__hip_atomic_load(wsp<unsigned>(p, WS_CTL) + CW_ECNT + 64 * tid, __ATOMIC_RELAXED, __HIP_MEMORY_SCOPE_AGENT);
    __syncthreads();
    if (tid == 0) {
        int base = 0;
        for (int e = 0; e < NEXP; ++e) {
            const int cnt = tb[160 + e];
            const int nt = (cnt + 255) >> 8; tb[e] = base * 256;
            int ev = e; asm volatile("" : "+v"(ev));
#pragma clang loop vectorize(disable) unroll(disable)
            for (int t = 0; t < nt; ++t) tb[16 + base + t] = ev;
            base += nt;
        }
        tb[8] = base;
    }
    __syncthreads();
}

__device__ __forceinline__ int gemm_cus(int nwg, int G) { const int R = (nwg + G - 1) / G; const int g = (((nwg + R - 1) / R) + 7) & ~7; return g < G ? g : G; }

constexpr int NPHASE = 24;
constexpr int MAIN_RT = 2 * ML / 256;
constexpr int CONV_C1 = 0, CONV_C2 = CONV_C1 + 7168, CONV_CF = CONV_C2 + 0  , CONV_C3 = CONV_CF + (FFN2_FP8 ? 22528 : 21504), CONV_C4 = CONV_C3 + 9216;
constexpr int DI_GU_A = 5632;
constexpr int CONV_WQG = 544;
constexpr int CONV_C5 = CONV_C4 + 2 * CONV_WQG * 32;
static_assert(CONV_C5 <= NCONV, "conversion shares");
__global__ void __launch_bounds__(512, 2) fwd_kernel(Params pk) {
    const KArg ka0 = (KArg)__builtin_amdgcn_kernarg_segment_ptr(); (void)pk;
    Params p = load_params(ka0);
    extern __shared__ __attribute__((aligned(16))) unsigned char lds_raw[];
    LAS unsigned char* lds = (LAS unsigned char*)lds_raw;
    volatile LAS unsigned* MISC = (volatile LAS unsigned*)(lds + MISC_OFF);
    const int wave_o = __builtin_amdgcn_readfirstlane((int)threadIdx.x >> 6);
    const int G_o = gridDim.x; const int vcu_o = (G_o % 8 == 0) ? ((int)blockIdx.x % 8) * (G_o / 8) + (int)blockIdx.x / 8 : (int)blockIdx.x;
    { const int t0 = threadIdx.x; if (t0 < 256) MISC[t0] = 0u; }
    __syncthreads();
    XcdBarrier bar; bar.bar = wsp<unsigned>(p, WS_CTL) + CW_BAR; bar.x = 0; bar.st = MISC + 8;
#if MK_ONE_LAUNCH
    bar = xcd_barrier_post(wsp<unsigned>(p, WS_CTL) + CW_BAR, MISC + 8, wave_o == 0 && lane_id_asm() == 0);
#endif
    const int lo = p.ph_lo, hi = p.ph_hi;
#define IN(k) (lo <= (k) && (k) < hi)
#ifndef PH_MASK
#define PH_MASK 0xffffffffu
#endif
#define PHEN(k) (((PH_MASK) >> (k)) & 1u)
#ifndef REP_MASK
#define REP_MASK 0u
#endif
#ifndef REP_LAYER
#define REP_LAYER -1
#endif
#define REPS(k) (1 + (int)((((REP_MASK) >> (k)) & 1u) && (REP_LAYER < 0 || l == REP_LAYER)))
#if MK_ONE_LAUNCH
#define SEAM(k) do { if (IN(k) && IN((k) + 1)) xcd_barrier(bar, wave_o == 0 && lane_id_asm() == 0); } while (0)
#else
#define SEAM(k) do { } while (0)
#endif
#ifdef NO_LWS
#define LAUNDER_WS
#else
#define LAUNDER_WS asm volatile("" : "+s"(p.ws))
#endif
#define OPQ Params p = load_params(ka0); const int lane = lane_id_asm(), wave = lnd_s(wave_o), tid = wave * 64 + lane, bid = lnd_s((int)blockIdx.x), G = lnd_s(G_o), vcu = lnd_s(vcu_o), gw = vcu * 8 + wave, NGW = G * 8; \
    (void)tid; (void)bid; (void)gw; (void)NGW; LAUNDER_WS; if (REP_MASK) __syncthreads();
    LAS int* tb = (LAS int*)(lds + MISC_OFF + 256);

    if (PHEN(0) && IN(0)) for (int rep = 0, l = 1; rep < REPS(0); ++rep) { OPQ p0_prologue(p, lds, G, vcu, wave); }
    SEAM(0);

#pragma unroll
    for (int l = 0; l < 2; ++l) {
        const int pb = 1 + 12 * l;
        const float* mod = wsp<float>(p, WS_MOD) + (size_t)l * 5 * MODW;
        const int mrows = l == 0 ? MT : ML;
        if (PHEN(1) && IN(pb + 0)) for (int rep = 0; rep < REPS(1); ++rep) { OPQ
            for (int row = 2 * gw; row < MT; row += 2 * NGW) {
                const float* ma = mod + (size_t)(row < ML ? (row >> 12) : 4) * MODW;
                if (l == 0) norm_mod_row2<false, false>(row < ML ? p.in[I_X] + (size_t)row * DM : p.in[I_CTX] + (size_t)(row - ML) * DM, p.in[I_NMIX] + l * DM, ma, ma + DM, wsp<bf16_t>(p, WS_H) + (size_t)row * DM, DM, lane);
                else norm_mod_row2<false, true>(wsp<bf16_t>(p, WS_X1) + (size_t)row * DM, p.in[I_NMIX] + l * DM, ma, ma + DM, wsp<bf16_t>(p, WS_H) + (size_t)row * DM, DM, lane);
            }
        }
        SEAM(pb + 0);
        if (PHEN(2) && IN(pb + 1)) for (int rep = 0; rep < REPS(2); ++rep) { OPQ
            pg8::Gemm g{wsp<bf16_t>(p, WS_H), wsp<bf16_t>(p, WS_WIN) + (size_t)l * INCP * DM, DM, DM, 0, 0, 0};
            pg8::TileOrder S; S.init(MT / 256, INCP / 256, G, bid, nullptr);
            pg8::EpiBf16 E{wsp<bf16_t>(p, WS_P), INCP};
            pg8::gemm_phase<2>(lds, g, S, E, wave);
            { const int fi = S.first_idle(); const bool all = fi >= G;
              if (all || S.idle_last_round()) { const int wi = all ? gw : (bid - fi) * 8 + wave, nw = all ? NGW : (G - fi) * 8;
                  if (l == 0) dense_items(p, lds, wave, lane, 2 * DI_PER_L, 2 * DI_PER_L + DI_GU_A, wi, nw);
                  moe_convert_pipe(p, lds, wave, lane, l == 0 ? 0 : CONV_C3, l == 0 ? CONV_C1 : CONV_C4, wi, nw); } }
        }
        SEAM(pb + 1);
        if (PHEN(3) && IN(pb + 2)) for (int rep = 0; rep < REPS(3); ++rep) { OPQ
#ifndef NO_UPG
            { pg8::Gemm g{wsp<bf16_t>(p, WS_P) + PC_BQ, wsp<bf16_t>(p, WS_WUP) + (size_t)l * 1792 * 512, INCP, 512, 0, 0, 0};
              pg8::TileOrder S; S.init(MT / 256, 7, G, bid, nullptr);
              pg8::EpiBf16 E{wsp<bf16_t>(p, WS_UPRAW), 1792};
              pg8::gemm_phase<2>(lds, g, S, E, wave); }
#endif
            __syncthreads();
#ifndef NO_HEADS
            { const int l16h = lane & 15;
              const f32x4 g_ak = *(const f32x4*)(p.in[I_AKN] + l * 64 + 4 * l16h), g_dk = *(const f32x4*)(p.in[I_DKN] + l * 64 + 4 * l16h), g_no = {1.f, 1.f, 1.f, 1.f};
            for (int row = gw; row < MT; row += 2 * NGW) {
                const int rb = row + NGW < MT ? row + NGW : row;
                const HeadKind kak{PC_AK, 2, p.in[I_AKN] + l * 64, 1, 1.0f, wsp<bf16_t>(p, WS_KA), 1};
                const HeadKind kck{PC_CK, 8, nullptr, 1, 0.125f, wsp<bf16_t>(p, WS_KC), 1};
                const HeadKind kdk{PC_DK, 8, p.in[I_DKN] + l * 64, 0, 1.0f, wsp<bf16_t>(p, WS_KD), 1};
                u32x2 w1[2], w3[2], w5[2], u1[2], u3[2], u5[2];
                f32x4 ra[2], rbp[2];
                { const float* ca = wsp<float>(p, WS_ROPE64) + ((size_t)(row < ML ? (row & (SEQ - 1)) : 0) * 32 + 4 * (l16h & 7)) * 2; ra[0] = *(const f32x4*)ca; ra[1] = *(const f32x4*)(ca + 4);
                  const float* cb = wsp<float>(p, WS_ROPE64) + ((size_t)(rb < ML ? (rb & (SEQ - 1)) : 0) * 32 + 4 * (l16h & 7)) * 2; rbp[0] = *(const f32x4*)cb; rbp[1] = *(const f32x4*)(cb + 4); }
                prep_heads_load(p, kak, row, lane, w1); prep_heads_load(p, kck, row, lane, w3); prep_heads_load(p, kdk, row, lane, w5);
                prep_heads_load(p, kak, rb, lane, u1); prep_heads_load(p, kck, rb, lane, u3); prep_heads_load(p, kdk, rb, lane, u5);
                prep_heads_compute(p, kak, row, lane, w1, ra, g_ak); prep_heads_compute(p, kck, row, lane, w3, ra, g_no); prep_heads_compute(p, kdk, row, lane, w5, ra, g_dk);
                prep_heads_compute(p, kak, rb, lane, u1, rbp, g_ak); prep_heads_compute(p, kck, rb, lane, u3, rbp, g_no); prep_heads_compute(p, kdk, rb, lane, u5, rbp, g_dk);
            } }
#endif
#ifndef NO_TR
            LAS bf16_t* scr = (LAS bf16_t*)(lds + wave * 16384);
            for (int u = (gw + NGW / 2) % NGW; u < NB * 68 * 26; u += NGW) {
                const int b = u / (68 * 26), r = u % (68 * 26), tt = r / 26, hh = r % 26;
                if (hh < 2) { const TrKind k{wsp<bf16_t>(p, WS_P), INCP, PC_AV, 2, nullptr, 0, 1.0f, 0, wsp<bf16_t>(p, WS_VTA), nullptr, 0.f, 0.f, 2}; prep_transpose_unit(p, k, b, hh, tt, scr, lane); }
                else if (hh < 10) { const TrKind k{wsp<bf16_t>(p, WS_P), INCP, PC_CV, 8, nullptr, 0, 1.0f, 0, wsp<bf16_t>(p, WS_VTC), nullptr, 0.f, 0.f, 2}; prep_transpose_unit(p, k, b, hh - 2, tt, scr, lane); }
                else if (hh < 18) { const TrKind k{wsp<bf16_t>(p, WS_P), INCP, PC_DV, 8, nullptr, 0, 1.0f, 0, wsp<bf16_t>(p, WS_VTD), nullptr, 0.f, 0.f, 2}; prep_transpose_unit(p, k, b, hh - 10, tt, scr, lane); }
                else { const int h = hh - 18;
                    const float lgf2 = -__expf(p.in[I_CLD][(l * 2 + 0) * 8 + h]) * LOG2E, lgr2 = -__expf(p.in[I_CLD][(l * 2 + 1) * 8 + h]) * LOG2E;
                    const TrKind k{wsp<bf16_t>(p, WS_P), INCP, PC_CK, 8, nullptr, 1, 0.125f, 1, wsp<bf16_t>(p, WS_KWF), wsp<bf16_t>(p, WS_KWR), lgf2, lgr2, 2}; prep_transpose_unit(p, k, b, h, tt, scr, lane); }
            }
#endif
        }
        SEAM(pb + 2);
        if (PHEN(4) && IN(pb + 3)) for (int rep = 0; rep < REPS(4); ++rep) { OPQ
            { const int l32m = lane & 31, d0m = l32m < 24 ? 4 * l32m : 0;
              const f32x4 gq = *(const f32x4*)(p.in[I_BQN] + l * 96 + d0m), gk = *(const f32x4*)(p.in[I_BKN] + l * 96 + d0m);
            for (int row = gw; row < MT; row += 2 * NGW) {
                const int rb = row + NGW < MT ? row + NGW : row;
                MlaRegs Ra, Rb; prep_mla_load(p, row, lane, Ra); prep_mla_load(p, rb, lane, Rb);
                prep_mla_compute(p, l, row, lane, Ra, gq, gk); prep_mla_compute(p, l, rb, lane, Rb, gq, gk);
            } }
            for (int u = (gw + NGW / 2) % NGW; u < 64 * 34; u += NGW) ret_c1_unit(p, u / 34, u % 34, lane);
        }
        SEAM(pb + 3);
        if (PHEN(5) && IN(pb + 4)) for (int rep = 0; rep < REPS(5); ++rep) { OPQ
            LAS bf16_t* scr = (LAS bf16_t*)(lds + wave * 16384);
            for (int u = gw; u < NB * 68 * 8; u += NGW) {
                const int b = u / (68 * 8), r = u % (68 * 8), tt = r / 8, h = r % 8;
                const TrKind k{wsp<bf16_t>(p, WS_UPRAW), 1792, 768 + 64, -8, wsp<float>(p, WS_RKV), 0, 1.0f, 0, wsp<bf16_t>(p, WS_VTB), nullptr, 0.f, 0.f, 1};
                prep_transpose_unit(p, k, b, h, tt, scr, lane);
            }
            ret_c2(p, l, vcu * 512 + tid, G * 512);
        }
        SEAM(pb + 4);
        if (PHEN(6) && IN(pb + 5)) for (int rep = 0; rep < REPS(6); ++rep) { OPQ
#ifndef REP_MLA
#define REP_MLA 1
#endif
#ifndef REP_WQ
#define REP_WQ 1
#endif
            for (int rep2 = 0; rep2 < REP_MLA; ++rep2)
            { const int nmla = NB * 8 * 16 + (l == 0 ? NB * 8 : 0);
              for (int u = vcu; u < nmla; u += G) {
                  if (u < NB * 8 * 16) mla_unit(p, lds, u >> 4, u & 15, 0, MLA_NT, tid, p.in[I_BQN] + l * 96);
                  else mla_unit(p, lds, u - NB * 8 * 16, 16, SEQ / 64, CTXL / 64, tid, p.in[I_BQN] + l * 96);
                  __builtin_amdgcn_s_barrier();
              } }
            const int nq = l == 0 ? 136 : 128;
            const int gD = NB * 8 * (nq / 8), gA = NB * 2 * (nq / 2), gC = NB * 8 * ((l == 0 ? 34 : 32) / 2);
            const int total = gD + gA + gC;
            const float NEG = -__builtin_inff();
            for (int rep3 = 0; rep3 < REP_WQ; ++rep3) {
            unsigned qpend = 0u;
            if (tid == 0) qpend = __hip_atomic_fetch_add(wsp<unsigned>(p, WS_CTL) + CW_Q + 64 * (l + 2 * rep + 4 * rep3), 1u, __ATOMIC_RELAXED, __HIP_MEMORY_SCOPE_AGENT);
            for (;;) {
                __syncthreads();
                if (tid == 0) { MISC[16] = qpend; qpend = __hip_atomic_fetch_add(wsp<unsigned>(p, WS_CTL) + CW_Q + 64 * (l + 2 * rep + 4 * rep3), 1u, __ATOMIC_RELAXED, __HIP_MEMORY_SCOPE_AGENT); }
                __syncthreads();
                const int qi = (int)MISC[16];
                if (qi >= 4 * max((total + 2) / 3, CONV_WQG)) break;
                if ((qi & 3) == 3) {
                    if ((qi >> 2) < CONV_WQG && rep3 == 0 && rep == 0) { const int r0 = CONV_C4 + l * CONV_WQG * 32 + (qi >> 2) * 32 + wave * 4; moe_convert_pipe(p, lds, wave, lane, r0, r0 + 4, 0, 1); }
                    continue;
                }
                int gi = 3 * (qi >> 2) + (qi & 3);
                if (gi >= total) continue;
                if (gi < gD + gA) {
                    int mixer, b, h, qb;
                    if (gi < gD) { mixer = 3; const int rg = gi % (nq / 8), bh = gi / (nq / 8); b = bh >> 3; h = bh & 7; qb = 8 * rg + wave; }
                    else { gi -= gD; mixer = 0; const int qp = gi % (nq / 2), bg = gi / (nq / 2); b = bg >> 1; h = 4 * (bg & 1) + (wave & 3); qb = 2 * qp + (wave >> 2); }
                    const int bh = b * 8 + h;
                    const bool cq = qb >= 128;
                    const int row0 = cq ? ML + b * CTXL + 32 * (qb - 128) : b * SEQ + 32 * qb;
                    AttnArgs a; a.c0 = 128; a.c1 = 136; a.sink2 = NEG; a.q0 = 0; a.qrow = 0; a.rpb = nullptr; a.opitch = DM; a.t0 = 0; a.t1 = 0; a.qpitch = INCP; a.qscale = 0.125f * LOG2E; a.qrope = nullptr;
                    if (mixer == 0) {
                        a.Q = wsp<bf16_t>(p, WS_P) + (size_t)row0 * INCP + PC_AQ + h * 64; a.qgain = p.in[I_AQN] + l * 64; if (!cq) a.qrope = wsp<float>(p, WS_ROPE64) + (size_t)(32 * qb) * 64;
                        a.K = wsp<bf16_t>(p, WS_KA) + (size_t)(b * 2 + (h >> 2)) * KEYS * 64; a.Vt = wsp<bf16_t>(p, WS_VTA) + (size_t)(b * 2 + (h >> 2)) * 64 * KEYS;
                        a.O = wsp<bf16_t>(p, WS_OCAT) + (size_t)row0 * DM + h * 64; a.sink2 = p.in[I_ASINK][l * 8 + h] * LOG2E;
                        if (!cq) { a.t0 = max(0, qb - 4); a.t1 = min(128, qb + 5); a.q0 = 32 * qb; attn_wave<64, 1>(a, lane); } else attn_wave<64, 0>(a, lane);
                    } else {
                        a.Q = wsp<bf16_t>(p, WS_P) + (size_t)row0 * INCP + PC_DQ + h * 64; a.qgain = p.in[I_DQN] + l * 64;
                        a.K = wsp<bf16_t>(p, WS_KD) + (size_t)bh * KEYS * 64; a.Vt = wsp<bf16_t>(p, WS_VTD) + (size_t)bh * 64 * KEYS;
                        a.O = wsp<bf16_t>(p, WS_OCAT) + (size_t)row0 * DM + 1536 + h * 64;
                        if (!cq) { const int gr = qb >> 1, rs = min(max(gr - 4, 0), 56); a.t0 = 2 * rs; a.t1 = a.t0 + 16; a.q0 = (qb & 1) * 32; a.qrow = gr; a.rpb = wsp<float>(p, WS_RPB) + (size_t)(l * 8 + h) * 15 * 128;
                            attn_wave<64, 2>(a, lane); } else attn_wave<64, 0>(a, lane);
                    }
                } else {
                    gi -= gD + gA;
                    const int nch2 = (l == 0 ? 34 : 32) / 2;
                    const int c = 2 * (gi % nch2) + (wave >> 2), bh = gi / nch2;
                    ret_c3_unit(p, l, bh, c, wave & 3, lane);
                }
            }
            }
        }
        SEAM(pb + 5);
        if (PHEN(7) && IN(pb + 6)) for (int rep = 0; rep < REPS(7); ++rep) { OPQ
            pg8::Gemm g{wsp<bf16_t>(p, WS_OCAT), wsp<bf16_t>(p, WS_WOUT) + (size_t)l * DM * DM, DM, DM, 0, 0, 0};
            const int Gg = gemm_cus((mrows / 256) * (DM / 256), G);
            pg8::TileOrder S; S.init(mrows / 256, DM / 256, Gg, bid, nullptr);
            if (bid < Gg) {
                if (l == 0) { pg8::EpiResid<true> E{p.in[I_X], p.in[I_CTX], wsp<bf16_t>(p, WS_X1), mod + 2 * DM}; pg8::gemm_phase<2>(lds, g, S, E, wave); }
                else { pg8::EpiResid<false> E{wsp<bf16_t>(p, WS_X1), wsp<bf16_t>(p, WS_X1) + (size_t)ML * DM, wsp<bf16_t>(p, WS_X1), mod + 2 * DM}; pg8::gemm_phase<2>(lds, g, S, E, wave); }
            }
            if (l == 0) { if (Gg >= G) { dense_items(p, lds, wave, lane, 2 * DI_PER_L + DI_GU_A, DI_ALL, gw, NGW); moe_convert(p, lds, wave, lane, CONV_C1, CONV_C2, gw, NGW); }
              else if (bid >= Gg) { dense_items(p, lds, wave, lane, 2 * DI_PER_L + DI_GU_A, DI_ALL, (bid - Gg) * 8 + wave, (G - Gg) * 8);
                  moe_convert_pipe(p, lds, wave, lane, CONV_C1, CONV_C2, (bid - Gg) * 8 + wave, (G - Gg) * 8); } }
        }
        SEAM(pb + 6);
        if (PHEN(8) && IN(pb + 7)) for (int rep = 0; rep < REPS(8); ++rep) { OPQ
            if (l == 0) {
                for (int row = 2 * gw; row < MT; row += 2 * NGW) {
                    const float* ma = mod + (size_t)(row < ML ? (row >> 12) : 4) * MODW;
                    norm_mod_row2<(FFN1_FP8 != 0), true>(wsp<bf16_t>(p, WS_X1) + (size_t)row * DM, p.in[I_NFFN] + l * DM, ma + 3 * DM, ma + 4 * DM, wsp<bf16_t>(p, WS_H) + (size_t)row * (FFN1_FP8 ? DM / 2 : DM), FFN1_FP8 ? DM / 2 : DM, lane);
                }
            } else {
                LAS float* rt = (LAS float*)lds;
                LAS int* lcnt = (LAS int*)(lds + 65536);
                LAS int* rinfo = (LAS int*)(lds + 65536 + 64);
                for (int i = tid; i < DM * 8; i += 512) rt[i] = p.in[I_MR][i];
                if (tid < 16) lcnt[tid] = 0;
                __syncthreads();
                for (int grp = bid; grp < ML / 64; grp += G) {
                    const float* mv = mod + (size_t)((grp * 64) >> 12) * MODW;
                    const u32x2* xr = (const u32x2*)(wsp<bf16_t>(p, WS_X1) + (size_t)(grp * 64 + wave * 8) * DM);
                    u32x2 xn[8]; f32x4 m1[8], sq[8];
#pragma unroll
                    for (int j = 0; j < 8; ++j) xn[j] = xr[lane + 64 * j];
#pragma unroll
                    for (int j = 0; j < 8; ++j) { const int c = lane + 64 * j; const f32x4 gq = *((const f32x4*)(p.in[I_NFFN] + l * DM) + c), aq = *((const f32x4*)(mv + 4 * DM) + c);
                        sq[j] = *((const f32x4*)(mv + 3 * DM) + c); m1[j] = gq * (aq + 1.0f); }
#pragma nounroll
                    for (int rr = 0; rr < 8; ++rr) {
                        const int rl = wave * 8 + rr, row = grp * 64 + rl;
                        f32x4 v[8];
#pragma unroll
                        for (int j = 0; j < 8; ++j) v[j] = (f32x4){bf_lo(xn[j].x), bf_hi(xn[j].x), bf_lo(xn[j].y), bf_hi(xn[j].y)};
                        if (rr < 7) { xr += DM / 4;
#pragma unroll
                            for (int j = 0; j < 8; ++j) xn[j] = xr[lane + 64 * j]; }
                        { float ss = 0.f;
#pragma unroll
                          for (int j = 0; j < 8; ++j) ss += (v[j].x * v[j].x + v[j].y * v[j].y) + (v[j].z * v[j].z + v[j].w * v[j].w);
                          const float rstd = 1.0f / sqrtf(wave_sum(ss) * (1.0f / DM) + EPS);
                          unsigned* orow = (unsigned*)(wsp<unsigned char>(p, WS_H) + (size_t)row * DM);
#pragma unroll
                          for (int j = 0; j < 8; ++j) { v[j] = (v[j] * rstd) * m1[j] + sq[j]; orow[lane + 64 * j] = pack_fp8x4(v[j].x, v[j].y, v[j].z, v[j].w); } }
                        float lg[8];
#pragma unroll
                        for (int e = 0; e < 8; ++e) lg[e] = 0.f;
#pragma unroll
                        for (int j = 0; j < 8; ++j)
#pragma unroll
                            for (int c = 0; c < 4; ++c) { const int k = 4 * (lane + 64 * j) + c; const f32x4 r0 = *(const LAS f32x4*)(rt + k * 8), r1 = *(const LAS f32x4*)(rt + k * 8 + 4); const float x = v[j][c];
                                lg[0] += x * r0.x; lg[1] += x * r0.y; lg[2] += x * r0.z; lg[3] += x * r0.w; lg[4] += x * r1.x; lg[5] += x * r1.y; lg[6] += x * r1.z; lg[7] += x * r1.w; }
#pragma unroll
                        for (int e = 0; e < 8; ++e) lg[e] = wave_sum(lg[e]);
                        int e0 = 0; float l0 = lg[0];
#pragma unroll
                        for (int e = 1; e < 8; ++e) if (lg[e] > l0) { l0 = lg[e]; e0 = e; }
                        int e1 = -1; float l1 = -__builtin_inff();
#pragma unroll
                        for (int e = 0; e < 8; ++e) if (e != e0 && lg[e] > l1) { l1 = lg[e]; e1 = e; }
                        if (lane == 0) {
                            const float g0 = 1.0f / (1.0f + __expf(l1 - l0));
                            const int r0 = __hip_atomic_fetch_add(lcnt + e0, 1, __ATOMIC_RELAXED, __HIP_MEMORY_SCOPE_WORKGROUP), r1 = __hip_atomic_fetch_add(lcnt + e1, 1, __ATOMIC_RELAXED, __HIP_MEMORY_SCOPE_WORKGROUP);
                            rinfo[rl * 8 + 0] = e0; rinfo[rl * 8 + 1] = e1; rinfo[rl * 8 + 2] = r0; rinfo[rl * 8 + 3] = r1; rinfo[rl * 8 + 4] = __float_as_int(g0); rinfo[rl * 8 + 5] = __float_as_int(1.0f - g0);
                        }
                    }
                    __syncthreads();
                    if (tid < 8) lcnt[8 + tid] = (int)__hip_atomic_fetch_add(wsp<unsigned>(p, WS_CTL) + CW_ECNT + 64 * tid, (unsigned)lcnt[tid], __ATOMIC_RELAXED, __HIP_MEMORY_SCOPE_AGENT);
                    __syncthreads();
                    if (tid < 64) { int* ro = wsp<int>(p, WS_ROUTE) + (size_t)(grp * 64 + tid) * 8; const int e0 = rinfo[tid * 8], e1 = rinfo[tid * 8 + 1];
                        ro[0] = e0; ro[1] = e1; ro[2] = lcnt[8 + e0] + rinfo[tid * 8 + 2]; ro[3] = lcnt[8 + e1] + rinfo[tid * 8 + 3]; ro[4] = rinfo[tid * 8 + 4]; ro[5] = rinfo[tid * 8 + 5]; }
                    __syncthreads();
                    if (tid < 8) lcnt[tid] = 0;
                    __syncthreads();
                }
            }
        }
        SEAM(pb + 7);
        if (l == 0) {
            if (PHEN(9) && IN(pb + 8)) for (int rep = 0; rep < REPS(9); ++rep) { OPQ
                pg8::TileOrder S; S.init(MT / 256, 2 * DFF / 256, G, bid, nullptr);
#if FFN2_FP8
                pg8::EpiSwiGLU8 E{wsp<unsigned char>(p, WS_ACT), DFF};
#else
                pg8::EpiSwiGLU E{wsp<bf16_t>(p, WS_ACT), DFF};
#endif
#if FFN1_FP8
                pg8::Gemm g{wsp<unsigned char>(p, WS_H), wsp<unsigned char>(p, WS_WGU), DM, DM, 0, 0x7f7f7f7f, 0x77777777};
                pg8::gemm_phase<1>(lds, g, S, E, wave);
#else
                pg8::Gemm g{wsp<bf16_t>(p, WS_H), wsp<bf16_t>(p, WS_WGU), DM, DM, 0, 0, 0};
                pg8::gemm_phase<2>(lds, g, S, E, wave);
#endif
                { const int fi = S.first_idle(); if (fi >= G) moe_convert(p, lds, wave, lane, CONV_C2, CONV_CF, gw, NGW);
                  else if (S.idle_last_round()) moe_convert(p, lds, wave, lane, CONV_C2, CONV_CF, (bid - fi) * 8 + wave, (G - fi) * 8); }
            }
            SEAM(pb + 8);
            if (PHEN(10) && IN(pb + 9)) for (int rep = 0; rep < REPS(10); ++rep) { OPQ
                const int Gg = gemm_cus((MT / 256) * (DM / 256), G);
                pg8::TileOrder S; S.init(MT / 256, DM / 256, Gg, bid, nullptr);
                pg8::EpiResid<false> E{wsp<bf16_t>(p, WS_X1), wsp<bf16_t>(p, WS_X1) + (size_t)ML * DM, wsp<bf16_t>(p, WS_X1), mod + 5 * DM};
#if FFN2_FP8
                pg8::Gemm g{wsp<unsigned char>(p, WS_ACT), wsp<unsigned char>(p, WS_WD), DFF, DFF, 0, 0x7f7f7f7f, 0x77777777};
                if (bid < Gg) pg8::gemm_phase<1>(lds, g, S, E, wave);
#else
                pg8::Gemm g{wsp<bf16_t>(p, WS_ACT), wsp<bf16_t>(p, WS_WD), DFF, DFF, 0, 0, 0};
                if (bid < Gg) pg8::gemm_phase<2>(lds, g, S, E, wave);
#endif
                if (Gg >= G) { dense_items(p, lds, wave, lane, DI_PER_L, 2 * DI_PER_L, gw, NGW); moe_convert(p, lds, wave, lane, CONV_CF, CONV_C3, gw, NGW); }
                else if (bid >= Gg) { dense_items(p, lds, wave, lane, DI_PER_L, 2 * DI_PER_L, (bid - Gg) * 8 + wave, (G - Gg) * 8);
                    moe_convert_pipe(p, lds, wave, lane, CONV_CF, CONV_C3, (bid - Gg) * 8 + wave, (G - Gg) * 8); }
            }
            SEAM(pb + 9);
        } else {
            if (PHEN(9) && IN(pb + 8)) for (int rep = 0; rep < REPS(9); ++rep) { OPQ
                moe_convert(p, lds, wave, lane, CONV_C5, NCONV, gw, NGW);
                __syncthreads();
                moe_tables(p, tb, tid);
                for (int row = gw; row < ML; row += 4 * NGW) {
                    i32x4r rt4[4]; u32x4 v4[4][2];
#pragma unroll
                    for (int q = 0; q < 4; ++q) { const int rw = min(row + q * NGW, ML - 1);
                        rt4[q] = *(const i32x4r*)(wsp<int>(p, WS_ROUTE) + (size_t)rw * 8);
                        const u32x4* src = (const u32x4*)(wsp<unsigned char>(p, WS_H) + (size_t)rw * DM);
                        v4[q][0] = src[lane]; v4[q][1] = src[lane + 64]; }
#pragma unroll
                    for (int q = 0; q < 4; ++q) { const int rw = row + q * NGW;
                        if (rw < ML) {
                            int* ro = wsp<int>(p, WS_ROUTE) + (size_t)rw * 8;
                            const int s0 = tb[rt4[q].x] + rt4[q].z, s1 = tb[rt4[q].y] + rt4[q].w;
                            if (lane == 0) { ro[6] = s0; ro[7] = s1; }
                            u32x4* d0 = (u32x4*)(wsp<unsigned char>(p, WS_HS) + (size_t)s0 * DM); u32x4* d1 = (u32x4*)(wsp<unsigned char>(p, WS_HS) + (size_t)s1 * DM);
                            d0[lane] = v4[q][0]; d1[lane] = v4[q][0]; d0[lane + 64] = v4[q][1]; d1[lane + 64] = v4[q][1];
                        } }
                }
            }
            SEAM(pb + 8);
            if (PHEN(10) && IN(pb + 9)) for (int rep = 0; rep < REPS(10); ++rep) { OPQ
                if (!MK_ONE_LAUNCH) moe_tables(p, tb, tid);
                pg8::Gemm g{wsp<unsigned char>(p, WS_HS), wsp<unsigned char>(p, WS_MGU), DM, DM, (size_t)2 * DFF * DM, 0x7f7f7f7f, 0x77777777};
                pg8::TileOrder S; S.init(__builtin_amdgcn_readfirstlane(tb[8]), 2 * DFF / 256, G, bid, tb + 16);
                pg8::EpiSwiGLU8 E{wsp<unsigned char>(p, WS_ACT), DFF};
                pg8::gemm_phase<1>(lds, g, S, E, wave);
            }
            SEAM(pb + 9);
            if (PHEN(11) && IN(pb + 10)) { OPQ
                if (!MK_ONE_LAUNCH) moe_tables(p, tb, tid);
                { pg8::Gemm g{wsp<unsigned char>(p, WS_ACT), wsp<unsigned char>(p, WS_MD), DFF, DFF, (size_t)DM * DFF, 0x7f7f7f7f, 0x77777777};
                  pg8::TileOrder S; S.init(MAIN_RT, DM / 256, G, bid, tb + 16);
                  pg8::EpiBf16 E{wsp<bf16_t>(p, WS_YS), DM, 0};
                  pg8::gemm_phase<1>(lds, g, S, E, wave); }
                SEAM(pb + 10);
                const int ntail = (__builtin_amdgcn_readfirstlane(tb[8]) - MAIN_RT) * 8;
                if (bid < 2 * ntail) {
                    const int half = bid >= ntail ? 1 : 0, t = bid - half * ntail, pm = t >> 3;
                    const pg8::OneUnit S{pm, t & 7, __builtin_amdgcn_readfirstlane(tb[16 + MAIN_RT + pm]), 1};
                    const pg8::Gemm g{wsp<unsigned char>(p, WS_ACT) + (size_t)MAIN_RT * 256 * DFF + half * (DFF / 2), wsp<unsigned char>(p, WS_MD) + half * (DFF / 2), DFF, DFF / 2, (size_t)DM * DFF, 0x7f7f7f7f, 0x77777777, DFF};
                    float* P = wsp<float>(p, WS_SPLIT) + (size_t)t * 65536; unsigned* fl = wsp<unsigned>(p, WS_CTL) + CW_SPLIT + 64 * t;
                    if (half == 0) { pg8::EpiPartial E{P, fl}; pg8::gemm_phase<1>(lds, g, S, E, wave); }
                    else { pg8::EpiBf16Add E{wsp<bf16_t>(p, WS_YS) + (size_t)MAIN_RT * 256 * DM, DM, P, fl}; pg8::gemm_phase<1>(lds, g, S, E, wave);
                        if (tid == 0) __hip_atomic_fetch_add(wsp<unsigned>(p, WS_CTL) + CW_TAIL, 1u, __ATOMIC_RELAXED, __HIP_MEMORY_SCOPE_AGENT); }
                }
            }
            if (PHEN(12) && IN(pb + 11)) { OPQ
                if (!MK_ONE_LAUNCH) moe_tables(p, tb, tid);
                const int ntail = (__builtin_amdgcn_readfirstlane(tb[8]) - MAIN_RT) * 8;
                const int c0 = 2 * ntail <= G / 2 ? 2 * ntail : 0;
                if (bid >= c0) {
                    const int NGWf = (G - c0) * 8, gwf = (bid - c0) * 8 + wave;
#pragma nounroll
                    for (int pass = 0; pass < 2; ++pass) {
                        int nblk = 0;
                        if (pass) {
                            while ((int)__builtin_amdgcn_readfirstlane(__hip_atomic_load(wsp<unsigned>(p, WS_CTL) + CW_TAIL, __ATOMIC_RELAXED, __HIP_MEMORY_SCOPE_AGENT)) < min(ntail, G)) __builtin_amdgcn_s_sleep(16);
                            __builtin_amdgcn_fence(__ATOMIC_ACQUIRE, "agent");
                        }
                for (int row0 = gwf; row0 < ML; row0 += 8 * NGWf) {
                    i32x4r rt8[8];
#pragma unroll
                    for (int q = 0; q < 8; ++q) rt8[q] = *(const i32x4r*)(wsp<int>(p, WS_ROUTE) + (size_t)min(row0 + q * NGWf, ML - 1) * 8 + 4);
#pragma unroll
                    for (int q = 0; q < 8; ++q) { const int row = row0 + q * NGWf;
                        const int s0 = __builtin_amdgcn_readfirstlane(rt8[q].z), s1 = __builtin_amdgcn_readfirstlane(rt8[q].w);
                        const int blk = (row < ML && (s0 >= MAIN_RT * 256 || s1 >= MAIN_RT * 256)) ? 1 : 0; nblk += blk;
                        if (row < ML && blk == pass) {
                    const float g0 = __int_as_float(rt8[q].x), g1 = __int_as_float(rt8[q].y);
                    const u32x4* y0 = (const u32x4*)(wsp<bf16_t>(p, WS_YS) + (size_t)s0 * DM); const u32x4* y1 = (const u32x4*)(wsp<bf16_t>(p, WS_YS) + (size_t)s1 * DM);
                    const float* gv = mod + (size_t)(row >> 12) * MODW + 5 * DM;
                    const u32x4* xr = (const u32x4*)(wsp<bf16_t>(p, WS_X1) + (size_t)row * DM); float* orow = p.out + (size_t)row * DM;
#pragma unroll
                    for (int j = 0; j < 4; ++j) { const int c = lane + 64 * j; const u32x4 a = y0[c], bq = y1[c];
                        const u32x4 xw = xr[c]; const f32x4 x0 = (f32x4){bf_lo(xw.x), bf_hi(xw.x), bf_lo(xw.y), bf_hi(xw.y)}, x1 = (f32x4){bf_lo(xw.z), bf_hi(xw.z), bf_lo(xw.w), bf_hi(xw.w)}, gg0 = *((const f32x4*)gv + 2 * c), gg1 = *((const f32x4*)gv + 2 * c + 1);
                        f32x4 r0, r1;
                        r0.x = x0.x + gg0.x * (g0 * bf_lo(a.x) + g1 * bf_lo(bq.x)); r0.y = x0.y + gg0.y * (g0 * bf_hi(a.x) + g1 * bf_hi(bq.x));
                        r0.z = x0.z + gg0.z * (g0 * bf_lo(a.y) + g1 * bf_lo(bq.y)); r0.w = x0.w + gg0.w * (g0 * bf_hi(a.y) + g1 * bf_hi(bq.y));
                        r1.x = x1.x + gg1.x * (g0 * bf_lo(a.z) + g1 * bf_lo(bq.z)); r1.y = x1.y + gg1.y * (g0 * bf_hi(a.z) + g1 * bf_hi(bq.z));
                        r1.z = x1.z + gg1.z * (g0 * bf_lo(a.w) + g1 * bf_lo(bq.w)); r1.w = x1.w + gg1.w * (g0 * bf_hi(a.w) + g1 * bf_hi(bq.w));
                        *((f32x4*)orow + 2 * c) = r0; *((f32x4*)orow + 2 * c + 1) = r1; }
                        } }
                }
                        if (nblk == 0) break;
                    }
                }
            }
        }
    }
#undef IN
#undef SEAM
}

extern "C" void kernel_launch(void* const* d_in, const int* in_sizes, int n_in, void* d_out, int out_size, void* d_ws, size_t ws_size, hipStream_t stream) {
    static int grid = 0;
    if (grid == 0) {
        if (n_in != 28 || out_size != ML * DM || ws_size < WS_END) { fprintf(stderr, "kernel_launch: unexpected problem (n_in %d, out %d, ws %zu < %zu)\n", n_in, out_size, ws_size, (size_t)WS_END); grid = -1; return; }
        int dev = 0, cus = 0, per_cu = 0;
        if (hipGetDevice(&dev) != hipSuccess || hipDeviceGetAttribute(&cus, hipDeviceAttributeMultiprocessorCount, dev) != hipSuccess) { grid = -1; return; }
        if (hipFuncSetAttribute((const void*)fwd_kernel, hipFuncAttributeMaxDynamicSharedMemorySize, LDS_BYTES) != hipSuccess) { fprintf(stderr, "kernel_launch: hipFuncSetAttribute failed\n"); grid = -1; return; }
        if (hipOccupancyMaxActiveBlocksPerMultiprocessor(&per_cu, (const void*)fwd_kernel, 512, LDS_BYTES) != hipSuccess || per_cu < 1) { fprintf(stderr, "kernel_launch: occupancy query says %d\n", per_cu); }
        (void)hipGetLastError();
        grid = cus;
    }
    if (grid < 0) return;
    (void)hipMemsetAsync((char*)d_ws + WS_CTL, 0, CTL_BYTES, stream);
    Params prm{};
    for (int i = 0; i < 28; ++i) prm.in[i] = (const float*)d_in[i];
    prm.out = (float*)d_out; prm.ws = (unsigned char*)d_ws;
#if MK_ONE_LAUNCH
    prm.ph_lo = 0; prm.ph_hi = NPHASE + 1;
    hipLaunchKernelGGL(fwd_kernel, dim3(grid), dim3(512), LDS_BYTES, stream, prm);
#else
    for (int ph = 0; ph <= NPHASE; ++ph) {
        if (ph == 11 || ph == 12) continue;
        prm.ph_lo = ph; prm.ph_hi = ph + 1;
        hipLaunchKernelGGL(fwd_kernel, dim3(grid), dim3(512), LDS_BYTES, stream, prm);
    }
#endif
}
```

```cpp
#include <hip/hip_runtime.h>
#include <cstdio>
#include <cstdint>

#define LAS __attribute__((address_space(3)))
#define GAS __attribute__((address_space(1)))
typedef unsigned short bf16_t;
typedef short bf16x8 __attribute__((ext_vector_type(8)));
typedef float f32x2 __attribute__((ext_vector_type(2)));
typedef float f32x4 __attribute__((ext_vector_type(4)));
typedef float f32x16 __attribute__((ext_vector_type(16)));
typedef unsigned u32x2 __attribute__((ext_vector_type(2)));
typedef unsigned u32x4 __attribute__((ext_vector_type(4)));
typedef GAS unsigned gu32;
typedef int i32x4r __attribute__((ext_vector_type(4)));

#ifndef FFN1_FP8
#define FFN1_FP8 1
#endif
#ifndef FFN2_FP8
#define FFN2_FP8 1
#endif
#ifndef MK_ONE_LAUNCH
#define MK_ONE_LAUNCH 1
#endif

constexpr int DM = 2048, NB = 4, SEQ = 4096, CTXL = 256, KEYS = SEQ + CTXL;
constexpr int ML = NB * SEQ, MC = NB * CTXL, MT = ML + MC;
constexpr int INC = 4896, INCP = 5120, DFF = 7168, NEXP = 8, MODW = 6 * DM;
constexpr int MSLOT = 2 * ML + NEXP * 256;
constexpr float EPS = 1e-6f, LOG2E = 1.4426950408889634f;
constexpr int PC_AQ = 0, PC_AK = 512, PC_AV = 640, PC_BQ = 768, PC_BKV = 1152, PC_CQ = 1280, PC_CK = 1792, PC_CV = 2304, PC_CG = 2816,
              PC_DQ = 3328, PC_DK = 3840, PC_DV = 4352, PC_BKR = 4864;

constexpr size_t al256(size_t x) { return (x + 255) & ~(size_t)255; }
constexpr size_t WS_CTL = 0, CTL_BYTES = 1u << 20;
constexpr size_t WS_MOD = WS_CTL + CTL_BYTES;
constexpr size_t WS_ROPE64 = WS_MOD + al256((size_t)2 * 5 * MODW * 4);
constexpr size_t WS_ROPE32 = WS_ROPE64 + al256((size_t)SEQ * 32 * 2 * 4);
constexpr size_t WS_RKV = WS_ROPE32 + al256((size_t)SEQ * 16 * 2 * 4);
constexpr size_t WS_RPB = WS_RKV + al256((size_t)MT * 4);
constexpr size_t WS_ROUTE = WS_RPB + al256((size_t)2 * 8 * 15 * 128 * 4);
constexpr size_t WS_WIN = WS_ROUTE + al256((size_t)ML * 32);
constexpr size_t WS_WOUT = WS_WIN + al256((size_t)2 * INCP * DM * 2);
constexpr size_t WS_WUP = WS_WOUT + al256((size_t)2 * DM * DM * 2);
constexpr size_t WS_WGU = WS_WUP + al256((size_t)2 * 1792 * 512 * 2);
constexpr size_t WS_WD = WS_WGU + al256((size_t)2 * DFF * DM * 2);
constexpr size_t WS_MGU = WS_WD + al256((size_t)DM * DFF * 2);
constexpr size_t WS_MD = WS_MGU + al256((size_t)NEXP * 2 * DFF * DM * 2);
constexpr size_t WS_X1 = WS_MD + al256((size_t)NEXP * DM * DFF * 2);
constexpr size_t WS_H = WS_X1 + al256((size_t)MT * DM * 4);
constexpr size_t WS_P = WS_H + al256((size_t)MT * DM * 2);
constexpr size_t WS_UPRAW = WS_P + al256((size_t)MT * INCP * 2);
constexpr size_t WS_QA = WS_UPRAW + al256((size_t)MT * 1792 * 2);
constexpr size_t WS_KA = WS_QA + al256((size_t)MT * 512 * 2);
constexpr size_t WS_VTA = WS_KA + al256((size_t)NB * 2 * KEYS * 64 * 2);
constexpr size_t WS_QB = WS_VTA + al256((size_t)NB * 2 * KEYS * 64 * 2);
constexpr size_t WS_KB = WS_QB + al256((size_t)MT * 768 * 2);
constexpr size_t WS_VTB = WS_KB + al256((size_t)NB * 8 * KEYS * 96 * 2);
constexpr size_t HB64 = al256((size_t)NB * 8 * KEYS * 64 * 2);
constexpr size_t WS_QC = WS_VTB + HB64;
constexpr size_t WS_KC = WS_QC + al256((size_t)MT * 512 * 2);
constexpr size_t WS_KWF = WS_KC + HB64, WS_KWR = WS_KWF + HB64, WS_VTC = WS_KWR + HB64;
constexpr size_t WS_QD = WS_VTC + HB64;
constexpr size_t WS_KD = WS_QD + al256((size_t)MT * 512 * 2), WS_VTD = WS_KD + HB64;
constexpr size_t WS_KVST = WS_VTD + HB64;
constexpr size_t WS_SPREV = WS_KVST + al256((size_t)64 * 34 * 4096 * 4);
constexpr size_t WS_OCAT = WS_SPREV + al256((size_t)64 * 34 * 4096 * 2);
constexpr size_t WS_ACT = WS_OCAT + al256((size_t)MT * DM * 2);
constexpr size_t WS_HS = WS_ACT + al256((size_t)MSLOT * DFF * 2);
constexpr size_t WS_YS = WS_HS + al256((size_t)MSLOT * DM * 2);
constexpr size_t WS_SPLIT = WS_YS + al256((size_t)MSLOT * DM * 2);
constexpr size_t WS_RQ = WS_SPLIT + (size_t)64 * 65536 * 4;
constexpr size_t WS_END = WS_RQ + al256((size_t)MT * 4);
constexpr int CW_BAR = 4096;
constexpr int CW_Q = 8192;
constexpr int CW_ECNT = 16384;
constexpr int CW_SPLIT = 36864;
constexpr int CW_TAIL = 32768;

constexpr int RING_BYTES = 131072;
constexpr int MISC_OFF = 146432;
constexpr int LDS_BYTES = 147456;

__device__ __forceinline__ unsigned cvt_pk_bf16(float lo, float hi) { unsigned r; asm volatile("v_cvt_pk_bf16_f32 %0, %1, %2" : "=v"(r) : "v"(lo), "v"(hi)); return r; }
__device__ __forceinline__ float bf_lo(unsigned w) { return __uint_as_float(w << 16); }
__device__ __forceinline__ float bf_hi(unsigned w) { return __uint_as_float(w & 0xffff0000u); }
__device__ __forceinline__ float bf2f(bf16_t h) { return __uint_as_float((unsigned)h << 16); }
__device__ __forceinline__ float fexp2(float x) { return __builtin_amdgcn_exp2f(x); }
__device__ __forceinline__ float frcp(float x) { return __builtin_amdgcn_rcpf(x); }
__device__ __forceinline__ float silu_f(float g) { return g * frcp(1.0f + fexp2(-g * LOG2E)); }
__device__ __forceinline__ unsigned pack_fp8x4(float a, float b, float c, float d) {
    a = __builtin_amdgcn_fmed3f(a, -448.f, 448.f); b = __builtin_amdgcn_fmed3f(b, -448.f, 448.f); c = __builtin_amdgcn_fmed3f(c, -448.f, 448.f); d = __builtin_amdgcn_fmed3f(d, -448.f, 448.f);
    int w = 0; w = __builtin_amdgcn_cvt_pk_fp8_f32(a, b, w, false); w = __builtin_amdgcn_cvt_pk_fp8_f32(c, d, w, true); return (unsigned)w; }
#if 1
__device__ __forceinline__ float opaque_zero() { return 0.f; }
#else
__device__ __forceinline__ float opaque_zero() { float z; asm volatile("v_mov_b32 %0, 0" : "=v"(z)); return z; }
#endif
__device__ __forceinline__ float xhalf_max(float m) { const auto rr = __builtin_amdgcn_permlane32_swap(__float_as_uint(m), __float_as_uint(m), false, false); return fmaxf(__uint_as_float(rr[0]), __uint_as_float(rr[1])); }
__device__ __forceinline__ float xhalf_sum(float m) { const auto rr = __builtin_amdgcn_permlane32_swap(__float_as_uint(m), __float_as_uint(m), false, false); return __uint_as_float(rr[0]) + __uint_as_float(rr[1]); }
__device__ __forceinline__ int lnd_s(int x) { asm volatile("" : "+s"(x)); return x; }
__device__ __forceinline__ float shfl_idx(float x, int src) { return __int_as_float(__builtin_amdgcn_ds_bpermute(src << 2, __float_as_int(x))); }
__device__ __forceinline__ int lane_id_asm() { int l; asm volatile("v_mbcnt_lo_u32_b32 %0, -1, 0\n\tv_mbcnt_hi_u32_b32 %0, -1, %0" : "=v"(l)); return l; }
template <int N> __device__ __forceinline__ float dpp_ror(float v) { return __int_as_float(__builtin_amdgcn_update_dpp(0, __float_as_int(v), 0x120 + N, 0xf, 0xf, false)); }
__device__ __forceinline__ float row_sum16(float v) { v += dpp_ror<8>(v); v += dpp_ror<4>(v); v += dpp_ror<2>(v); v += dpp_ror<1>(v); return v; }
__device__ __forceinline__ float wave_sum(float v) {
    v = row_sum16(v);
    const float a = __int_as_float(__builtin_amdgcn_readlane(__float_as_int(v), 0)), b = __int_as_float(__builtin_amdgcn_readlane(__float_as_int(v), 16));
    const float c = __int_as_float(__builtin_amdgcn_readlane(__float_as_int(v), 32)), d = __int_as_float(__builtin_amdgcn_readlane(__float_as_int(v), 48));
    return (a + b) + (c + d);
}
__device__ __forceinline__ void row_bp(int row, int& b, int& p) { if (row < ML) { b = row >> 12; p = row & (SEQ - 1); } else { const int r = row - ML; b = r >> 8; p = SEQ + (r & (CTXL - 1)); } }
__device__ __forceinline__ int bp_row(int b, int p) { return p < SEQ ? b * SEQ + p : ML + b * CTXL + (p - SEQ); }
namespace pg8 {
constexpr int BM = 256, BK = 64, HALF = 128, HTB = HALF * BK * 2  , STAGE_BYTES = 8 * HTB, NXCD = 8, WGM = 8;
__host__ __device__ __forceinline__ int lds_byte(int r, int c) { const int st = (r >> 4) * 2 + (c >> 5), rr = r & 15, cc = c & 31, ob = rr * 64 + cc * 2; return st * 1024 + (ob ^ (((ob >> 9) & 1) << 5)); }
__host__ __device__ __forceinline__ void stage_rc(int b, int& R, int& C) { const int st = b / 1024, sb = b % 1024, swz = sb ^ (((sb >> 9) & 1) << 5); R = (st >> 1) * 16 + swz / 64; C = (st & 1) * 32 + (swz % 64) / 2; }
__host__ __device__ __forceinline__ int perm32(int rho) { const int n = rho >> 4, i = rho & 15; return 8 * (i >> 2) + 4 * n + (i & 3); }

struct Unit { int pm, pn, eb; };
struct Gemm { const void* A; const void* Bt; int lda, K; size_t bstride; int scaleA, scaleB; int ldb; };
typedef int i32x8 __attribute__((ext_vector_type(8)));
typedef int i32x4 __attribute__((ext_vector_type(4)));
__device__ __forceinline__ i32x8 cat8(bf16x8 lo, bf16x8 hi) { return __builtin_shufflevector(__builtin_bit_cast(i32x4, lo), __builtin_bit_cast(i32x4, hi), 0, 1, 2, 3, 4, 5, 6, 7); }

struct TileOrder {
    int nM, nN, nwg, G, c; const LAS int* tile_e;
    __device__ void init(int nM_, int nN_, int G_, int c_, const LAS int* te) { nM = nM_; nN = nN_; nwg = nM * nN; G = G_; c = c_; tile_e = te; }
    __device__ bool idle_last_round() const { const int R = (nwg + G - 1) / G; return c + (R - 1) * G >= nwg; }
    __device__ int first_idle() const { const int R = (nwg + G - 1) / G; return nwg - (R - 1) * G; }
    __device__ bool next(int i, Unit& u) const {
        const long L = (long)i * G + c; if (L >= nwg) return false;
        int wgid = (int)L; { const int q = nwg / NXCD, r = nwg % NXCD, xcd = wgid % NXCD, off = wgid / NXCD; wgid = (xcd < r ? xcd * (q + 1) : r * (q + 1) + (xcd - r) * q) + off; }
        const int nig = WGM * nN, gid = wgid / nig, fm = gid * WGM, gsz = (nM - fm) < WGM ? (nM - fm) : WGM;
        u.pm = fm + ((wgid % nig) % gsz); u.pn = (wgid % nig) / gsz; u.eb = tile_e ? __builtin_amdgcn_readfirstlane(tile_e[u.pm]) : 0; return true;
    }
};

struct EpiBf16 {
    static constexpr bool PERM = true;
    bf16_t* O; int ldc; int wt;
    __device__ __forceinline__ void operator()(const f32x4 (&acc)[2][2][4][2], const Unit& u, int wr, int wc, int fr, int fq) const {
        const int row0 = u.pm * BM + wr * 64 + fr, col0 = u.pn * BM + wc * 32 + 8 * fq;
        if (wt) {
            const __amdgpu_buffer_rsrc_t rs = __builtin_amdgcn_make_buffer_rsrc((void*)O, 0, 0x7ffffff0, 0x00020000);
#pragma unroll
            for (int ai = 0; ai < 2; ++ai)
#pragma unroll
                for (int m = 0; m < 4; ++m) { const int ob = ((row0 + ai * HALF + m * 16) * ldc + col0) * 2;
#pragma unroll
                    for (int bj = 0; bj < 2; ++bj) { const f32x4 v0 = acc[ai][bj][m][0], v1 = acc[ai][bj][m][1];
                        u32x4 w; w.x = cvt_pk_bf16(v0[0], v0[1]); w.y = cvt_pk_bf16(v0[2], v0[3]); w.z = cvt_pk_bf16(v1[0], v1[1]); w.w = cvt_pk_bf16(v1[2], v1[3]);
                        __builtin_amdgcn_raw_buffer_store_b128(w, rs, ob + bj * HALF * 2, 0, 16); } }
            return;
        }
#pragma unroll
        for (int ai = 0; ai < 2; ++ai)
#pragma unroll
            for (int m = 0; m < 4; ++m) { bf16_t* rowp = O + (size_t)(row0 + ai * HALF + m * 16) * ldc + col0;
#pragma unroll
                for (int bj = 0; bj < 2; ++bj) { const f32x4 v0 = acc[ai][bj][m][0], v1 = acc[ai][bj][m][1];
                    u32x4 w; w.x = cvt_pk_bf16(v0[0], v0[1]); w.y = cvt_pk_bf16(v0[2], v0[3]); w.z = cvt_pk_bf16(v1[0], v1[1]); w.w = cvt_pk_bf16(v1[2], v1[3]);
                    *(u32x4*)(rowp + bj * HALF) = w; } }
    }
};
struct EpiSwiGLU {
    static constexpr bool PERM = true;
    bf16_t* O; int ldc;
    __device__ __forceinline__ void operator()(const f32x4 (&acc)[2][2][4][2], const Unit& u, int wr, int wc, int fr, int fq) const {
        const int row0 = u.pm * BM + wr * 64 + fr, col0 = u.pn * HALF + wc * 32 + 8 * fq;
#pragma unroll
        for (int ai = 0; ai < 2; ++ai)
#pragma unroll
            for (int m = 0; m < 4; ++m) { bf16_t* rowp = O + (size_t)(row0 + ai * HALF + m * 16) * ldc + col0;
                float o[8];
#pragma unroll
                for (int n = 0; n < 2; ++n)
#pragma unroll
                    for (int j = 0; j < 4; ++j) o[n * 4 + j] = silu_f(acc[ai][0][m][n][j]) * acc[ai][1][m][n][j];
                u32x4 w; w.x = cvt_pk_bf16(o[0], o[1]); w.y = cvt_pk_bf16(o[2], o[3]); w.z = cvt_pk_bf16(o[4], o[5]); w.w = cvt_pk_bf16(o[6], o[7]);
                *(u32x4*)rowp = w; asm volatile("" ::: "memory"); }
    }
};
struct EpiSwiGLU8 {
    static constexpr bool PERM = true;
    unsigned char* O; int ldc;
    __device__ __forceinline__ void operator()(const f32x4 (&acc)[2][2][4][2], const Unit& u, int wr, int wc, int fr, int fq) const {
        const int row0 = u.pm * BM + wr * 64 + fr, col0 = u.pn * HALF + wc * 32 + 8 * fq;
#pragma unroll
        for (int ai = 0; ai < 2; ++ai)
#pragma unroll
            for (int m = 0; m < 4; ++m) { unsigned char* rowp = O + (size_t)(row0 + ai * HALF + m * 16) * ldc + col0;
                float o[8];
#pragma unroll
                for (int n = 0; n < 2; ++n)
#pragma unroll
                    for (int j = 0; j < 4; ++j) o[n * 4 + j] = silu_f(acc[ai][0][m][n][j]) * acc[ai][1][m][n][j];
                u32x2 w; w.x = pack_fp8x4(o[0], o[1], o[2], o[3]); w.y = pack_fp8x4(o[4], o[5], o[6], o[7]);
                *(u32x2*)rowp = w; asm volatile("" ::: "memory"); }
    }
};
template <bool BF32>
struct EpiResid {
    static constexpr bool PERM = true;
    const void* base_lat; const void* base_ctx; bf16_t* out; const float* gate;
    __device__ __forceinline__ void operator()(const f32x4 (&acc)[2][2][4][2], const Unit& u, int wr, int wc, int fr, int fq) const {
        const bool isctx = u.pm >= ML / BM;
        const char* base = isctx ? (const char*)base_ctx - (size_t)ML * DM * (BF32 ? 4 : 2) : (const char*)base_lat;
        const float* gv = gate + (size_t)(isctx ? 4 : (u.pm >> 4)) * MODW;
        const int col0 = u.pn * BM + wc * 32 + 8 * fq;
        f32x4 g[2][2];
#pragma unroll
        for (int bj = 0; bj < 2; ++bj)
#pragma unroll
            for (int n = 0; n < 2; ++n) g[bj][n] = *(const f32x4*)(gv + col0 + bj * HALF + n * 4);
        f32x4 bsf[BF32 ? 3 : 1][2][2]; u32x4 bsb[BF32 ? 1 : 3][2];
        const size_t off0 = (size_t)(u.pm * BM + wr * 64 + fr) * DM + col0;
#define ER_LOAD(q) do { const size_t off_ = off0 + (size_t)(((q) >> 2) * HALF + ((q) & 3) * 16) * DM; _Pragma("unroll") for (int bj = 0; bj < 2; ++bj) { \
            if constexpr (BF32) { _Pragma("unroll") for (int n = 0; n < 2; ++n) bsf[(q) % 3][bj][n] = *(const f32x4*)((const float*)base + off_ + bj * HALF + n * 4); } \
            else bsb[(q) % 3][bj] = *(const u32x4*)((const bf16_t*)base + off_ + bj * HALF); } } while (0)
        ER_LOAD(0); ER_LOAD(1);
#pragma unroll
        for (int q = 0; q < 8; ++q) {
            if (q + 2 < 8) ER_LOAD(q + 2);
            const int ai = q >> 2, m = q & 3; const size_t off = off0 + (size_t)(ai * HALF + m * 16) * DM;
#pragma unroll
            for (int bj = 0; bj < 2; ++bj) {
                f32x4 b0, b1;
                if constexpr (BF32) { b0 = bsf[q % 3][bj][0]; b1 = bsf[q % 3][bj][1]; }
                else { const u32x4 w = bsb[q % 3][bj]; b0 = (f32x4){bf_lo(w.x), bf_hi(w.x), bf_lo(w.y), bf_hi(w.y)}; b1 = (f32x4){bf_lo(w.z), bf_hi(w.z), bf_lo(w.w), bf_hi(w.w)}; }
                const f32x4 r0 = b0 + g[bj][0] * acc[ai][bj][m][0], r1 = b1 + g[bj][1] * acc[ai][bj][m][1];
                u32x4 o; o.x = cvt_pk_bf16(r0[0], r0[1]); o.y = cvt_pk_bf16(r0[2], r0[3]); o.z = cvt_pk_bf16(r1[0], r1[1]); o.w = cvt_pk_bf16(r1[2], r1[3]);
                *(u32x4*)(out + off + bj * HALF) = o; }
            asm volatile("" ::: "memory");
        }
#undef ER_LOAD
    }
};

struct OneUnit { int pm, pn, eb, valid; __device__ bool next(int i, Unit& u) const { if (i > 0 || !valid) return false; u.pm = pm; u.pn = pn; u.eb = eb; return true; } };
struct EpiPartial {
    static constexpr bool PERM = true;
    float* P; unsigned* flag;
    __device__ __forceinline__ void operator()(const f32x4 (&acc)[2][2][4][2], const Unit& u, int wr, int wc, int fr, int fq) const {
        const int wv = wr * 4 + wc, ln = fq * 16 + fr;
        const __amdgpu_buffer_rsrc_t rs = __builtin_amdgcn_make_buffer_rsrc((void*)P, 0, 65536 * 4, 0x00020000);
#pragma unroll
        for (int ai = 0; ai < 2; ++ai)
#pragma unroll
            for (int bj = 0; bj < 2; ++bj)
#pragma unroll
                for (int m = 0; m < 4; ++m)
#pragma unroll
                    for (int n = 0; n < 2; ++n) { const int gi = ((ai * 2 + bj) * 4 + m) * 2 + n;
                        __builtin_amdgcn_raw_buffer_store_b128(__builtin_bit_cast(u32x4, acc[ai][bj][m][n]), rs, ((wv * 32 + gi) * 64 + ln) * 16, 0, 16); }
        asm volatile("s_waitcnt vmcnt(0)" ::: "memory");
        if (ln == 0) __hip_atomic_fetch_add(flag, 1u, __ATOMIC_RELAXED, __HIP_MEMORY_SCOPE_AGENT);
    }
};
struct EpiBf16Add {
    static constexpr bool PERM = true;
    bf16_t* O; int ldc; const float* P; unsigned* flag;
    __device__ __forceinline__ void operator()(const f32x4 (&acc)[2][2][4][2], const Unit& u, int wr, int wc, int fr, int fq) const {
        const int wv = wr * 4 + wc, ln = fq * 16 + fr;
        while (__builtin_amdgcn_readfirstlane(__hip_atomic_load(flag, __ATOMIC_RELAXED, __HIP_MEMORY_SCOPE_AGENT)) < 8u) __builtin_amdgcn_s_sleep(4);
        __builtin_amdgcn_fence(__ATOMIC_ACQUIRE, "agent");
        const f32x4* pp = (const f32x4*)P + (size_t)(wv * 32) * 64 + ln;
        const int row0 = u.pm * BM + wr * 64 + fr, col0 = u.pn * BM + wc * 32 + 8 * fq;
        const __amdgpu_buffer_rsrc_t rs = __builtin_amdgcn_make_buffer_rsrc((void*)O, 0, 0x7ffffff0, 0x00020000);
        f32x4 q[3][2][2];
#define EA_LOAD(g_) do { _Pragma("unroll") for (int bj = 0; bj < 2; ++bj) _Pragma("unroll") for (int n = 0; n < 2; ++n) \
            q[(g_) % 3][bj][n] = pp[(((((g_) >> 2) * 2 + bj) * 4 + ((g_) & 3)) * 2 + n) * 64]; } while (0)
        EA_LOAD(0); EA_LOAD(1);
#pragma unroll
        for (int g_ = 0; g_ < 8; ++g_) {
            if (g_ + 2 < 8) EA_LOAD(g_ + 2);
            const int ai = g_ >> 2, m = g_ & 3; const int ob = ((row0 + ai * HALF + m * 16) * ldc + col0) * 2;
#pragma unroll
            for (int bj = 0; bj < 2; ++bj) { const f32x4 v0 = acc[ai][bj][m][0] + q[g_ % 3][bj][0], v1 = acc[ai][bj][m][1] + q[g_ % 3][bj][1];
                u32x4 w; w.x = cvt_pk_bf16(v0[0], v0[1]); w.y = cvt_pk_bf16(v0[2], v0[3]); w.z = cvt_pk_bf16(v1[0], v1[1]); w.w = cvt_pk_bf16(v1[2], v1[3]);
                __builtin_amdgcn_raw_buffer_store_b128(w, rs, ob + bj * HALF * 2, 0, 16); }
            asm volatile("" ::: "memory");
        }
#undef EA_LOAD
    }
};

template <int ES  , class Epi, class Sched>
__device__ __forceinline__ void gemm_phase(LAS unsigned char* lds, const Gemm g, const Sched& S, const Epi& E, int wid) {
    const int lane = lane_id_asm(), tid = wid * 64 + lane, wr = wid >> 2, wc = wid & 3, fr = lane & 15, fq = lane >> 4;
    const int K = g.K, nt = K * ES / (BK * 2), lda = g.lda, ldb = g.ldb ? g.ldb : g.K;
    int sclA = g.scaleA, sclB = g.scaleB; asm volatile("" : "+v"(sclA), "+v"(sclB));
    unsigned voffA[2], voffB[2];
#pragma unroll
    for (int i = 0; i < 2; ++i) { int R, C; stage_rc(tid * 16 + i * 8192, R, C); const int Rb = Epi::PERM ? ((R & ~31) + perm32(R & 31)) : R;
        voffA[i] = (unsigned)(R * lda * ES + C * 2); voffB[i] = (unsigned)(Rb * ldb * ES + C * 2); }
    const size_t kstep = (size_t)(BK * 2);
    const size_t hstepA = (size_t)HALF * lda * ES, hstepB = (size_t)HALF * ldb * ES;
    const size_t tstepA = 2 * hstepA, tstepB = 2 * hstepB;
    const unsigned ldsw = (unsigned)wid * 1024u;
    const int aoff = lds_byte(wr * 64 + fr, fq * 8), boff = lds_byte(wc * 32 + fr, fq * 8);
#define PG8_SA(b, h) (((b) * 2 + (h)) * HTB)
#define PG8_SB(b, h) ((4 + (b) * 2 + (h)) * HTB)
#define PG8_STAGE(bufoff, gbase, voff) do { _Pragma("unroll") for (int _i = 0; _i < 2; ++_i) \
        __builtin_amdgcn_global_load_lds((const GAS unsigned*)((const char*)(gbase) + (voff)[_i]), (LAS unsigned*)(lds + (bufoff) + ldsw + _i * 8192), 16, 0, 0); } while (0)
#define PG8_LDA(dst, b, h) do { _Pragma("unroll") for (int m = 0; m < 4; ++m) _Pragma("unroll") for (int k = 0; k < 2; ++k) dst[m][k] = *(const LAS bf16x8*)(lds + PG8_SA(b, h) + aoff + m * 2048 + k * 1024); } while (0)
#define PG8_LDB(dst, b, h) do { _Pragma("unroll") for (int n = 0; n < 2; ++n) _Pragma("unroll") for (int k = 0; k < 2; ++k) dst[n][k] = *(const LAS bf16x8*)(lds + PG8_SB(b, h) + boff + n * 2048 + k * 1024); } while (0)
#define PG8_MMA(ai, bj, At, Bt) do { __builtin_amdgcn_s_setprio(1); _Pragma("unroll") for (int m = 0; m < 4; ++m) _Pragma("unroll") for (int n = 0; n < 2; ++n) { \
        if constexpr (ES == 2) { _Pragma("unroll") for (int k = 0; k < 2; ++k) acc[ai][bj][m][n] = __builtin_amdgcn_mfma_f32_16x16x32_bf16(Bt[n][k], At[m][k], acc[ai][bj][m][n], 0, 0, 0); } \
        else { const i32x8 _a = cat8(Bt[n][0], Bt[n][1]), _b = cat8(At[m][0], At[m][1]); \
               asm volatile("v_mfma_scale_f32_16x16x128_f8f6f4 %0, %1, %2, %0, %3, %4 op_sel_hi:[0,0,0]" : "+v"(acc[ai][bj][m][n]) : "v"(_a), "v"(_b), "v"(sclB), "v"(sclA)); } } \
        __builtin_amdgcn_s_setprio(0); } while (0)
#define PG8_WAIT_V(n) asm volatile("s_waitcnt vmcnt(" #n ")" ::: "memory")
#define PG8_WAIT_L(n) asm volatile("s_waitcnt lgkmcnt(" #n ")" ::: "memory")
#define PG8_BAR __builtin_amdgcn_s_barrier()
#define PG8_SCHED __builtin_amdgcn_sched_barrier(0)
    Unit cur, nxt; int ui = 0;
    if (!S.next(0, cur)) return;
    f32x4 acc[2][2][4][2];
    float zr = opaque_zero();
#pragma unroll
    for (int a = 0; a < 2; ++a)
#pragma unroll
        for (int b = 0; b < 2; ++b)
#pragma unroll
            for (int m = 0; m < 4; ++m)
#pragma unroll
                for (int n = 0; n < 2; ++n) acc[a][b][m][n] = (f32x4){zr, zr, zr, zr};
    bf16x8 At[4][2], B0[2][2], B1[2][2];
    const char* cA = (const char*)g.A + (size_t)cur.pm * tstepA; const char* cB = (const char*)g.Bt + ((size_t)cur.eb * g.bstride) * ES + (size_t)cur.pn * tstepB;
    PG8_STAGE(PG8_SB(0, 0), cB, voffB); PG8_STAGE(PG8_SB(0, 1), cB + hstepB, voffB); PG8_STAGE(PG8_SA(0, 0), cA, voffA); PG8_STAGE(PG8_SA(0, 1), cA + hstepA, voffA);
    if (wr == 1) PG8_BAR;
    PG8_WAIT_V(2); PG8_BAR;
    PG8_STAGE(PG8_SB(1, 0), cB + kstep, voffB); PG8_STAGE(PG8_SA(1, 0), cA + kstep, voffA); PG8_STAGE(PG8_SB(1, 1), cB + hstepB + kstep, voffB);
    PG8_WAIT_V(6); PG8_BAR;
    for (;;) {
        const bool has_next = S.next(ui + 1, nxt);
        const char* nA = has_next ? (const char*)g.A + (size_t)nxt.pm * tstepA : cA;
        const char* nB = has_next ? (const char*)g.Bt + ((size_t)nxt.eb * g.bstride) * ES + (size_t)nxt.pn * tstepB : cB;
#pragma nounroll
        for (int t = 0; t < nt; t += 2) {
            const bool last = (t == nt - 2);
            const char* a1 = cA + (size_t)(t + 1) * kstep;
            const char* a2 = last ? nA : cA + (size_t)(t + 2) * kstep; const char* b2 = last ? nB : cB + (size_t)(t + 2) * kstep;
            const char* a3 = a2 + kstep; const char* b3 = b2 + kstep;
            PG8_LDB(B0, 0, 0); PG8_LDB(B1, 0, 1); PG8_SCHED; PG8_LDA(At, 0, 0); PG8_STAGE(PG8_SA(1, 1), a1 + hstepA, voffA);
            PG8_WAIT_V(8); PG8_WAIT_L(0); PG8_BAR; PG8_MMA(0, 0, At, B0); PG8_MMA(0, 1, At, B1); PG8_BAR; PG8_SCHED;
            PG8_LDA(At, 0, 1); PG8_STAGE(PG8_SB(0, 0), b2, voffB); PG8_STAGE(PG8_SB(0, 1), b2 + hstepB, voffB); PG8_STAGE(PG8_SA(0, 0), a2, voffA);
            PG8_WAIT_V(8); PG8_WAIT_L(0); PG8_BAR; PG8_MMA(1, 0, At, B0); PG8_MMA(1, 1, At, B1); PG8_BAR; PG8_SCHED;
            PG8_LDB(B0, 1, 0); PG8_LDB(B1, 1, 1); PG8_SCHED; PG8_LDA(At, 1, 0); PG8_STAGE(PG8_SA(0, 1), a2 + hstepA, voffA);
            PG8_WAIT_V(8); PG8_WAIT_L(0); PG8_BAR; PG8_MMA(0, 0, At, B0); PG8_MMA(0, 1, At, B1); PG8_BAR; PG8_SCHED;
            PG8_LDA(At, 1, 1); PG8_STAGE(PG8_SB(1, 0), b3, voffB); PG8_STAGE(PG8_SB(1, 1), b3 + hstepB, voffB); PG8_STAGE(PG8_SA(1, 0), a3, voffA);
            PG8_WAIT_V(8); PG8_WAIT_L(0); PG8_BAR; PG8_MMA(1, 0, At, B0); PG8_MMA(1, 1, At, B1); PG8_BAR; PG8_SCHED;
        }
        if (wr == 0) PG8_BAR;
        if constexpr (ES == 1) asm volatile("s_nop 15\n\ts_nop 15" ::: "memory");
        E(acc, cur, wr, wc, fr, fq);
        if (!has_next) break;
        zr = opaque_zero();
#pragma unroll
        for (int a = 0; a < 2; ++a)
#pragma unroll
            for (int b = 0; b < 2; ++b)
#pragma unroll
                for (int m = 0; m < 4; ++m)
#pragma unroll
                    for (int n = 0; n < 2; ++n) acc[a][b][m][n] = (f32x4){zr, zr, zr, zr};
        cur = nxt; cA = nA; cB = nB; ++ui;
        if (wr == 1) PG8_BAR;
    }
    PG8_WAIT_V(0);
    PG8_BAR;
#undef PG8_SA
#undef PG8_SB
#undef PG8_STAGE
#undef PG8_LDA
#undef PG8_LDB
#undef PG8_MMA
#undef PG8_WAIT_V
#undef PG8_WAIT_L
#undef PG8_BAR
#undef PG8_SCHED
}
}
#define XB_TMO      128
#define XB_XCNT(j)  (256  + 64 * (j))
#define XB_XSUB(j)  (1280 + 64 * (j))
#define XB_XGEN(j)  (2304 + 64 * (j))
#define XB_TOP      3328
#define XB_TOPGEN   3392
#define XCD_BAR_WORDS 3456
#define XB_SPIN_CAP (1u << 18)
__device__ __forceinline__ unsigned xb_ld(unsigned* p)              { return __hip_atomic_load(p, __ATOMIC_RELAXED, __HIP_MEMORY_SCOPE_AGENT); }
__device__ __forceinline__ unsigned xb_add(unsigned* p, unsigned v) { return __hip_atomic_fetch_add(p, v, __ATOMIC_RELAXED, __HIP_MEMORY_SCOPE_AGENT); }
__device__ __forceinline__ unsigned xb_xcc_id() { return (unsigned)__builtin_amdgcn_s_getreg((3 << 11) | 20) & 0xFu; }
#define XB_SPIN(cond, bar) do { unsigned _sp = 0; while (cond) { __builtin_amdgcn_s_sleep(1); \
    if ((++_sp & 255u) == 0u) { if (xb_ld(&(bar)[XB_TMO])) break; if (_sp > XB_SPIN_CAP) { atomicAdd(&(bar)[XB_TMO], 1u); break; } } } } while (0)
struct XcdBarrier { unsigned* bar; unsigned x; volatile LAS unsigned* st; };
__device__ __forceinline__ XcdBarrier xcd_barrier_post(unsigned* bar, volatile LAS unsigned* st, bool leader) {
    XcdBarrier b; b.bar = bar; b.x = xb_xcc_id(); b.st = st;
    if (leader) (void)xb_add(&bar[XB_XCNT(b.x)], 1u);
    return b;
}
__device__ __forceinline__ void xcd_barrier_complete(unsigned* bar, unsigned x, unsigned& nloc, unsigned& nx) {
    const unsigned G = gridDim.x * gridDim.y * gridDim.z;
    unsigned sum, cnt, mine, sp = 0u;
    for (;;) {
        sum = 0u; cnt = 0u; mine = 0u;
#pragma unroll
        for (unsigned j = 0; j < 16; ++j) { const unsigned c = xb_ld(&bar[XB_XCNT(j)]); sum += c; cnt += (c > 0u) ? 1u : 0u; mine = (j == x) ? c : mine; }
        if (sum == G) break;
        __builtin_amdgcn_s_sleep(1);
        if ((++sp & 255u) == 0u) { if (xb_ld(&bar[XB_TMO])) break; if (sp > XB_SPIN_CAP) { atomicAdd(&bar[XB_TMO], 1u); break; } }
    }
    nloc = mine > 0u ? mine : 1u; nx = cnt > 0u ? cnt : 1u;
}
__device__ __forceinline__ void xcd_barrier(const XcdBarrier& b, bool leader) {
    asm volatile("s_waitcnt vmcnt(0)" ::: "memory");
    __syncthreads();
    if (leader) {
        unsigned* bar = b.bar; unsigned bx = b.x;
        asm volatile("" : "+s"(bar), "+s"(bx));
        __builtin_amdgcn_s_waitcnt(0);
        unsigned nloc = b.st[0], nx = b.st[1];
        if (nloc == 0u) { xcd_barrier_complete(bar, bx, nloc, nx); b.st[0] = nloc; b.st[1] = nx; }
        const unsigned old = xb_add(&bar[XB_XSUB(bx)], 1u);
        const unsigned gen = old / nloc;
        if (old + 1u == (gen + 1u) * nloc) {
            __builtin_amdgcn_fence(__ATOMIC_RELEASE, "agent");
            asm volatile("s_waitcnt vmcnt(0)" ::: "memory");
            const unsigned og = xb_add(&bar[XB_TOP], 1u);
            const unsigned tg = og / nx;
            if (og + 1u == (tg + 1u) * nx) xb_add(&bar[XB_TOPGEN], 1u);
            else XB_SPIN(xb_ld(&bar[XB_TOPGEN]) == tg, bar);
            __builtin_amdgcn_fence(__ATOMIC_ACQUIRE, "agent");
            xb_add(&bar[XB_XGEN(bx)], 1u);
            asm volatile("s_waitcnt vmcnt(0)" ::: "memory");
        } else {
            XB_SPIN(xb_ld(&bar[XB_XGEN(bx)]) == gen, bar);
            __builtin_amdgcn_fence(__ATOMIC_ACQUIRE, "agent");
            asm volatile("s_waitcnt vmcnt(0)" ::: "memory");
        }
    }
    __syncthreads();
}

struct Params { const float* in[28]; float* out; unsigned char* ws; int ph_lo, ph_hi; };
enum { I_X = 0, I_C, I_CTX, I_CCTX, I_WADA, I_BADA, I_NMIX, I_NFFN, I_WIN, I_WOUT, I_AQN, I_AKN, I_ASINK, I_BQAN, I_BKVAN, I_BWUQ, I_BWUKV, I_BQN, I_BKN,
       I_CLD, I_DQN, I_DKN, I_DRPB, I_FGU, I_FD, I_MR, I_MGU, I_MD };
template <class T> __device__ __forceinline__ T* wsp(const Params& p, size_t off) { return (T*)(p.ws + off); }
typedef const __attribute__((address_space(4))) Params* KArg;
__device__ __forceinline__ Params load_params(KArg k) {
    asm volatile("" : "+s"(k));
    Params p;
#pragma unroll
    for (int i = 0; i < 28; ++i) p.in[i] = k->in[i];
    p.out = k->out; p.ws = k->ws; p.ph_lo = k->ph_lo; p.ph_hi = k->ph_hi; return p;
}

__device__ __forceinline__ int q_next(const Params& p, int q, int lane) {
    unsigned v = 0;
    if (lane == 0) v = __hip_atomic_fetch_add(wsp<unsigned>(p, WS_CTL) + CW_Q + 64 * q, 1u, __ATOMIC_RELAXED, __HIP_MEMORY_SCOPE_AGENT);
    return (int)__builtin_amdgcn_readfirstlane(v);
}

template <class RMap>
__device__ __forceinline__ void transpose_item(const float* W, int K, int N, bf16_t* WT, int ldt, const float* kgain, LAS float* scr, int item, int lane, RMap rmap) {
    const int nblk = N / 32, kb = item / nblk, nb = item % nblk, k0 = 64 * kb, n0 = 32 * nb;
#pragma unroll
    for (int i = 0; i < 32; ++i) { const int kk = 2 * i + (lane >> 5); float v = W[(size_t)(k0 + kk) * N + n0 + (lane & 31)]; if (kgain) v *= kgain[k0 + kk]; scr[kk * 33 + (lane & 31)] = v; }
    asm volatile("s_waitcnt lgkmcnt(0)" ::: "memory");
    const int c = lane & 7; const int drow = rmap(n0);
#pragma unroll
    for (int j = 0; j < 4; ++j) { const int n = (lane >> 3) + 8 * j; const LAS float* s = scr + (8 * c) * 33 + n;
        u32x4 o; o.x = cvt_pk_bf16(s[0 * 33], s[1 * 33]); o.y = cvt_pk_bf16(s[2 * 33], s[3 * 33]); o.z = cvt_pk_bf16(s[4 * 33], s[5 * 33]); o.w = cvt_pk_bf16(s[6 * 33], s[7 * 33]);
        *(u32x4*)(WT + (size_t)(drow + n) * ldt + k0 + 8 * c) = o; }
    asm volatile("s_waitcnt lgkmcnt(0)" ::: "memory");
}
template <class RMap>
__device__ __forceinline__ void transpose_item_fp8(const float* W, int K, int N, unsigned char* WT, LAS float* scr, int item, int lane, RMap rmap) {
    const int nblk = N / 32, kb = item / nblk, nb = item % nblk, k0 = 64 * kb, n0 = 32 * nb;
#pragma unroll 8
    for (int i = 0; i < 32; ++i) { const int kk = 2 * i + (lane >> 5); scr[kk * 33 + (lane & 31)] = W[(size_t)(k0 + kk) * N + n0 + (lane & 31)] * 256.0f; }
    asm volatile("s_waitcnt lgkmcnt(0)" ::: "memory");
    const int c = lane & 7; const int drow = rmap(n0);
#pragma unroll
    for (int j = 0; j < 4; ++j) { const int n = (lane >> 3) + 8 * j; const LAS float* s = scr + (8 * c) * 33 + n;
        u32x2 o; o.x = pack_fp8x4(s[0 * 33], s[1 * 33], s[2 * 33], s[3 * 33]); o.y = pack_fp8x4(s[4 * 33], s[5 * 33], s[6 * 33], s[7 * 33]);
        *(u32x2*)(WT + (size_t)(drow + n) * K + k0 + 8 * c) = o; }
    asm volatile("s_waitcnt lgkmcnt(0)" ::: "memory");
}
template <bool FP8, class RMap>
__device__ __forceinline__ void transpose_item64(const float* W, int K, int N, void* WT, LAS float* scr, int item, int lane, RMap rmap) {
    const int nblk = N / 64, kb = item / nblk, nb = item % nblk, k0 = 64 * kb, n0 = 64 * nb;
    f32x4 v[16];
    const float* src = W + (size_t)(k0 + (lane >> 4)) * N + n0 + 4 * (lane & 15);
#pragma unroll
    for (int i = 0; i < 16; ++i) v[i] = __builtin_nontemporal_load((const f32x4*)(src + (size_t)(4 * i) * N));
#pragma unroll
    for (int i = 0; i < 16; ++i) { LAS float* d = scr + ((lane >> 4) + 4 * i) * 65 + 4 * (lane & 15); d[0] = v[i].x; d[1] = v[i].y; d[2] = v[i].z; d[3] = v[i].w; }
    asm volatile("s_waitcnt lgkmcnt(0)" ::: "memory");
    const int c = lane & 7; const int drow = rmap(n0);
#pragma unroll
    for (int j = 0; j < 8; ++j) { const int n = (lane >> 3) + 8 * j; const LAS float* s = scr + (8 * c) * 65 + n;
        if constexpr (FP8) { u32x2 o; o.x = pack_fp8x4(s[0] * 256.f, s[65] * 256.f, s[130] * 256.f, s[195] * 256.f); o.y = pack_fp8x4(s[260] * 256.f, s[325] * 256.f, s[390] * 256.f, s[455] * 256.f);
            *(u32x2*)((unsigned char*)WT + (size_t)(drow + n) * K + k0 + 8 * c) = o; }
        else { u32x4 o; o.x = cvt_pk_bf16(s[0], s[65]); o.y = cvt_pk_bf16(s[130], s[195]); o.z = cvt_pk_bf16(s[260], s[325]); o.w = cvt_pk_bf16(s[390], s[455]);
            *(u32x4*)((bf16_t*)WT + (size_t)(drow + n) * K + k0 + 8 * c) = o; } }
    asm volatile("s_waitcnt lgkmcnt(0)" ::: "memory");
}
struct RmIdent { __device__ int operator()(int n0) const { return n0; } };
struct RmWin { __device__ int operator()(int n0) const { return n0 < 1280 ? n0 : (n0 < 1312 ? n0 - 1280 + PC_BKR : n0 - 32); } };
struct RmGateUp { __device__ int operator()(int n0) const { const int u = n0 < DFF ? n0 : n0 - DFF; return 256 * (u >> 7) + (n0 < DFF ? 0 : 128) + (u & 127); } };

constexpr int DI_IN = (DM / 64) * (INC / 32), DI_OUT = (DM / 64) * (DM / 32), DI_UQ = (384 / 64) * (768 / 32), DI_UKV = (128 / 64) * (1024 / 32);
constexpr int DI_GU = (DM / 64) * (2 * DFF / 64), DI_DN = (DFF / 64) * (DM / 64);
constexpr int DI_PER_L = DI_IN + DI_OUT + DI_UQ + DI_UKV, DI_ALL = 2 * DI_PER_L + DI_GU + DI_DN;
__device__ __forceinline__ void dense_items(const Params& p, LAS unsigned char* lds, int wave, int lane, int lo, int hi, int wi, int nw) {
    LAS float* scr = (LAS float*)(lds + wave * 16896);
    constexpr int I_IN = DI_IN, I_OUT = DI_OUT, I_UQ = DI_UQ, I_GU = DI_GU, I_DN = DI_DN, PER_L = DI_PER_L;
    for (int it = lo + wi; it < hi; it += nw) {
        int r = it;
        if (r < 2 * PER_L) { const int l = r / PER_L; r -= l * PER_L;
            if (r < I_IN) { transpose_item(p.in[I_WIN] + (size_t)l * DM * INC, DM, INC, wsp<bf16_t>(p, WS_WIN) + (size_t)l * INCP * DM, DM, nullptr, scr, r, lane, RmWin()); continue; } r -= I_IN;
            if (r < I_OUT) { transpose_item(p.in[I_WOUT] + (size_t)l * DM * DM, DM, DM, wsp<bf16_t>(p, WS_WOUT) + (size_t)l * DM * DM, DM, nullptr, scr, r, lane, RmIdent()); continue; } r -= I_OUT;
            if (r < I_UQ) { transpose_item(p.in[I_BWUQ] + (size_t)l * 384 * 768, 384, 768, wsp<bf16_t>(p, WS_WUP) + (size_t)l * 1792 * 512, 512, p.in[I_BQAN] + l * 384, scr, r, lane, RmIdent()); continue; } r -= I_UQ;
            transpose_item(p.in[I_BWUKV] + (size_t)l * 128 * 1024, 128, 1024, wsp<bf16_t>(p, WS_WUP) + (size_t)l * 1792 * 512 + (size_t)768 * 512 + 384, 512, p.in[I_BKVAN] + l * 128, scr, r, lane, RmIdent()); continue; }
        r -= 2 * PER_L;
        if (r < I_GU) { transpose_item64<(FFN1_FP8 != 0)>(p.in[I_FGU], DM, 2 * DFF, wsp<unsigned char>(p, WS_WGU), scr, r, lane, RmGateUp()); continue; } r -= I_GU;
#if FFN2_FP8
        if (r < I_DN) { transpose_item64<true>(p.in[I_FD], DFF, DM, wsp<unsigned char>(p, WS_WD), scr, r, lane, RmIdent()); continue; } r -= I_DN;
#else
        if (r < I_DN) { transpose_item64<false>(p.in[I_FD], DFF, DM, wsp<bf16_t>(p, WS_WD), scr, r, lane, RmIdent()); continue; } r -= I_DN;
#endif
    }
}
__device__ __forceinline__ void p0_prologue(const Params& p, LAS unsigned char* lds, int G, int vcu, int wave) {
    const int lane = lane_id_asm(), tid = wave * 64 + lane;
    {
        LAS float* sv = (LAS float*)lds;
        LAS float* red = (LAS float*)(lds + 5 * DM * 4);
        bool loaded = false;
        for (int u = blockIdx.x; u < 2 * (MODW / 128); u += G) {
            if (!loaded) { for (int i = tid; i < 5 * DM; i += 512) { const int v = i / DM, k = i % DM; const float cv = v < 4 ? p.in[I_C][v * DM + k] : p.in[I_CCTX][k]; sv[i] = cv / (1.0f + __expf(-cv)); } loaded = true; __syncthreads(); }
            const int l = u / (MODW / 128), n0 = (u % (MODW / 128)) * 128;
            int hi = lane >> 5, c4 = lane & 31; asm volatile("" : "+v"(hi), "+v"(c4));
            const float* W = p.in[I_WADA] + (size_t)l * DM * MODW + n0 + 4 * c4 + (size_t)hi * MODW;
            float a[5][4];
#pragma unroll
            for (int v = 0; v < 5; ++v) { a[v][0] = 0.f; a[v][1] = 0.f; a[v][2] = 0.f; a[v][3] = 0.f; }
#pragma unroll 16
            for (int k = wave * 256; k < wave * 256 + 256; k += 2) { const f32x4 w = __builtin_nontemporal_load((const f32x4*)(W + (size_t)k * MODW));
#pragma unroll
                for (int v = 0; v < 5; ++v) { const float s = sv[v * DM + k + hi]; a[v][0] += s * w.x; a[v][1] += s * w.y; a[v][2] += s * w.z; a[v][3] += s * w.w; } }
#pragma unroll
            for (int v = 0; v < 5; ++v) {
#pragma unroll
                for (int j = 0; j < 4; ++j) a[v][j] = xhalf_sum(a[v][j]);
                if (hi == 0) *(LAS f32x4*)(red + (wave * 5 + v) * 128 + 4 * c4) = (f32x4){a[v][0], a[v][1], a[v][2], a[v][3]}; }
            __syncthreads();
            for (int i = tid; i < 5 * 128; i += 512) { const int v = i / 128, n = i % 128; float s = 0.f;
#pragma unroll
                for (int w = 0; w < 8; ++w) s += red[(w * 5 + v) * 128 + n];
                wsp<float>(p, WS_MOD)[((size_t)l * 5 + v) * MODW + n0 + n] = s + p.in[I_BADA][(size_t)l * MODW + n0 + n]; }
            __syncthreads();
        }
        __syncthreads();
    }
    const int gw = vcu * 8 + wave, NGW = G * 8;
    const unsigned zu = __float_as_uint(opaque_zero());
    for (int i = gw * 64 + lane; i < SEQ * 48; i += NGW * 64) {
        const int t = i / 48, j = i % 48; const float rw = (float)(t >> 6), cl = (float)(t & 63);
        if (j < 32) { const float fr = __powf(10000.0f, -(float)(j & 15) / 16.0f); const float ang = (j < 16 ? rw : cl) * fr; const float s = __sinf(ang), c = __cosf(ang);
            wsp<float>(p, WS_ROPE64)[(t * 32 + j) * 2] = c; wsp<float>(p, WS_ROPE64)[(t * 32 + j) * 2 + 1] = s; }
        else { const int jj = j - 32; const float fr = __powf(10000.0f, -(float)(jj & 7) / 8.0f); const float ang = (jj < 8 ? rw : cl) * fr; const float s = __sinf(ang), c = __cosf(ang);
            wsp<float>(p, WS_ROPE32)[(t * 16 + jj) * 2] = c; wsp<float>(p, WS_ROPE32)[(t * 16 + jj) * 2 + 1] = s; }
    }
    for (int i = gw * 64 + lane; i < 2 * 8 * 15 * 128; i += NGW * 64) {
        const int lh = i / (15 * 128), r = i % (15 * 128), dr = r >> 7, dc = (r & 127) - 48;
        wsp<float>(p, WS_RPB)[i] = (dc >= 0 && dc < 31) ? p.in[I_DRPB][(size_t)lh * 15 * 31 + dr * 31 + dc] * LOG2E : 0.f;
    }
    for (int i = gw * 64 + lane; i < 2 * (INCP - INC) * DM / 8; i += NGW * 64) {
        const int l = i / ((INCP - INC) * DM / 8), r = i % ((INCP - INC) * DM / 8);
        *(u32x4*)(wsp<bf16_t>(p, WS_WIN) + ((size_t)l * INCP + INC) * DM + (size_t)r * 8) = (u32x4){zu, zu, zu, zu};
    }
    for (int i = gw * 64 + lane; i < 2 * (768 * 16 + 1024 * 48); i += NGW * 64) {
        const int l = i / (768 * 16 + 1024 * 48), r = i % (768 * 16 + 1024 * 48);
        bf16_t* base = wsp<bf16_t>(p, WS_WUP) + (size_t)l * 1792 * 512;
        bf16_t* d = r < 768 * 16 ? base + (size_t)(r / 16) * 512 + 384 + (r % 16) * 8 : base + (size_t)(768 + (r - 768 * 16) / 48) * 512 + ((r - 768 * 16) % 48) * 8;
        *(u32x4*)d = (u32x4){zu, zu, zu, zu};
    }
    dense_items(p, lds, wave, lane, 0, DI_PER_L, gw, NGW);
}

constexpr int CONV_GU = (DM / 64) * (2 * DFF / 64), CONV_DN = (DFF / 64) * (DM / 64), NCONV = NEXP * (CONV_GU + CONV_DN);
struct ConvItem { const float* src; unsigned char* dst; int N, K; };
__device__ __forceinline__ void moe_item_load(const Params& p, int r, int lane, ConvItem& it, f32x4 (&v)[16]) {
    const int e = r / (CONV_GU + CONV_DN); r -= e * (CONV_GU + CONV_DN);
    const bool gu = r < CONV_GU; const int item = gu ? r : r - CONV_GU;
    const int N = gu ? 2 * DFF : DM, K = gu ? DM : DFF;
    const float* W = gu ? p.in[I_MGU] + (size_t)e * DM * 2 * DFF : p.in[I_MD] + (size_t)e * DFF * DM;
    unsigned char* WT = gu ? wsp<unsigned char>(p, WS_MGU) + (size_t)e * 2 * DFF * DM : wsp<unsigned char>(p, WS_MD) + (size_t)e * DM * DFF;
    const int nblk = N / 64, kb = item / nblk, nb = item % nblk, k0 = 64 * kb, n0 = 64 * nb;
    const int drow = gu ? RmGateUp()(n0) : n0;
    it.src = W + (size_t)(k0 + (lane >> 4)) * N + n0 + 4 * (lane & 15); it.N = N; it.K = K;
    it.dst = WT + (size_t)drow * K + k0 + 8 * (lane & 7);
#pragma unroll
    for (int i = 0; i < 16; ++i) v[i] = __builtin_nontemporal_load((const f32x4*)(it.src + (size_t)(4 * i) * N));
}
__device__ __forceinline__ void moe_item_finish(const ConvItem& it, const f32x4 (&v)[16], LAS float* scr, int lane) {
#pragma unroll
    for (int i = 0; i < 16; ++i) { LAS float* d = scr + ((lane >> 4) + 4 * i) * 65 + 4 * (lane & 15); d[0] = v[i].x; d[1] = v[i].y; d[2] = v[i].z; d[3] = v[i].w; }
    asm volatile("s_waitcnt lgkmcnt(0)" ::: "memory");
    const int c = lane & 7;
#pragma unroll
    for (int j = 0; j < 8; ++j) { const int n = (lane >> 3) + 8 * j; const LAS float* s = scr + (8 * c) * 65 + n;
        u32x2 o; o.x = pack_fp8x4(s[0] * 256.f, s[65] * 256.f, s[130] * 256.f, s[195] * 256.f); o.y = pack_fp8x4(s[260] * 256.f, s[325] * 256.f, s[390] * 256.f, s[455] * 256.f);
        *(u32x2*)(it.dst + (size_t)n * it.K) = o; }
    asm volatile("s_waitcnt lgkmcnt(0)" ::: "memory");
}
__device__ __forceinline__ void moe_convert_pipe(const Params& p, LAS unsigned char* lds, int wave, int lane, int lo, int hi, int wi, int nw) {
    LAS float* scr = (LAS float*)(lds + wave * 16896);
    int r = lo + wi;
    if (r >= hi) return;
    ConvItem ia, ib; f32x4 va[16], vb[16];
    moe_item_load(p, r, lane, ia, va);
    for (;;) {
        const int rb = r + nw;
        if (rb < hi) moe_item_load(p, rb, lane, ib, vb);
        moe_item_finish(ia, va, scr, lane);
        if (rb >= hi) break;
        const int ra = rb + nw;
        if (ra < hi) moe_item_load(p, ra, lane, ia, va);
        moe_item_finish(ib, vb, scr, lane);
        if (ra >= hi) break;
        r = ra;
    }
}

__device__ __forceinline__ void moe_convert_item(const Params& p, LAS float* scr, int r, int lane) {
    const int e = r / (CONV_GU + CONV_DN); r -= e * (CONV_GU + CONV_DN);
    if (r < CONV_GU) transpose_item64<true>(p.in[I_MGU] + (size_t)e * DM * 2 * DFF, DM, 2 * DFF, wsp<unsigned char>(p, WS_MGU) + (size_t)e * 2 * DFF * DM, scr, r, lane, RmGateUp());
    else transpose_item64<true>(p.in[I_MD] + (size_t)e * DFF * DM, DFF, DM, wsp<unsigned char>(p, WS_MD) + (size_t)e * DM * DFF, scr, r - CONV_GU, lane, RmIdent());
}
__device__ __forceinline__ void moe_convert(const Params& p, LAS unsigned char* lds, int wave, int lane, int lo, int hi, int wi, int nw) {
    LAS float* scr = (LAS float*)(lds + wave * 16896);
    for (int r = lo + wi; r < hi; r += nw) moe_convert_item(p, scr, r, lane);
}

__device__ __forceinline__ f32x4 ldx4(const void* row, int c, bool xb) {
    if (xb) { const u32x2 w = *((const u32x2*)row + c); return (f32x4){bf_lo(w.x), bf_hi(w.x), bf_lo(w.y), bf_hi(w.y)}; }
    return *((const f32x4*)row + c);
}
template <bool FP8 = false, bool XB = false>
__device__ __forceinline__ void norm_mod_row(const void* xrow, const float* gain, const float* sh, const float* sc, bf16_t* orow, int lane, f32x4 (&v)[8]) {
    float ss = 0.f;
    f32x4 gq[8], aq[8], sq[8];
#pragma unroll
    for (int j = 0; j < 8; ++j) { const int c = lane + 64 * j; v[j] = ldx4(xrow, c, XB); gq[j] = *((const f32x4*)gain + c); aq[j] = *((const f32x4*)sc + c); sq[j] = *((const f32x4*)sh + c); }
#pragma unroll
    for (int j = 0; j < 8; ++j) ss += (v[j].x * v[j].x + v[j].y * v[j].y) + (v[j].z * v[j].z + v[j].w * v[j].w);
    const float rstd = 1.0f / sqrtf(wave_sum(ss) * (1.0f / DM) + EPS);
#pragma unroll
    for (int j = 0; j < 8; ++j) { const int c = lane + 64 * j; const f32x4 g = gq[j], a = aq[j], s = sq[j];
        v[j] = (v[j] * rstd * g) * (a + 1.0f) + s;
        if constexpr (FP8) { *((unsigned*)orow + c) = pack_fp8x4(v[j].x, v[j].y, v[j].z, v[j].w); }
        else { u32x2 w; w.x = cvt_pk_bf16(v[j].x, v[j].y); w.y = cvt_pk_bf16(v[j].z, v[j].w); *((u32x2*)orow + c) = w; } }
}
template <bool FP8 = false, bool XB = false>
__device__ __forceinline__ void norm_mod_row2(const void* xa, const float* gain, const float* sh, const float* sc, bf16_t* oa, int opitch_elems, int lane) {
    f32x4 va[8], vb[8], g[8], a[8], s[8];
#pragma unroll
    for (int j = 0; j < 8; ++j) { const int c = lane + 64 * j; va[j] = ldx4(xa, c, XB); vb[j] = ldx4((const char*)xa + (size_t)DM * (XB ? 2 : 4), c, XB);
        g[j] = *((const f32x4*)gain + c); a[j] = *((const f32x4*)sc + c); s[j] = *((const f32x4*)sh + c); }
    float sa = 0.f, sb = 0.f;
#pragma unroll
    for (int j = 0; j < 8; ++j) { sa += (va[j].x * va[j].x + va[j].y * va[j].y) + (va[j].z * va[j].z + va[j].w * va[j].w); sb += (vb[j].x * vb[j].x + vb[j].y * vb[j].y) + (vb[j].z * vb[j].z + vb[j].w * vb[j].w); }
    const float ra = 1.0f / sqrtf(wave_sum(sa) * (1.0f / DM) + EPS), rb = 1.0f / sqrtf(wave_sum(sb) * (1.0f / DM) + EPS);
    bf16_t* ob = oa + opitch_elems;
#pragma unroll
    for (int j = 0; j < 8; ++j) { const int c = lane + 64 * j; const f32x4 m1 = g[j] * (a[j] + 1.0f);
        const f32x4 ya = (va[j] * ra) * m1 + s[j], yb = (vb[j] * rb) * m1 + s[j];
        if constexpr (FP8) { *((unsigned*)oa + c) = pack_fp8x4(ya.x, ya.y, ya.z, ya.w); *((unsigned*)ob + c) = pack_fp8x4(yb.x, yb.y, yb.z, yb.w); }
        else { u32x2 w; w.x = cvt_pk_bf16(ya.x, ya.y); w.y = cvt_pk_bf16(ya.z, ya.w); *((u32x2*)oa + c) = w; w.x = cvt_pk_bf16(yb.x, yb.y); w.y = cvt_pk_bf16(yb.z, yb.w); *((u32x2*)ob + c) = w; } }
}
struct HeadKind { int src, nh; const float* gain; int rope; float scale; bf16_t* dst; int keymajor; };
__device__ __forceinline__ void prep_heads_load(const Params& p, const HeadKind& k, int row, int lane, u32x2 (&w)[2]) {
    const int g = lane >> 4, l16 = lane & 15;
    const bf16_t* prow = wsp<bf16_t>(p, WS_P) + (size_t)row * INCP + k.src + 4 * l16;
#pragma unroll
    for (int it = 0; it < 2; ++it) { const int h = min(4 * it + g, k.nh - 1); w[it] = *(const u32x2*)(prow + h * 64); }
}
__device__ __forceinline__ void prep_heads_compute(const Params& p, const HeadKind& k, int row, int lane, const u32x2 (&w)[2], const f32x4 (&rope)[2], const f32x4 gn) {
    const int g = lane >> 4, l16 = lane & 15;
    int b, pos; row_bp(row, b, pos);
    const bool dorope = k.rope && row < ML;
#pragma unroll
    for (int it = 0; it < 2; ++it) {
        const int h = 4 * it + g;
        if (4 * it < k.nh) {
            float x[4] = {bf_lo(w[it].x), bf_hi(w[it].x), bf_lo(w[it].y), bf_hi(w[it].y)};
            if (k.gain) {
                float ss = (x[0] * x[0] + x[1] * x[1]) + (x[2] * x[2] + x[3] * x[3]);
                ss = row_sum16(ss);
                const float r = 1.0f / sqrtf(ss * (1.0f / 64.0f) + EPS);
                x[0] *= r * gn.x; x[1] *= r * gn.y; x[2] *= r * gn.z; x[3] *= r * gn.w;
            }
            if (k.rope) {
                float y[4];
#pragma unroll
                for (int e = 0; e < 4; ++e) y[e] = dpp_ror<8>(x[e]);
                if (dorope) {
                    const float cs[8] = {rope[0].x, rope[0].y, rope[0].z, rope[0].w, rope[1].x, rope[1].y, rope[1].z, rope[1].w};
#pragma unroll
                    for (int e = 0; e < 4; ++e) { const float c = cs[2 * e], s = cs[2 * e + 1];
                        x[e] = l16 < 8 ? x[e] * c - y[e] * s : y[e] * s + x[e] * c; }
                }
            }
            if (h < k.nh) {
                u32x2 o; o.x = cvt_pk_bf16(x[0] * k.scale, x[1] * k.scale); o.y = cvt_pk_bf16(x[2] * k.scale, x[3] * k.scale);
                bf16_t* d = k.keymajor == 1 ? k.dst + (((size_t)(b * k.nh + h)) * (KEYS / 32) + (pos >> 5)) * 2048 + (l16 >> 1) * 256 + (pos & 31) * 8 + 4 * (l16 & 1)
                          : k.keymajor == 2 ? k.dst + (((size_t)(b * k.nh + h)) * (KEYS / 64) + (pos >> 6)) * 4096 + (l16 >> 1) * 512 + (pos & 63) * 8 + 4 * (l16 & 1)
                                            : k.dst + (size_t)row * (k.nh * 64) + h * 64 + 4 * l16;
                *(u32x2*)d = o;
            }
        }
    }
}

struct TrKind { const bf16_t* src; int spitch, scol, nh; const float* rowscale; int rope; float scale; int decay; bf16_t* dst; bf16_t* dst2; float lgf2, lgr2; int tiled; };
__device__ __forceinline__ void tr_store_tiled32(LAS bf16_t* scr, bf16_t* img, int lane) {
    unsigned w[32];
#pragma unroll
    for (int t = 0; t < 32; ++t) w[t] = (unsigned)scr[(2 * t) * 72 + lane] | ((unsigned)scr[(2 * t + 1) * 72 + lane] << 16);
#pragma unroll
    for (int q = 0; q < 8; ++q) *(u32x4*)(img + (q >> 2) * 2048 + ((q & 3) * 64 + lane) * 8) = (u32x4){w[4 * q], w[4 * q + 1], w[4 * q + 2], w[4 * q + 3]};
}
__device__ __forceinline__ void tr_store_tiled(LAS bf16_t* scr, bf16_t* img, int lane) {
    unsigned w[32];
#pragma unroll
    for (int t = 0; t < 32; ++t) w[t] = (unsigned)scr[(2 * t) * 72 + lane] | ((unsigned)scr[(2 * t + 1) * 72 + lane] << 16);
#pragma unroll
    for (int q = 0; q < 8; ++q) *(u32x4*)(img + (q * 64 + lane) * 8) = (u32x4){w[4 * q], w[4 * q + 1], w[4 * q + 2], w[4 * q + 3]};
}
__device__ __forceinline__ void tr_store(LAS bf16_t* scr, bf16_t* dst, int lane) {
    unsigned w[32];
#pragma unroll
    for (int t = 0; t < 32; ++t) w[t] = (unsigned)scr[(2 * t) * 72 + lane] | ((unsigned)scr[(2 * t + 1) * 72 + lane] << 16);
#pragma unroll
    for (int q = 0; q < 8; ++q) *(u32x4*)(dst + (size_t)lane * KEYS + 8 * q) = (u32x4){w[4 * q], w[4 * q + 1], w[4 * q + 2], w[4 * q + 3]};
}
__device__ __forceinline__ void prep_transpose_unit(const Params& p, const TrKind& k, int b, int h, int tt, LAS bf16_t* scr, int lane) {
    const int p0 = 64 * tt, c8 = lane & 7;
    const bool latent = p0 < SEQ;
    float x[8][8];
#pragma unroll
    for (int i = 0; i < 8; ++i) {
        const int tok = (lane >> 3) + 8 * i, row = bp_row(b, p0 + tok);
        const u32x4 w = *(const u32x4*)(k.src + (size_t)row * k.spitch + k.scol + h * (k.nh > 0 ? 64 : 128) + 8 * c8);
        const float rs = (k.rowscale ? k.rowscale[row] : 1.0f) * k.scale;
        x[i][0] = bf_lo(w.x) * rs; x[i][1] = bf_hi(w.x) * rs; x[i][2] = bf_lo(w.y) * rs; x[i][3] = bf_hi(w.y) * rs;
        x[i][4] = bf_lo(w.z) * rs; x[i][5] = bf_hi(w.z) * rs; x[i][6] = bf_lo(w.w) * rs; x[i][7] = bf_hi(w.w) * rs;
        if (k.rope) {
            float y[8];
#pragma unroll
            for (int e = 0; e < 8; ++e) y[e] = shfl_idx(x[i][e], lane ^ 4);
            if (latent) {
                const float* cs = wsp<float>(p, WS_ROPE64) + ((size_t)(p0 + tok) * 32 + 8 * (c8 & 3)) * 2;
#pragma unroll
                for (int e = 0; e < 8; ++e) { const float c = cs[2 * e], s = cs[2 * e + 1]; x[i][e] = c8 < 4 ? x[i][e] * c - y[e] * s : y[e] * s + x[i][e] * c; }
            }
        }
    }
    const int nh = k.nh > 0 ? k.nh : -k.nh;
    for (int pass = 0; pass < (k.decay ? 2 : 1); ++pass) {
#pragma unroll
        for (int i = 0; i < 8; ++i) {
            const int tok = (lane >> 3) + 8 * i; float wgt = 1.0f;
            if (k.decay) { const int pc = (p0 + tok) & 127; wgt = pass == 0 ? fexp2(k.lgf2 * (float)(127 - pc)) : fexp2(k.lgr2 * (float)pc); }
            u32x4 o; o.x = cvt_pk_bf16(x[i][0] * wgt, x[i][1] * wgt); o.y = cvt_pk_bf16(x[i][2] * wgt, x[i][3] * wgt); o.z = cvt_pk_bf16(x[i][4] * wgt, x[i][5] * wgt); o.w = cvt_pk_bf16(x[i][6] * wgt, x[i][7] * wgt);
            *(LAS u32x4*)(scr + tok * 72 + 8 * c8) = o;
        }
        asm volatile("s_waitcnt lgkmcnt(0)" ::: "memory");
        if (k.tiled == 1) tr_store_tiled(scr, k.dst + ((size_t)(b * nh + h) * (KEYS / 64) + tt) * 4096, lane);
        else tr_store_tiled32(scr, (pass == 0 ? k.dst : k.dst2) + ((size_t)(b * nh + h) * (KEYS / 32) + 2 * tt) * 2048, lane);
        asm volatile("s_waitcnt lgkmcnt(0)" ::: "memory");
    }
}

struct MlaRegs { unsigned cq[3], ckv; u32x2 wk[4]; f32x4 rope[2]; };
__device__ __forceinline__ void prep_mla_load(const Params& p, int row, int lane, MlaRegs& R) {
    const bf16_t* prow = wsp<bf16_t>(p, WS_P) + (size_t)row * INCP;
    const int g = lane >> 5, l32 = lane & 31; const bool act = l32 < 24; const int d0 = 4 * l32;
#pragma unroll
    for (int j = 0; j < 3; ++j) R.cq[j] = *(const unsigned*)(prow + PC_BQ + 2 * (lane + 64 * j));
    R.ckv = *(const unsigned*)(prow + PC_BKV + 2 * lane);
    const int dd = act ? d0 : 0;
#pragma unroll
    for (int i = 0; i < 4; ++i) { const int h = 2 * i + g;
        R.wk[i] = l32 < 16 || !act ? *(const u32x2*)(wsp<bf16_t>(p, WS_UPRAW) + (size_t)row * 1792 + 768 + h * 128 + dd) : *(const u32x2*)(prow + PC_BKR + (d0 - 64)); }
    { const int pos = row < ML ? (row & (SEQ - 1)) : 0;
      const float* cs = wsp<float>(p, WS_ROPE32) + ((size_t)pos * 16 + (d0 >= 64 && act ? (d0 - 64) & 15 : 0)) * 2; R.rope[0] = *(const f32x4*)cs; R.rope[1] = *(const f32x4*)(cs + 4); }
}
__device__ __forceinline__ void prep_mla_compute(const Params& p, int l, int row, int lane, const MlaRegs& R, const f32x4 gq, const f32x4 gk) {
    int b, pos; row_bp(row, b, pos);
    float sq = 0.f, skv = 0.f;
    {
#pragma unroll
      for (int j = 0; j < 3; ++j) { const float a = bf_lo(R.cq[j]), c = bf_hi(R.cq[j]); sq += a * a + c * c; }
      const float a = bf_lo(R.ckv), c = bf_hi(R.ckv); skv = a * a + c * c; }
    sq = wave_sum(sq); skv = wave_sum(skv);
    const float rq = 1.0f / sqrtf(sq * (1.0f / 384.0f) + EPS), rkv = 1.0f / sqrtf(skv * (1.0f / 128.0f) + EPS);
    if (lane == 0) { wsp<float>(p, WS_RKV)[row] = rkv; wsp<float>(p, WS_RQ)[row] = rq; }
    const int g = lane >> 5, l32 = lane & 31; const bool act = l32 < 24; const int d0 = 4 * l32;
    const bool latent = row < ML;
    const float qscale = 0.10206207261596575f * LOG2E;
    const float cs[8] = {R.rope[0].x, R.rope[0].y, R.rope[0].z, R.rope[0].w, R.rope[1].x, R.rope[1].y, R.rope[1].z, R.rope[1].w};
    const int plane = (lane & 32) | (l32 < 20 ? l32 + 4 : l32 - 4);
#pragma unroll
    for (int i4 = 0; i4 < 4; ++i4) {
        const int h = 2 * i4 + g;
        { float x[4] = {0.f, 0.f, 0.f, 0.f};
          if (act) { const u32x2 w = R.wk[i4]; const float sc = l32 < 16 ? rkv : 1.0f; x[0] = bf_lo(w.x) * sc; x[1] = bf_hi(w.x) * sc; x[2] = bf_lo(w.y) * sc; x[3] = bf_hi(w.y) * sc; }
          float ss = (x[0] * x[0] + x[1] * x[1]) + (x[2] * x[2] + x[3] * x[3]);
          ss = row_sum16(ss); ss += shfl_idx(ss, lane ^ 16);
          const float r = 1.0f / sqrtf(ss * (1.0f / 96.0f) + EPS);
          if (act) { const f32x4 gn = gk; x[0] *= r * gn.x; x[1] *= r * gn.y; x[2] *= r * gn.z; x[3] *= r * gn.w; }
          float y[4];
#pragma unroll
          for (int e = 0; e < 4; ++e) y[e] = shfl_idx(x[e], plane);
          if (latent && l32 >= 16 && act) {
#pragma unroll
              for (int e = 0; e < 4; ++e) { const float c = cs[2 * e], s = cs[2 * e + 1]; x[e] = l32 < 20 ? x[e] * c - y[e] * s : y[e] * s + x[e] * c; } }
          if (act) { u32x2 o; o.x = cvt_pk_bf16(x[0], x[1]); o.y = cvt_pk_bf16(x[2], x[3]);
              *(u32x2*)(wsp<bf16_t>(p, WS_KB) + ((((size_t)(b * 8 + h)) * (KEYS / 64) + (pos >> 6)) * 12 + (d0 >> 3)) * 512 + (pos & 63) * 8 + (d0 & 7)) = o; } }
    }
}
__device__ __forceinline__ int permkey(int m) { const int a = m >> 3, h = (m >> 2) & 1, c = m & 3; return 16 * (a >> 1) + 8 * h + c + 4 * (a & 1); }
__device__ __forceinline__ bf16x8 pack8(const f32x16& s, int o) {
    u32x4 w; w.x = cvt_pk_bf16(s[o], s[o + 1]); w.y = cvt_pk_bf16(s[o + 2], s[o + 3]); w.z = cvt_pk_bf16(s[o + 4], s[o + 5]); w.w = cvt_pk_bf16(s[o + 6], s[o + 7]);
    return __builtin_bit_cast(bf16x8, w);
}
template <bool GAIN, bool ROPE>
__device__ __forceinline__ void load_q_prepped(const bf16_t* qrow, const float* gain, const float* rope, float scale, int hi, bf16x8 (&qf)[4]) {
    u32x4 raw[4]; f32x4 gn[4][2], cs[2][4];
#pragma unroll
    for (int d0 = 0; d0 < 4; ++d0) raw[d0] = *(const u32x4*)(qrow + 16 * d0 + 8 * hi);
    if constexpr (GAIN) {
#pragma unroll
        for (int d0 = 0; d0 < 4; ++d0) { gn[d0][0] = *(const f32x4*)(gain + 16 * d0 + 8 * hi); gn[d0][1] = *(const f32x4*)(gain + 16 * d0 + 8 * hi + 4); } }
    if constexpr (ROPE) {
#pragma unroll
        for (int dd = 0; dd < 2; ++dd)
#pragma unroll
            for (int j = 0; j < 4; ++j) cs[dd][j] = *(const f32x4*)(rope + (16 * dd + 8 * hi) * 2 + 4 * j); }
    float x[4][8];
#pragma unroll
    for (int d0 = 0; d0 < 4; ++d0) { x[d0][0] = bf_lo(raw[d0].x); x[d0][1] = bf_hi(raw[d0].x); x[d0][2] = bf_lo(raw[d0].y); x[d0][3] = bf_hi(raw[d0].y);
        x[d0][4] = bf_lo(raw[d0].z); x[d0][5] = bf_hi(raw[d0].z); x[d0][6] = bf_lo(raw[d0].w); x[d0][7] = bf_hi(raw[d0].w); }
    if constexpr (GAIN) {
        float ss = 0.f;
#pragma unroll
        for (int d0 = 0; d0 < 4; ++d0)
#pragma unroll
            for (int e = 0; e < 8; e += 2) ss += x[d0][e] * x[d0][e] + x[d0][e + 1] * x[d0][e + 1];
        ss = xhalf_sum(ss);
        const float r = 1.0f / sqrtf(ss * (1.0f / 64.0f) + EPS);
#pragma unroll
        for (int d0 = 0; d0 < 4; ++d0)
#pragma unroll
            for (int e = 0; e < 8; ++e) x[d0][e] *= r * gn[d0][e >> 2][e & 3];
    }
    if constexpr (ROPE) {
#pragma unroll
        for (int dd = 0; dd < 2; ++dd)
#pragma unroll
            for (int e = 0; e < 8; ++e) { const float c = cs[dd][e >> 1][2 * (e & 1)], s = cs[dd][e >> 1][2 * (e & 1) + 1]; const float lo = x[dd][e], up = x[dd + 2][e];
                x[dd][e] = lo * c - up * s; x[dd + 2][e] = lo * s + up * c; }
    }
#pragma unroll
    for (int d0 = 0; d0 < 4; ++d0) { u32x4 w; w.x = cvt_pk_bf16(x[d0][0] * scale, x[d0][1] * scale); w.y = cvt_pk_bf16(x[d0][2] * scale, x[d0][3] * scale);
        w.z = cvt_pk_bf16(x[d0][4] * scale, x[d0][5] * scale); w.w = cvt_pk_bf16(x[d0][6] * scale, x[d0][7] * scale); qf[d0] = __builtin_bit_cast(bf16x8, w); }
}
struct AttnArgs {
    const bf16_t* Q; int qpitch;
    const float* qgain; const float* qrope; float qscale;
    const bf16_t* K;
    const bf16_t* Vt;
    bf16_t* O; int opitch;
    int t0, t1, c0, c1;
    float sink2;
    int q0, qrow;
    const float* rpb;
};
template <int DQK, int MODE>
__device__ __forceinline__ void attn_wave(const AttnArgs& a, int lane) {
    constexpr int ND = DQK / 16;
    const int r32 = lane & 31, hi = lane >> 5;
    const float NEG = -__builtin_inff();
    bf16x8 qf[ND];
    load_q_prepped<true, MODE == 1>(a.Q + (size_t)r32 * a.qpitch, a.qgain, a.qrope + r32 * 64, a.qscale, hi, qf);
    static_assert(DQK == 64, "tiled 32-key images: K [8 chunks][32 rows][8], V^T [4 kc][64 d][8]");
    const __amdgpu_buffer_rsrc_t krs = __builtin_amdgcn_make_buffer_rsrc((void*)a.K, 0, 0x7ffffff0, 0x00020000), vrs = __builtin_amdgcn_make_buffer_rsrc((void*)a.Vt, 0, 0x7ffffff0, 0x00020000);
    const int klo = (hi * 256 + permkey(r32) * 8) * 2, vlo = ((hi * 64 + r32) * 8) * 2;
#define AW_K(t, d0) __builtin_bit_cast(bf16x8, __builtin_amdgcn_raw_buffer_load_b128(krs, klo, (t) * 4096 + (d0) * 1024, 0))
#define AW_V(t, s, d0) __builtin_bit_cast(bf16x8, __builtin_amdgcn_raw_buffer_load_b128(vrs, vlo, (t) * 4096 + (s) * 2048 + (d0) * 512, 0))
    f32x16 o0, o1; const float zr = opaque_zero();
#pragma unroll
    for (int r = 0; r < 16; ++r) { o0[r] = zr; o1[r] = zr; }
    float m_run = 0.f, l_run = 0.f;
    const int n1 = a.t1 - a.t0, n = n1 + (a.c1 - a.c0);
#define AW_TILE(ii) ((ii) < n1 ? a.t0 + (ii) : a.c0 + ((ii) - n1))
    bf16x8 kf[ND], vf[2][2], k1[ND], v1[2][2], k2[ND], v2[2][2];
    { const int tA = AW_TILE(0), tB = AW_TILE(n > 1 ? 1 : 0);
#pragma unroll
      for (int d0 = 0; d0 < ND; ++d0) { kf[d0] = AW_K(tA, d0); k1[d0] = AW_K(tB, d0); }
#pragma unroll
      for (int d0 = 0; d0 < 2; ++d0)
#pragma unroll
          for (int s = 0; s < 2; ++s) { vf[d0][s] = AW_V(tA, s, d0); v1[d0][s] = AW_V(tB, s, d0); } }
    auto step = [&](int i, bf16x8 (&kf)[ND], bf16x8 (&vf)[2][2], bf16x8 (&kn)[ND], bf16x8 (&vn)[2][2]) __attribute__((always_inline)) {
        const int cur = AW_TILE(i); const bool masked = i < n1;
        { const int t2 = AW_TILE(i + 2 < n ? i + 2 : n - 1);
#pragma unroll
          for (int d0 = 0; d0 < ND; ++d0) kn[d0] = AW_K(t2, d0);
#pragma unroll
          for (int d0 = 0; d0 < 2; ++d0)
#pragma unroll
              for (int s = 0; s < 2; ++s) vn[d0][s] = AW_V(t2, s, d0); }
        float bias[16];
        if (MODE == 2 && masked) {
            const int kr = cur >> 1, w = a.q0 + r32, cb = (cur & 1) * 32 + 8 * hi;
            const float* rp = a.rpb + (kr - a.qrow + 7) * 128 + (cb - w + 15 + 48);
#pragma unroll
            for (int r = 0; r < 16; ++r) bias[r] = rp[16 * (r >> 3) + (r & 7)];
        }
        f32x16 st;
#pragma unroll
        for (int r = 0; r < 16; ++r) st[r] = -m_run;
#pragma unroll
        for (int d0 = 0; d0 < ND; ++d0) st = __builtin_amdgcn_mfma_f32_32x32x16_bf16(kf[d0], qf[d0], st, 0, 0, 0);
        if (MODE == 1 && masked) {
            const int dt = cur * 32 - a.q0;
            if (dt <= -128 || dt >= 128) {
                const int dq = a.q0 + r32 - cur * 32 - 8 * hi;
#pragma unroll
                for (int r = 0; r < 16; ++r) { const int dd = dq - (16 * (r >> 3) + (r & 7)); if (dd > 128 || dd < -128) st[r] = NEG; }
            }
        }
        if (MODE == 2 && masked) {
            const int kr = cur >> 1, w = a.q0 + r32; const int cs = min(max(w - 8, 0), 48);
            const int cb = (cur & 1) * 32 + 8 * hi;
            const int c0 = cb - cs;
#pragma unroll
            for (int r = 0; r < 16; ++r) { const int o = 16 * (r >> 3) + (r & 7); st[r] = ((unsigned)(c0 + o) < 16u) ? st[r] + bias[r] : NEG; }
        }
        float mx = st[0];
#pragma unroll
        for (int r = 1; r < 16; ++r) mx = fmaxf(mx, st[r]);
        mx = xhalf_max(mx);
        if (__any(mx > 8.0f)) {
            const float d = fmaxf(mx, 0.f), f = fexp2(-d);
            m_run += d; l_run *= f;
#pragma unroll
            for (int r = 0; r < 16; ++r) { o0[r] *= f; o1[r] *= f; st[r] -= d; }
        }
        float ps = 0.f;
#pragma unroll
        for (int r = 0; r < 16; ++r) { st[r] = fexp2(st[r]); ps += st[r]; }
        l_run += ps;
        const bf16x8 p0 = pack8(st, 0), p1 = pack8(st, 8);
        o0 = __builtin_amdgcn_mfma_f32_32x32x16_bf16(vf[0][0], p0, o0, 0, 0, 0);
        o0 = __builtin_amdgcn_mfma_f32_32x32x16_bf16(vf[0][1], p1, o0, 0, 0, 0);
        o1 = __builtin_amdgcn_mfma_f32_32x32x16_bf16(vf[1][0], p0, o1, 0, 0, 0);
        o1 = __builtin_amdgcn_mfma_f32_32x32x16_bf16(vf[1][1], p1, o1, 0, 0, 0);
    };
    for (int i = 0; i < n; i += 3) { step(i, kf, vf, k2, v2); if (i + 1 < n) step(i + 1, k1, v1, kf, vf); if (i + 2 < n) step(i + 2, k2, v2, k1, v1); }
#undef AW_TILE
#undef AW_K
#undef AW_V
    l_run = xhalf_sum(l_run);
    if (a.sink2 != NEG) l_run += fexp2(a.sink2 - m_run);
    const float inv = 1.0f / l_run;
    bf16_t* orow = a.O + (size_t)r32 * a.opitch + 4 * hi;
#pragma unroll
    for (int g = 0; g < 4; ++g) {
        u32x2 w0, w1;
        w0.x = cvt_pk_bf16(o0[4 * g] * inv, o0[4 * g + 1] * inv); w0.y = cvt_pk_bf16(o0[4 * g + 2] * inv, o0[4 * g + 3] * inv);
        w1.x = cvt_pk_bf16(o1[4 * g] * inv, o1[4 * g + 1] * inv); w1.y = cvt_pk_bf16(o1[4 * g + 2] * inv, o1[4 * g + 3] * inv);
        *(u32x2*)(orow + 8 * g) = w0; *(u32x2*)(orow + 32 + 8 * g) = w1;
    }
}

__device__ __forceinline__ void ret_c1_unit(const Params& p, int chain, int c, int lane) {
    const int r32 = lane & 31, hi = lane >> 5, bh = chain >> 1, dir = chain & 1;
    const bf16_t* kw = wsp<bf16_t>(p, dir ? WS_KWR : WS_KWF) + ((size_t)bh * (KEYS / 32) + 4 * c) * 2048 + (hi * 64 + r32) * 8;
    const bf16_t* vt = wsp<bf16_t>(p, WS_VTC) + ((size_t)bh * (KEYS / 32) + 4 * c) * 2048 + (hi * 64 + r32) * 8;
    f32x16 acc[2][2]; const float zr = opaque_zero();
#pragma unroll
    for (int mi = 0; mi < 2; ++mi)
#pragma unroll
        for (int ni = 0; ni < 2; ++ni)
#pragma unroll
            for (int r = 0; r < 16; ++r) acc[mi][ni][r] = zr;
    bf16x8 af[8][2], bfr[8][2];
#pragma unroll
    for (int s = 0; s < 8; ++s)
#pragma unroll
        for (int mi = 0; mi < 2; ++mi) { af[s][mi] = *(const bf16x8*)(kw + (s >> 1) * 2048 + (s & 1) * 1024 + mi * 256); bfr[s][mi] = *(const bf16x8*)(vt + (s >> 1) * 2048 + (s & 1) * 1024 + mi * 256); }
#pragma unroll
    for (int s = 0; s < 8; ++s)
#pragma unroll
        for (int mi = 0; mi < 2; ++mi)
#pragma unroll
            for (int ni = 0; ni < 2; ++ni) acc[mi][ni] = __builtin_amdgcn_mfma_f32_32x32x16_bf16(af[s][mi], bfr[s][ni], acc[mi][ni], 0, 0, 0);
    float* out = wsp<float>(p, WS_KVST) + ((size_t)chain * 34 + c) * 4096;
#pragma unroll
    for (int mi = 0; mi < 2; ++mi)
#pragma unroll
        for (int ni = 0; ni < 2; ++ni)
#pragma unroll
            for (int g = 0; g < 4; ++g)
                *(f32x4*)(out + (size_t)(r32 + 32 * ni) * 64 + 32 * mi + 8 * g + 4 * hi) = (f32x4){acc[mi][ni][4 * g], acc[mi][ni][4 * g + 1], acc[mi][ni][4 * g + 2], acc[mi][ni][4 * g + 3]};
}
__device__ __forceinline__ void ret_c2(const Params& p, int l, int gtid, int gthreads) {
    for (int idx = gtid; idx < 64 * 4096; idx += gthreads) {
        const int chain = idx >> 12, e = idx & 4095, dir = chain & 1, h = (chain >> 1) & 7;
        const float lg = -__expf(p.in[I_CLD][(l * 2 + dir) * 8 + h]);
        const float dec = __expf(lg * 128.0f);
        const float* kv = wsp<float>(p, WS_KVST) + (size_t)chain * 34 * 4096 + e;
        bf16_t* sp = wsp<bf16_t>(p, WS_SPREV) + (size_t)chain * 34 * 4096 + e;
        float kvv[34];
#pragma unroll
        for (int st = 0; st < 34; ++st) { const int cc = dir == 0 ? (st < 2 ? 32 + st : st - 2) : 33 - st; kvv[st] = kv[(size_t)cc * 4096]; }
        float s = 0.f;
#pragma unroll
        for (int st = 0; st < 34; ++st) { const int cc = dir == 0 ? (st < 2 ? 32 + st : st - 2) : 33 - st; sp[(size_t)cc * 4096] = (bf16_t)(cvt_pk_bf16(s, 0.f) & 0xffffu); s = s * dec + kvv[st]; }
    }
}
__device__ __forceinline__ void ret_c3_unit(const Params& p, int l, int bh, int c, int qq, int lane) {
    const int r32 = lane & 31, hi = lane >> 5, b = bh >> 3, h = bh & 7;
    const int row0 = c < 32 ? b * SEQ + 128 * c + 32 * qq : ML + b * CTXL + 128 * (c - 32) + 32 * qq;
    const float lgf2 = -__expf(p.in[I_CLD][(l * 2 + 0) * 8 + h]) * LOG2E, lgr2 = -__expf(p.in[I_CLD][(l * 2 + 1) * 8 + h]) * LOG2E;
    bf16x8 qf[4];
    if (c < 32) load_q_prepped<false, true>(wsp<bf16_t>(p, WS_P) + (size_t)(row0 + r32) * INCP + PC_CQ + h * 64, nullptr, wsp<float>(p, WS_ROPE64) + (size_t)((row0 + r32) & (SEQ - 1)) * 64, 1.0f, hi, qf);
    else load_q_prepped<false, false>(wsp<bf16_t>(p, WS_P) + (size_t)(row0 + r32) * INCP + PC_CQ + h * 64, nullptr, nullptr, 1.0f, hi, qf);
    const bf16_t* kp = wsp<bf16_t>(p, WS_KC) + ((size_t)bh * (KEYS / 32) + 4 * c) * 2048 + hi * 256 + permkey(r32) * 8;
    const bf16_t* vp = wsp<bf16_t>(p, WS_VTC) + ((size_t)bh * (KEYS / 32) + 4 * c) * 2048 + (hi * 64 + r32) * 8;
    bf16x8 spa[2][2][4]; u32x2 gq0[4], gq1[4];
    { const bf16_t* gp0 = wsp<bf16_t>(p, WS_P) + (size_t)(row0 + r32) * INCP + PC_CG + h * 64 + 4 * hi;
#pragma unroll
      for (int dir = 0; dir < 2; ++dir) { const bf16_t* sp = wsp<bf16_t>(p, WS_SPREV) + (((size_t)(bh * 2 + dir)) * 34 + c) * 4096 + (size_t)r32 * 64 + 8 * hi;
#pragma unroll
          for (int s = 0; s < 4; ++s) { spa[dir][0][s] = *(const bf16x8*)(sp + 16 * s); spa[dir][1][s] = *(const bf16x8*)(sp + 32 * 64 + 16 * s); } }
#pragma unroll
      for (int g = 0; g < 4; ++g) { gq0[g] = *(const u32x2*)(gp0 + 8 * g); gq1[g] = *(const u32x2*)(gp0 + 32 + 8 * g); } }
    f32x16 o0, o1; const float zr = opaque_zero();
#pragma unroll
    for (int r = 0; r < 16; ++r) { o0[r] = zr; o1[r] = zr; }
    const int il = 32 * qq + r32;
#pragma unroll 1
    for (int kt = 0; kt < 4; ++kt) {
        f32x16 st;
#pragma unroll
        for (int r = 0; r < 16; ++r) st[r] = zr;
#pragma unroll
        for (int d0 = 0; d0 < 4; ++d0) { const bf16x8 kf = *(const bf16x8*)(kp + kt * 2048 + d0 * 512); st = __builtin_amdgcn_mfma_f32_32x32x16_bf16(kf, qf[d0], st, 0, 0, 0); }
        const int dq = il - 32 * kt - 8 * hi;
#pragma unroll
        for (int r = 0; r < 16; ++r) { const int dd = dq - (16 * (r >> 3) + (r & 7));
            const float dec = dd > 0 ? fexp2(lgf2 * (float)dd) : (dd == 0 ? 2.0f : fexp2(lgr2 * (float)(-dd)));
            st[r] *= dec; }
        const bf16x8 p0 = pack8(st, 0), p1 = pack8(st, 8);
        const bf16x8 v00 = *(const bf16x8*)(vp + kt * 2048), v01 = *(const bf16x8*)(vp + kt * 2048 + 1024), v10 = *(const bf16x8*)(vp + kt * 2048 + 256), v11 = *(const bf16x8*)(vp + kt * 2048 + 1024 + 256);
        o0 = __builtin_amdgcn_mfma_f32_32x32x16_bf16(v00, p0, o0, 0, 0, 0); o0 = __builtin_amdgcn_mfma_f32_32x32x16_bf16(v01, p1, o0, 0, 0, 0);
        o1 = __builtin_amdgcn_mfma_f32_32x32x16_bf16(v10, p0, o1, 0, 0, 0); o1 = __builtin_amdgcn_mfma_f32_32x32x16_bf16(v11, p1, o1, 0, 0, 0);
    }
#pragma unroll
    for (int dir = 0; dir < 2; ++dir) {
        f32x16 c0, c1;
#pragma unroll
        for (int r = 0; r < 16; ++r) { c0[r] = zr; c1[r] = zr; }
#pragma unroll
        for (int s = 0; s < 4; ++s) { c0 = __builtin_amdgcn_mfma_f32_32x32x16_bf16(spa[dir][0][s], qf[s], c0, 0, 0, 0); c1 = __builtin_amdgcn_mfma_f32_32x32x16_bf16(spa[dir][1][s], qf[s], c1, 0, 0, 0); }
        const float wgt = dir == 0 ? fexp2(lgf2 * (float)(il + 1)) : fexp2(lgr2 * (float)(128 - il));
#pragma unroll
        for (int r = 0; r < 16; ++r) { o0[r] += wgt * c0[r]; o1[r] += wgt * c1[r]; }
    }
    float ss = 0.f;
#pragma unroll
    for (int r = 0; r < 16; ++r) ss += o0[r] * o0[r] + o1[r] * o1[r];
    ss = xhalf_sum(ss);
    const float rstd = 1.0f / sqrtf(ss * (1.0f / 64.0f) + EPS);
    bf16_t* op = wsp<bf16_t>(p, WS_OCAT) + (size_t)(row0 + r32) * DM + 1024 + h * 64 + 4 * hi;
#pragma unroll
    for (int g = 0; g < 4; ++g) {
        const u32x2 g0 = gq0[g], g1 = gq1[g];
        u32x2 w0, w1;
        w0.x = cvt_pk_bf16(o0[4 * g] * rstd * silu_f(bf_lo(g0.x)), o0[4 * g + 1] * rstd * silu_f(bf_hi(g0.x))); w0.y = cvt_pk_bf16(o0[4 * g + 2] * rstd * silu_f(bf_lo(g0.y)), o0[4 * g + 3] * rstd * silu_f(bf_hi(g0.y)));
        w1.x = cvt_pk_bf16(o1[4 * g] * rstd * silu_f(bf_lo(g1.x)), o1[4 * g + 1] * rstd * silu_f(bf_hi(g1.x))); w1.y = cvt_pk_bf16(o1[4 * g + 2] * rstd * silu_f(bf_lo(g1.y)), o1[4 * g + 3] * rstd * silu_f(bf_hi(g1.y)));
        *(u32x2*)(op + 8 * g) = w0; *(u32x2*)(op + 32 + 8 * g) = w1;
    }
}
constexpr int MLA_KIMG = 12288, MLA_VIMG = 8192, MLA_NT = KEYS / 64, MLA_NS = 6, MLA_D = MLA_NS - 1, MLA_VOFF = MLA_NS * MLA_KIMG;
__device__ __forceinline__ void mla_dma_tile(const unsigned char* kimg, const unsigned char* vimg, LAS unsigned char* lds, int slot, int w, int lane) {
#pragma unroll
    for (int i = 0; i < 3; ++i) {
        const int j = w + 8 * i;
        if (j < 20) {
            const unsigned char* src = j < 12 ? kimg + j * 1024 + lane * 16 : vimg + (j - 12) * 1024 + lane * 16;
            LAS unsigned char* dst = j < 12 ? lds + slot * MLA_KIMG + j * 1024 : lds + MLA_VOFF + slot * MLA_VIMG + (j - 12) * 1024;
            __builtin_amdgcn_global_load_lds((const GAS unsigned*)src, (LAS unsigned*)dst, 16, 0, 0);
        }
    }
}
__device__ __forceinline__ void mla_unit(const Params& p, LAS unsigned char* lds, int bh, int qb, int tile0, int ntiles, int tid, const float* qgain  ) {
    const int lane = tid & 63, w = __builtin_amdgcn_readfirstlane(tid >> 6), r32 = lane & 31, hi = lane >> 5, b = bh >> 3, h = bh & 7;
    const bool late = w >= 4;
    const int row0 = (qb < 16 ? b * SEQ + 256 * qb : ML + b * CTXL) + 32 * w;
    const unsigned char* kimg = wsp<unsigned char>(p, WS_KB) + ((size_t)bh * MLA_NT + tile0) * MLA_KIMG;
    const unsigned char* vimg = wsp<unsigned char>(p, WS_VTB) + ((size_t)bh * MLA_NT + tile0) * MLA_VIMG;
    bf16x8 qf[6];
    { const bf16_t* qrow = wsp<bf16_t>(p, WS_UPRAW) + (size_t)(row0 + r32) * 1792 + h * 96 + 8 * hi;
      u32x4 raw[6]; f32x4 gn[6][2], cs[4];
#pragma unroll
      for (int d0 = 0; d0 < 6; ++d0) raw[d0] = *(const u32x4*)(qrow + 16 * d0);
      const float rq = wsp<float>(p, WS_RQ)[row0 + r32];
#pragma unroll
      for (int d0 = 0; d0 < 6; ++d0) { gn[d0][0] = *(const f32x4*)(qgain + 16 * d0 + 8 * hi); gn[d0][1] = *(const f32x4*)(qgain + 16 * d0 + 8 * hi + 4); }
      const bool latent = qb < 16;
      { const float* rp = wsp<float>(p, WS_ROPE32) + ((size_t)(latent ? ((row0 + r32) & (SEQ - 1)) : 0) * 16 + 8 * hi) * 2;
#pragma unroll
        for (int j = 0; j < 4; ++j) cs[j] = *(const f32x4*)(rp + 4 * j); }
      asm volatile("s_waitcnt vmcnt(0)" ::: "memory");
      float x[6][8]; float ss = 0.f;
#pragma unroll
      for (int d0 = 0; d0 < 6; ++d0) { x[d0][0] = bf_lo(raw[d0].x); x[d0][1] = bf_hi(raw[d0].x); x[d0][2] = bf_lo(raw[d0].y); x[d0][3] = bf_hi(raw[d0].y);
          x[d0][4] = bf_lo(raw[d0].z); x[d0][5] = bf_hi(raw[d0].z); x[d0][6] = bf_lo(raw[d0].w); x[d0][7] = bf_hi(raw[d0].w);
#pragma unroll
          for (int e = 0; e < 8; e += 2) ss += x[d0][e] * x[d0][e] + x[d0][e + 1] * x[d0][e + 1]; }
      ss = xhalf_sum(ss);
      const float r = rq / sqrtf(rq * rq * ss * (1.0f / 96.0f) + EPS);
#pragma unroll
      for (int d0 = 0; d0 < 6; ++d0)
#pragma unroll
          for (int e = 0; e < 8; ++e) x[d0][e] *= r * gn[d0][e >> 2][e & 3];
      if (latent) {
#pragma unroll
          for (int e = 0; e < 8; ++e) { const float c = cs[e >> 1][2 * (e & 1)], s = cs[e >> 1][2 * (e & 1) + 1]; const float lo = x[4][e], up = x[5][e];
              x[4][e] = lo * c - up * s; x[5][e] = lo * s + up * c; } }
      const float qscale = 0.10206207261596575f * LOG2E;
#pragma unroll
      for (int d0 = 0; d0 < 6; ++d0) { u32x4 w; w.x = cvt_pk_bf16(x[d0][0] * qscale, x[d0][1] * qscale); w.y = cvt_pk_bf16(x[d0][2] * qscale, x[d0][3] * qscale);
          w.z = cvt_pk_bf16(x[d0][4] * qscale, x[d0][5] * qscale); w.w = cvt_pk_bf16(x[d0][6] * qscale, x[d0][7] * qscale); qf[d0] = __builtin_bit_cast(bf16x8, w); }
    }
#pragma unroll
    for (int i = 0; i < MLA_D; ++i) if (i < ntiles) mla_dma_tile(kimg + (size_t)i * MLA_KIMG, vimg + (size_t)i * MLA_VIMG, lds, i, w, lane);
    f32x16 o0, o1; const float zr = opaque_zero();
#pragma unroll
    for (int r = 0; r < 16; ++r) { o0[r] = zr; o1[r] = zr; }
    float m_run = 0.f, l_run = 0.f;
    if (ntiles >= MLA_D) { if (!late) asm volatile("s_waitcnt vmcnt(12)" ::: "memory"); else asm volatile("s_waitcnt vmcnt(8)" ::: "memory"); }
    else asm volatile("s_waitcnt vmcnt(0)" ::: "memory");
    __builtin_amdgcn_s_barrier();
    const int koff = (hi * 64 + permkey(r32)) * 16;
    const int voff = (hi * 64 + r32) * 16;
    bf16x8 kf[12];
#pragma unroll
    for (int d0 = 0; d0 < 6; ++d0) { kf[2 * d0] = *(const LAS bf16x8*)(lds + koff + d0 * 2048); kf[2 * d0 + 1] = *(const LAS bf16x8*)(lds + koff + d0 * 2048 + 512); }
    int slot = 0;
#define MLA_SEAM(t) do { if ((t) + MLA_D - 1 < ntiles) { if (!late) asm volatile("s_waitcnt vmcnt(9) lgkmcnt(0)" ::: "memory"); else asm volatile("s_waitcnt vmcnt(6) lgkmcnt(0)" ::: "memory"); } \
        else asm volatile("s_waitcnt vmcnt(0) lgkmcnt(0)" ::: "memory"); \
        __builtin_amdgcn_s_barrier(); \
        if ((t) + MLA_D < ntiles) mla_dma_tile(kimg + (size_t)((t) + MLA_D) * MLA_KIMG, vimg + (size_t)((t) + MLA_D) * MLA_VIMG, lds, slot == 0 ? MLA_NS - 1 : slot - 1, w, lane); } while (0)
    for (int t = 0; t < ntiles; ++t) {
        if (late) MLA_SEAM(t);
        f32x16 s0, s1;
#pragma unroll
        for (int r = 0; r < 16; ++r) { s0[r] = -m_run; s1[r] = -m_run; }
        __builtin_amdgcn_sched_barrier(0);
#pragma unroll
        for (int d0 = 0; d0 < 6; ++d0) {
            s0 = __builtin_amdgcn_mfma_f32_32x32x16_bf16(kf[2 * d0], qf[d0], s0, 0, 0, 0);
            s1 = __builtin_amdgcn_mfma_f32_32x32x16_bf16(kf[2 * d0 + 1], qf[d0], s1, 0, 0, 0);
        }
        __builtin_amdgcn_sched_barrier(0);
        if (!late) MLA_SEAM(t);
        const LAS unsigned char* vs = lds + MLA_VOFF + slot * MLA_VIMG + voff;
        const LAS unsigned char* ks = lds + (slot + 1 == MLA_NS ? 0 : slot + 1) * MLA_KIMG + koff;
        bf16x8 vf[8];
#pragma unroll
        for (int d0 = 0; d0 < 2; ++d0)
#pragma unroll
            for (int q = 0; q < 4; ++q) vf[d0 * 4 + q] = *(const LAS bf16x8*)(vs + q * 2048 + d0 * 512);
        if (t + 1 < ntiles) {
#pragma unroll
            for (int d0 = 0; d0 < 6; ++d0) { kf[2 * d0] = *(const LAS bf16x8*)(ks + d0 * 2048); kf[2 * d0 + 1] = *(const LAS bf16x8*)(ks + d0 * 2048 + 512); }
        }
        __builtin_amdgcn_sched_barrier(0);
        float mq[4];
#pragma unroll
        for (int r = 0; r < 4; ++r) mq[r] = fmaxf(s0[r], s1[r]);
#pragma unroll
        for (int r = 4; r < 16; ++r) mq[r & 3] = fmaxf(fmaxf(mq[r & 3], s0[r]), s1[r]);
        float mx = fmaxf(fmaxf(mq[0], mq[1]), fmaxf(mq[2], mq[3]));
        mx = xhalf_max(mx);
        if (__any(mx > 8.0f)) {
            const float d = fmaxf(mx, 0.f), f = fexp2(-d);
            m_run += d; l_run *= f;
#pragma unroll
            for (int r = 0; r < 16; ++r) { o0[r] *= f; o1[r] *= f; s0[r] -= d; s1[r] -= d; }
        }
        float pq[4] = {0.f, 0.f, 0.f, 0.f};
#define MLA_GRP(S, O, G, VA, VB) do { _Pragma("unroll") for (int r = (O); r < (O) + 8; ++r) { S[r] = fexp2(S[r]); pq[G] += S[r]; } \
            const bf16x8 pg = pack8(S, O); \
            o0 = __builtin_amdgcn_mfma_f32_32x32x16_bf16(vf[VA], pg, o0, 0, 0, 0); o1 = __builtin_amdgcn_mfma_f32_32x32x16_bf16(vf[VB], pg, o1, 0, 0, 0); } while (0)
        MLA_GRP(s0, 0, 0, 0, 4); MLA_GRP(s0, 8, 1, 1, 5); MLA_GRP(s1, 0, 2, 2, 6); MLA_GRP(s1, 8, 3, 3, 7);
#undef MLA_GRP
        l_run += (pq[0] + pq[1]) + (pq[2] + pq[3]);
        slot = slot + 1 == MLA_NS ? 0 : slot + 1;
    }
#undef MLA_SEAM
    l_run = xhalf_sum(l_run);
    const float inv = 1.0f / l_run;
    bf16_t* orow = wsp<bf16_t>(p, WS_OCAT) + (size_t)(row0 + r32) * DM + 512 + h * 64 + 4 * hi;
#pragma unroll
    for (int g = 0; g < 4; ++g) {
        u32x2 w0, w1;
        w0.x = cvt_pk_bf16(o0[4 * g] * inv, o0[4 * g + 1] * inv); w0.y = cvt_pk_bf16(o0[4 * g + 2] * inv, o0[4 * g + 3] * inv);
        w1.x = cvt_pk_bf16(o1[4 * g] * inv, o1[4 * g + 1] * inv); w1.y = cvt_pk_bf16(o1[4 * g + 2] * inv, o1[4 * g + 3] * inv);
        *(u32x2*)(orow + 8 * g) = w0; *(u32x2*)(orow + 32 + 8 * g) = w1;
    }
    asm volatile("s_waitcnt vmcnt(0) lgkmcnt(0)" ::: "memory");
}
__device__ __forceinline__ void moe_tables(const Params& p, LAS int* tb, int tid) {
    if (tid < NEXP)
        tb[160 + tid] = (int)__hip_atomic_load(wsp<unsigned>(p, WS_CTL) + CW_ECNT + 64 * tid, __ATOMIC_RELAXED, __HIP_MEMORY_SCOPE_AGENT);
    __syncthreads();
    if (tid == 0) {
        int base = 0;
        for (int e = 0; e < NEXP; ++e) {
            const int cnt = tb[160 + e];
            const int nt = (cnt + 255) >> 8; tb[e] = base * 256;
            int ev = e; asm volatile("" : "+v"(ev));
#pragma clang loop vectorize(disable) unroll(disable)
            for (int t = 0; t < nt; ++t) tb[16 + base + t] = ev;
            base += nt;
        }
        tb[8] = base;
    }
    __syncthreads();
}

__device__ __forceinline__ int gemm_cus(int nwg, int G) { const int R = (nwg + G - 1) / G; const int g = (((nwg + R - 1) / R) + 7) & ~7; return g < G ? g : G; }

constexpr int NPHASE = 24;
constexpr int MAIN_RT = 2 * ML / 256;
constexpr int CONV_C1 = 0, CONV_C2 = CONV_C1 + 7168, CONV_CF = CONV_C2 + 0  , CONV_C3 = CONV_CF + (FFN2_FP8 ? 22528 : 21504), CONV_C4 = CONV_C3 + 9216;
constexpr int DI_GU_A = 5632;
constexpr int CONV_WQG = 544;
constexpr int CONV_C5 = CONV_C4 + 2 * CONV_WQG * 32;
static_assert(CONV_C5 <= NCONV, "conversion shares");
__global__ void __launch_bounds__(512, 2) fwd_kernel(Params pk) {
    const KArg ka0 = (KArg)__builtin_amdgcn_kernarg_segment_ptr(); (void)pk;
    Params p = load_params(ka0);
    extern __shared__ __attribute__((aligned(16))) unsigned char lds_raw[];
    LAS unsigned char* lds = (LAS unsigned char*)lds_raw;
    volatile LAS unsigned* MISC = (volatile LAS unsigned*)(lds + MISC_OFF);
    const int wave_o = __builtin_amdgcn_readfirstlane((int)threadIdx.x >> 6);
    const int G_o = gridDim.x; const int vcu_o = (G_o % 8 == 0) ? ((int)blockIdx.x % 8) * (G_o / 8) + (int)blockIdx.x / 8 : (int)blockIdx.x;
    { const int t0 = threadIdx.x; if (t0 < 256) MISC[t0] = 0u; }
    __syncthreads();
    XcdBarrier bar; bar.bar = wsp<unsigned>(p, WS_CTL) + CW_BAR; bar.x = 0; bar.st = MISC + 8;
#if MK_ONE_LAUNCH
    bar = xcd_barrier_post(wsp<unsigned>(p, WS_CTL) + CW_BAR, MISC + 8, wave_o == 0 && lane_id_asm() == 0);
#endif
    const int lo = p.ph_lo, hi = p.ph_hi;
#define IN(k) (lo <= (k) && (k) < hi)
#ifndef PH_MASK
#define PH_MASK 0xffffffffu
#endif
#define PHEN(k) (((PH_MASK) >> (k)) & 1u)
#ifndef REP_MASK
#define REP_MASK 0u
#endif
#ifndef REP_LAYER
#define REP_LAYER -1
#endif
#define REPS(k) (1 + (int)((((REP_MASK) >> (k)) & 1u) && (REP_LAYER < 0 || l == REP_LAYER)))
#if MK_ONE_LAUNCH
#define SEAM(k) do { if (IN(k) && IN((k) + 1)) xcd_barrier(bar, wave_o == 0 && lane_id_asm() == 0); } while (0)
#else
#define SEAM(k) do { } while (0)
#endif
#ifdef NO_LWS
#define LAUNDER_WS
#else
#define LAUNDER_WS asm volatile("" : "+s"(p.ws))
#endif
#define OPQ Params p = load_params(ka0); const int lane = lane_id_asm(), wave = lnd_s(wave_o), tid = wave * 64 + lane, bid = lnd_s((int)blockIdx.x), G = lnd_s(G_o), vcu = lnd_s(vcu_o), gw = vcu * 8 + wave, NGW = G * 8; \
    (void)tid; (void)bid; (void)gw; (void)NGW; LAUNDER_WS; if (REP_MASK) __syncthreads();
    LAS int* tb = (LAS int*)(lds + MISC_OFF + 256);

    if (PHEN(0) && IN(0)) for (int rep = 0, l = 1; rep < REPS(0); ++rep) { OPQ p0_prologue(p, lds, G, vcu, wave); }
    SEAM(0);

#pragma unroll
    for (int l = 0; l < 2; ++l) {
        const int pb = 1 + 12 * l;
        const float* mod = wsp<float>(p, WS_MOD) + (size_t)l * 5 * MODW;
        const int mrows = l == 0 ? MT : ML;
        if (PHEN(1) && IN(pb + 0)) for (int rep = 0; rep < REPS(1); ++rep) { OPQ
            for (int row = 2 * gw; row < MT; row += 2 * NGW) {
                const float* ma = mod + (size_t)(row < ML ? (row >> 12) : 4) * MODW;
                if (l == 0) norm_mod_row2<false, false>(row < ML ? p.in[I_X] + (size_t)row * DM : p.in[I_CTX] + (size_t)(row - ML) * DM, p.in[I_NMIX] + l * DM, ma, ma + DM, wsp<bf16_t>(p, WS_H) + (size_t)row * DM, DM, lane);
                else norm_mod_row2<false, true>(wsp<bf16_t>(p, WS_X1) + (size_t)row * DM, p.in[I_NMIX] + l * DM, ma, ma + DM, wsp<bf16_t>(p, WS_H) + (size_t)row * DM, DM, lane);
            }
        }
        SEAM(pb + 0);
        if (PHEN(2) && IN(pb + 1)) for (int rep = 0; rep < REPS(2); ++rep) { OPQ
            pg8::Gemm g{wsp<bf16_t>(p, WS_H), wsp<bf16_t>(p, WS_WIN) + (size_t)l * INCP * DM, DM, DM, 0, 0, 0};
            pg8::TileOrder S; S.init(MT / 256, INCP / 256, G, bid, nullptr);
            pg8::EpiBf16 E{wsp<bf16_t>(p, WS_P), INCP};
            pg8::gemm_phase<2>(lds, g, S, E, wave);
            { const int fi = S.first_idle(); const bool all = fi >= G;
              if (all || S.idle_last_round()) { const int wi = all ? gw : (bid - fi) * 8 + wave, nw = all ? NGW : (G - fi) * 8;
                  if (l == 0) dense_items(p, lds, wave, lane, 2 * DI_PER_L, 2 * DI_PER_L + DI_GU_A, wi, nw);
                  moe_convert_pipe(p, lds, wave, lane, l == 0 ? 0 : CONV_C3, l == 0 ? CONV_C1 : CONV_C4, wi, nw); } }
        }
        SEAM(pb + 1);
        if (PHEN(3) && IN(pb + 2)) for (int rep = 0; rep < REPS(3); ++rep) { OPQ
#ifndef NO_UPG
            { pg8::Gemm g{wsp<bf16_t>(p, WS_P) + PC_BQ, wsp<bf16_t>(p, WS_WUP) + (size_t)l * 1792 * 512, INCP, 512, 0, 0, 0};
              pg8::TileOrder S; S.init(MT / 256, 7, G, bid, nullptr);
              pg8::EpiBf16 E{wsp<bf16_t>(p, WS_UPRAW), 1792};
              pg8::gemm_phase<2>(lds, g, S, E, wave); }
#endif
            __syncthreads();
#ifndef NO_HEADS
            { const int l16h = lane & 15;
              const f32x4 g_ak = *(const f32x4*)(p.in[I_AKN] + l * 64 + 4 * l16h), g_dk = *(const f32x4*)(p.in[I_DKN] + l * 64 + 4 * l16h), g_no = {1.f, 1.f, 1.f, 1.f};
            for (int row = gw; row < MT; row += 2 * NGW) {
                const int rb = row + NGW < MT ? row + NGW : row;
                const HeadKind kak{PC_AK, 2, p.in[I_AKN] + l * 64, 1, 1.0f, wsp<bf16_t>(p, WS_KA), 1};
                const HeadKind kck{PC_CK, 8, nullptr, 1, 0.125f, wsp<bf16_t>(p, WS_KC), 1};
                const HeadKind kdk{PC_DK, 8, p.in[I_DKN] + l * 64, 0, 1.0f, wsp<bf16_t>(p, WS_KD), 1};
                u32x2 w1[2], w3[2], w5[2], u1[2], u3[2], u5[2];
                f32x4 ra[2], rbp[2];
                { const float* ca = wsp<float>(p, WS_ROPE64) + ((size_t)(row < ML ? (row & (SEQ - 1)) : 0) * 32 + 4 * (l16h & 7)) * 2; ra[0] = *(const f32x4*)ca; ra[1] = *(const f32x4*)(ca + 4);
                  const float* cb = wsp<float>(p, WS_ROPE64) + ((size_t)(rb < ML ? (rb & (SEQ - 1)) : 0) * 32 + 4 * (l16h & 7)) * 2; rbp[0] = *(const f32x4*)cb; rbp[1] = *(const f32x4*)(cb + 4); }
                prep_heads_load(p, kak, row, lane, w1); prep_heads_load(p, kck, row, lane, w3); prep_heads_load(p, kdk, row, lane, w5);
                prep_heads_load(p, kak, rb, lane, u1); prep_heads_load(p, kck, rb, lane, u3); prep_heads_load(p, kdk, rb, lane, u5);
                prep_heads_compute(p, kak, row, lane, w1, ra, g_ak); prep_heads_compute(p, kck, row, lane, w3, ra, g_no); prep_heads_compute(p, kdk, row, lane, w5, ra, g_dk);
                prep_heads_compute(p, kak, rb, lane, u1, rbp, g_ak); prep_heads_compute(p, kck, rb, lane, u3, rbp, g_no); prep_heads_compute(p, kdk, rb, lane, u5, rbp, g_dk);
            } }
#endif
#ifndef NO_TR
            LAS bf16_t* scr = (LAS bf16_t*)(lds + wave * 16384);
            for (int u = (gw + NGW / 2) % NGW; u < NB * 68 * 26; u += NGW) {
                const int b = u / (68 * 26), r = u % (68 * 26), tt = r / 26, hh = r % 26;
                if (hh < 2) { const TrKind k{wsp<bf16_t>(p, WS_P), INCP, PC_AV, 2, nullptr, 0, 1.0f, 0, wsp<bf16_t>(p, WS_VTA), nullptr, 0.f, 0.f, 2}; prep_transpose_unit(p, k, b, hh, tt, scr, lane); }
                else if (hh < 10) { const TrKind k{wsp<bf16_t>(p, WS_P), INCP, PC_CV, 8, nullptr, 0, 1.0f, 0, wsp<bf16_t>(p, WS_VTC), nullptr, 0.f, 0.f, 2}; prep_transpose_unit(p, k, b, hh - 2, tt, scr, lane); }
                else if (hh < 18) { const TrKind k{wsp<bf16_t>(p, WS_P), INCP, PC_DV, 8, nullptr, 0, 1.0f, 0, wsp<bf16_t>(p, WS_VTD), nullptr, 0.f, 0.f, 2}; prep_transpose_unit(p, k, b, hh - 10, tt, scr, lane); }
                else { const int h = hh - 18;
                    const float lgf2 = -__expf(p.in[I_CLD][(l * 2 + 0) * 8 + h]) * LOG2E, lgr2 = -__expf(p.in[I_CLD][(l * 2 + 1) * 8 + h]) * LOG2E;
                    const TrKind k{wsp<bf16_t>(p, WS_P), INCP, PC_CK, 8, nullptr, 1, 0.125f, 1, wsp<bf16_t>(p, WS_KWF), wsp<bf16_t>(p, WS_KWR), lgf2, lgr2, 2}; prep_transpose_unit(p, k, b, h, tt, scr, lane); }
            }
#endif
        }
        SEAM(pb + 2);
        if (PHEN(4) && IN(pb + 3)) for (int rep = 0; rep < REPS(4); ++rep) { OPQ
            { const int l32m = lane & 31, d0m = l32m < 24 ? 4 * l32m : 0;
              const f32x4 gq = *(const f32x4*)(p.in[I_BQN] + l * 96 + d0m), gk = *(const f32x4*)(p.in[I_BKN] + l * 96 + d0m);
            for (int row = gw; row < MT; row += 2 * NGW) {
                const int rb = row + NGW < MT ? row + NGW : row;
                MlaRegs Ra, Rb; prep_mla_load(p, row, lane, Ra); prep_mla_load(p, rb, lane, Rb);
                prep_mla_compute(p, l, row, lane, Ra, gq, gk); prep_mla_compute(p, l, rb, lane, Rb, gq, gk);
            } }
            for (int u = (gw + NGW / 2) % NGW; u < 64 * 34; u += NGW) ret_c1_unit(p, u / 34, u % 34, lane);
        }
        SEAM(pb + 3);
        if (PHEN(5) && IN(pb + 4)) for (int rep = 0; rep < REPS(5); ++rep) { OPQ
            LAS bf16_t* scr = (LAS bf16_t*)(lds + wave * 16384);
            for (int u = gw; u < NB * 68 * 8; u += NGW) {
                const int b = u / (68 * 8), r = u % (68 * 8), tt = r / 8, h = r % 8;
                const TrKind k{wsp<bf16_t>(p, WS_UPRAW), 1792, 768 + 64, -8, wsp<float>(p, WS_RKV), 0, 1.0f, 0, wsp<bf16_t>(p, WS_VTB), nullptr, 0.f, 0.f, 1};
                prep_transpose_unit(p, k, b, h, tt, scr, lane);
            }
            ret_c2(p, l, vcu * 512 + tid, G * 512);
        }
        SEAM(pb + 4);
        if (PHEN(6) && IN(pb + 5)) for (int rep = 0; rep < REPS(6); ++rep) { OPQ
#ifndef REP_MLA
#define REP_MLA 1
#endif
#ifndef REP_WQ
#define REP_WQ 1
#endif
            for (int rep2 = 0; rep2 < REP_MLA; ++rep2)
            { const int nmla = NB * 8 * 16 + (l == 0 ? NB * 8 : 0);
              for (int u = vcu; u < nmla; u += G) {
                  if (u < NB * 8 * 16) mla_unit(p, lds, u >> 4, u & 15, 0, MLA_NT, tid, p.in[I_BQN] + l * 96);
                  else mla_unit(p, lds, u - NB * 8 * 16, 16, SEQ / 64, CTXL / 64, tid, p.in[I_BQN] + l * 96);
                  __builtin_amdgcn_s_barrier();
              } }
            const int nq = l == 0 ? 136 : 128;
            const int gD = NB * 8 * (nq / 8), gA = NB * 2 * (nq / 2), gC = NB * 8 * ((l == 0 ? 34 : 32) / 2);
            const int total = gD + gA + gC;
            const float NEG = -__builtin_inff();
            for (int rep3 = 0; rep3 < REP_WQ; ++rep3) {
            unsigned qpend = 0u;
            if (tid == 0) qpend = __hip_atomic_fetch_add(wsp<unsigned>(p, WS_CTL) + CW_Q + 64 * (l + 2 * rep + 4 * rep3), 1u, __ATOMIC_RELAXED, __HIP_MEMORY_SCOPE_AGENT);
            for (;;) {
                __syncthreads();
                if (tid == 0) { MISC[16] = qpend; qpend = __hip_atomic_fetch_add(wsp<unsigned>(p, WS_CTL) + CW_Q + 64 * (l + 2 * rep + 4 * rep3), 1u, __ATOMIC_RELAXED, __HIP_MEMORY_SCOPE_AGENT); }
                __syncthreads();
                const int qi = (int)MISC[16];
                if (qi >= 4 * max((total + 2) / 3, CONV_WQG)) break;
                if ((qi & 3) == 3) {
                    if ((qi >> 2) < CONV_WQG && rep3 == 0 && rep == 0) { const int r0 = CONV_C4 + l * CONV_WQG * 32 + (qi >> 2) * 32 + wave * 4; moe_convert_pipe(p, lds, wave, lane_id_asm(), r0, r0 + 4, 0, 1); }
                    continue;
                }
                int gi = 3 * (qi >> 2) + (qi & 3);
                if (gi >= total) continue;
                if (gi < gD + gA) {
                    int mixer, b, h, qb;
                    if (gi < gD) { mixer = 3; const int rg = gi % (nq / 8), bh = gi / (nq / 8); b = bh >> 3; h = bh & 7; qb = 8 * rg + wave; }
                    else { gi -= gD; mixer = 0; const int qp = gi % (nq / 2), bg = gi / (nq / 2); b = bg >> 1; h = 4 * (bg & 1) + (wave & 3); qb = 2 * qp + (wave >> 2); }
                    const int bh = b * 8 + h;
                    const bool cq = qb >= 128;
                    const int row0 = cq ? ML + b * CTXL + 32 * (qb - 128) : b * SEQ + 32 * qb;
                    AttnArgs a; a.c0 = 128; a.c1 = 136; a.sink2 = NEG; a.q0 = 0; a.qrow = 0; a.rpb = nullptr; a.opitch = DM; a.t0 = 0; a.t1 = 0; a.qpitch = INCP; a.qscale = 0.125f * LOG2E; a.qrope = nullptr;
                    if (mixer == 0) {
                        a.Q = wsp<bf16_t>(p, WS_P) + (size_t)row0 * INCP + PC_AQ + h * 64; a.qgain = p.in[I_AQN] + l * 64; if (!cq) a.qrope = wsp<float>(p, WS_ROPE64) + (size_t)(32 * qb) * 64;
                        a.K = wsp<bf16_t>(p, WS_KA) + (size_t)(b * 2 + (h >> 2)) * KEYS * 64; a.Vt = wsp<bf16_t>(p, WS_VTA) + (size_t)(b * 2 + (h >> 2)) * 64 * KEYS;
                        a.O = wsp<bf16_t>(p, WS_OCAT) + (size_t)row0 * DM + h * 64; a.sink2 = p.in[I_ASINK][l * 8 + h] * LOG2E;
                        if (!cq) { a.t0 = max(0, qb - 4); a.t1 = min(128, qb + 5); a.q0 = 32 * qb; attn_wave<64, 1>(a, lane); } else attn_wave<64, 0>(a, lane);
                    } else {
                        a.Q = wsp<bf16_t>(p, WS_P) + (size_t)row0 * INCP + PC_DQ + h * 64; a.qgain = p.in[I_DQN] + l * 64;
                        a.K = wsp<bf16_t>(p, WS_KD) + (size_t)bh * KEYS * 64; a.Vt = wsp<bf16_t>(p, WS_VTD) + (size_t)bh * 64 * KEYS;
                        a.O = wsp<bf16_t>(p, WS_OCAT) + (size_t)row0 * DM + 1536 + h * 64;
                        if (!cq) { const int gr = qb >> 1, rs = min(max(gr - 4, 0), 56); a.t0 = 2 * rs; a.t1 = a.t0 + 16; a.q0 = (qb & 1) * 32; a.qrow = gr; a.rpb = wsp<float>(p, WS_RPB) + (size_t)(l * 8 + h) * 15 * 128;
                            attn_wave<64, 2>(a, lane); } else attn_wave<64, 0>(a, lane);
                    }
                } else {
                    gi -= gD + gA;
                    const int nch2 = (l == 0 ? 34 : 32) / 2;
                    const int c = 2 * (gi % nch2) + (wave >> 2), bh = gi / nch2;
                    ret_c3_unit(p, l, bh, c, wave & 3, lane_id_asm());
                }
            }
            }
        }
        SEAM(pb + 5);
        if (PHEN(7) && IN(pb + 6)) for (int rep = 0; rep < REPS(7); ++rep) { OPQ
            pg8::Gemm g{wsp<bf16_t>(p, WS_OCAT), wsp<bf16_t>(p, WS_WOUT) + (size_t)l * DM * DM, DM, DM, 0, 0, 0};
            const int Gg = gemm_cus((mrows / 256) * (DM / 256), G);
            pg8::TileOrder S; S.init(mrows / 256, DM / 256, Gg, bid, nullptr);
            if (bid < Gg) {
                if (l == 0) { pg8::EpiResid<true> E{p.in[I_X], p.in[I_CTX], wsp<bf16_t>(p, WS_X1), mod + 2 * DM}; pg8::gemm_phase<2>(lds, g, S, E, wave); }
                else { pg8::EpiResid<false> E{wsp<bf16_t>(p, WS_X1), wsp<bf16_t>(p, WS_X1) + (size_t)ML * DM, wsp<bf16_t>(p, WS_X1), mod + 2 * DM}; pg8::gemm_phase<2>(lds, g, S, E, wave); }
            }
            if (l == 0) { if (Gg >= G) { dense_items(p, lds, wave, lane, 2 * DI_PER_L + DI_GU_A, DI_ALL, gw, NGW); moe_convert(p, lds, wave, lane, CONV_C1, CONV_C2, gw, NGW); }
              else if (bid >= Gg) { dense_items(p, lds, wave, lane, 2 * DI_PER_L + DI_GU_A, DI_ALL, (bid - Gg) * 8 + wave, (G - Gg) * 8);
                  moe_convert_pipe(p, lds, wave, lane, CONV_C1, CONV_C2, (bid - Gg) * 8 + wave, (G - Gg) * 8); } }
        }
        SEAM(pb + 6);
        if (PHEN(8) && IN(pb + 7)) for (int rep = 0; rep < REPS(8); ++rep) { OPQ
            if (l == 0) {
                for (int row = 2 * gw; row < MT; row += 2 * NGW) {
                    const float* ma = mod + (size_t)(row < ML ? (row >> 12) : 4) * MODW;
                    norm_mod_row2<(FFN1_FP8 != 0), true>(wsp<bf16_t>(p, WS_X1) + (size_t)row * DM, p.in[I_NFFN] + l * DM, ma + 3 * DM, ma + 4 * DM, wsp<bf16_t>(p, WS_H) + (size_t)row * (FFN1_FP8 ? DM / 2 : DM), FFN1_FP8 ? DM / 2 : DM, lane);
                }
            } else {
                LAS float* rt = (LAS float*)lds;
                LAS int* lcnt = (LAS int*)(lds + 65536);
                LAS int* rinfo = (LAS int*)(lds + 65536 + 64);
                for (int i = tid; i < DM * 8; i += 512) rt[i] = p.in[I_MR][i];
                if (tid < 16) lcnt[tid] = 0;
                __syncthreads();
                for (int grp = bid; grp < ML / 64; grp += G) {
                    const float* mv = mod + (size_t)((grp * 64) >> 12) * MODW;
                    const u32x2* xr = (const u32x2*)(wsp<bf16_t>(p, WS_X1) + (size_t)(grp * 64 + wave * 8) * DM);
                    u32x2 xn[8]; f32x4 m1[8], sq[8];
#pragma unroll
                    for (int j = 0; j < 8; ++j) xn[j] = xr[lane + 64 * j];
#pragma unroll
                    for (int j = 0; j < 8; ++j) { const int c = lane + 64 * j; const f32x4 gq = *((const f32x4*)(p.in[I_NFFN] + l * DM) + c), aq = *((const f32x4*)(mv + 4 * DM) + c);
                        sq[j] = *((const f32x4*)(mv + 3 * DM) + c); m1[j] = gq * (aq + 1.0f); }
#pragma nounroll
                    for (int rr = 0; rr < 8; ++rr) {
                        const int rl = wave * 8 + rr, row = grp * 64 + rl;
                        f32x4 v[8];
#pragma unroll
                        for (int j = 0; j < 8; ++j) v[j] = (f32x4){bf_lo(xn[j].x), bf_hi(xn[j].x), bf_lo(xn[j].y), bf_hi(xn[j].y)};
                        if (rr < 7) { xr += DM / 4;
#pragma unroll
                            for (int j = 0; j < 8; ++j) xn[j] = xr[lane + 64 * j]; }
                        { float ss = 0.f;
#pragma unroll
                          for (int j = 0; j < 8; ++j) ss += (v[j].x * v[j].x + v[j].y * v[j].y) + (v[j].z * v[j].z + v[j].w * v[j].w);
                          const float rstd = 1.0f / sqrtf(wave_sum(ss) * (1.0f / DM) + EPS);
                          unsigned* orow = (unsigned*)(wsp<unsigned char>(p, WS_H) + (size_t)row * DM);
#pragma unroll
                          for (int j = 0; j < 8; ++j) { v[j] = (v[j] * rstd) * m1[j] + sq[j]; orow[lane + 64 * j] = pack_fp8x4(v[j].x, v[j].y, v[j].z, v[j].w); } }
                        float lg[8];
#pragma unroll
                        for (int e = 0; e < 8; ++e) lg[e] = 0.f;
#pragma unroll
                        for (int j = 0; j < 8; ++j)
#pragma unroll
                            for (int c = 0; c < 4; ++c) { const int k = 4 * (lane + 64 * j) + c; const f32x4 r0 = *(const LAS f32x4*)(rt + k * 8), r1 = *(const LAS f32x4*)(rt + k * 8 + 4); const float x = v[j][c];
                                lg[0] += x * r0.x; lg[1] += x * r0.y; lg[2] += x * r0.z; lg[3] += x * r0.w; lg[4] += x * r1.x; lg[5] += x * r1.y; lg[6] += x * r1.z; lg[7] += x * r1.w; }
#pragma unroll
                        for (int e = 0; e < 8; ++e) lg[e] = wave_sum(lg[e]);
                        int e0 = 0; float l0 = lg[0];
#pragma unroll
                        for (int e = 1; e < 8; ++e) if (lg[e] > l0) { l0 = lg[e]; e0 = e; }
                        int e1 = -1; float l1 = -__builtin_inff();
#pragma unroll
                        for (int e = 0; e < 8; ++e) if (e != e0 && lg[e] > l1) { l1 = lg[e]; e1 = e; }
                        if (lane == 0) {
                            const float g0 = 1.0f / (1.0f + __expf(l1 - l0));
                            const int r0 = __hip_atomic_fetch_add(lcnt + e0, 1, __ATOMIC_RELAXED, __HIP_MEMORY_SCOPE_WORKGROUP), r1 = __hip_atomic_fetch_add(lcnt + e1, 1, __ATOMIC_RELAXED, __HIP_MEMORY_SCOPE_WORKGROUP);
                            rinfo[rl * 8 + 0] = e0; rinfo[rl * 8 + 1] = e1; rinfo[rl * 8 + 2] = r0; rinfo[rl * 8 + 3] = r1; rinfo[rl * 8 + 4] = __float_as_int(g0); rinfo[rl * 8 + 5] = __float_as_int(1.0f - g0);
                        }
                    }
                    __syncthreads();
                    if (tid < 8) lcnt[8 + tid] = (int)__hip_atomic_fetch_add(wsp<unsigned>(p, WS_CTL) + CW_ECNT + 64 * tid, (unsigned)lcnt[tid], __ATOMIC_RELAXED, __HIP_MEMORY_SCOPE_AGENT);
                    __syncthreads();
                    if (tid < 64) { int* ro = wsp<int>(p, WS_ROUTE) + (size_t)(grp * 64 + tid) * 8; const int e0 = rinfo[tid * 8], e1 = rinfo[tid * 8 + 1];
                        ro[0] = e0; ro[1] = e1; ro[2] = lcnt[8 + e0] + rinfo[tid * 8 + 2]; ro[3] = lcnt[8 + e1] + rinfo[tid * 8 + 3]; ro[4] = rinfo[tid * 8 + 4]; ro[5] = rinfo[tid * 8 + 5]; }
                    __syncthreads();
                    if (tid < 8) lcnt[tid] = 0;
                    __syncthreads();
                }
            }
        }
        SEAM(pb + 7);
        if (l == 0) {
            if (PHEN(9) && IN(pb + 8)) for (int rep = 0; rep < REPS(9); ++rep) { OPQ
                pg8::TileOrder S; S.init(MT / 256, 2 * DFF / 256, G, bid, nullptr);
#if FFN2_FP8
                pg8::EpiSwiGLU8 E{wsp<unsigned char>(p, WS_ACT), DFF};
#else
                pg8::EpiSwiGLU E{wsp<bf16_t>(p, WS_ACT), DFF};
#endif
#if FFN1_FP8
                pg8::Gemm g{wsp<unsigned char>(p, WS_H), wsp<unsigned char>(p, WS_WGU), DM, DM, 0, 0x7f7f7f7f, 0x77777777};
                pg8::gemm_phase<1>(lds, g, S, E, wave);
#else
                pg8::Gemm g{wsp<bf16_t>(p, WS_H), wsp<bf16_t>(p, WS_WGU), DM, DM, 0, 0, 0};
                pg8::gemm_phase<2>(lds, g, S, E, wave);
#endif
                { const int fi = S.first_idle(); if (fi >= G) moe_convert(p, lds, wave, lane, CONV_C2, CONV_CF, gw, NGW);
                  else if (S.idle_last_round()) moe_convert(p, lds, wave, lane, CONV_C2, CONV_CF, (bid - fi) * 8 + wave, (G - fi) * 8); }
            }
            SEAM(pb + 8);
            if (PHEN(10) && IN(pb + 9)) for (int rep = 0; rep < REPS(10); ++rep) { OPQ
                const int Gg = gemm_cus((MT / 256) * (DM / 256), G);
                pg8::TileOrder S; S.init(MT / 256, DM / 256, Gg, bid, nullptr);
                pg8::EpiResid<false> E{wsp<bf16_t>(p, WS_X1), wsp<bf16_t>(p, WS_X1) + (size_t)ML * DM, wsp<bf16_t>(p, WS_X1), mod + 5 * DM};
#if FFN2_FP8
                pg8::Gemm g{wsp<unsigned char>(p, WS_ACT), wsp<unsigned char>(p, WS_WD), DFF, DFF, 0, 0x7f7f7f7f, 0x77777777};
                if (bid < Gg) pg8::gemm_phase<1>(lds, g, S, E, wave);
#else
                pg8::Gemm g{wsp<bf16_t>(p, WS_ACT), wsp<bf16_t>(p, WS_WD), DFF, DFF, 0, 0, 0};
                if (bid < Gg) pg8::gemm_phase<2>(lds, g, S, E, wave);
#endif
                if (Gg >= G) { dense_items(p, lds, wave, lane, DI_PER_L, 2 * DI_PER_L, gw, NGW); moe_convert(p, lds, wave, lane, CONV_CF, CONV_C3, gw, NGW); }
                else if (bid >= Gg) { dense_items(p, lds, wave, lane, DI_PER_L, 2 * DI_PER_L, (bid - Gg) * 8 + wave, (G - Gg) * 8);
                    moe_convert_pipe(p, lds, wave, lane, CONV_CF, CONV_C3, (bid - Gg) * 8 + wave, (G - Gg) * 8); }
            }
            SEAM(pb + 9);
        } else {
            if (PHEN(9) && IN(pb + 8)) for (int rep = 0; rep < REPS(9); ++rep) { OPQ
                moe_convert(p, lds, wave, lane, CONV_C5, NCONV, gw, NGW);
                __syncthreads();
                moe_tables(p, tb, tid);
                for (int row = gw; row < ML; row += 4 * NGW) {
                    i32x4r rt4[4]; u32x4 v4[4][2];
#pragma unroll
                    for (int q = 0; q < 4; ++q) { const int rw = min(row + q * NGW, ML - 1);
                        rt4[q] = *(const i32x4r*)(wsp<int>(p, WS_ROUTE) + (size_t)rw * 8);
                        const u32x4* src = (const u32x4*)(wsp<unsigned char>(p, WS_H) + (size_t)rw * DM);
                        v4[q][0] = src[lane]; v4[q][1] = src[lane + 64]; }
#pragma unroll
                    for (int q = 0; q < 4; ++q) { const int rw = row + q * NGW;
                        if (rw < ML) {
                            int* ro = wsp<int>(p, WS_ROUTE) + (size_t)rw * 8;
                            const int s0 = tb[rt4[q].x] + rt4[q].z, s1 = tb[rt4[q].y] + rt4[q].w;
                            if (lane == 0) { ro[6] = s0; ro[7] = s1; }
                            u32x4* d0 = (u32x4*)(wsp<unsigned char>(p, WS_HS) + (size_t)s0 * DM); u32x4* d1 = (u32x4*)(wsp<unsigned char>(p, WS_HS) + (size_t)s1 * DM);
                            d0[lane] = v4[q][0]; d1[lane] = v4[q][0]; d0[lane + 64] = v4[q][1]; d1[lane + 64] = v4[q][1];
                        } }
                }
            }
            SEAM(pb + 8);
            if (PHEN(10) && IN(pb + 9)) for (int rep = 0; rep < REPS(10); ++rep) { OPQ
                if (!MK_ONE_LAUNCH) moe_tables(p, tb, tid);
                pg8::Gemm g{wsp<unsigned char>(p, WS_HS), wsp<unsigned char>(p, WS_MGU), DM, DM, (size_t)2 * DFF * DM, 0x7f7f7f7f, 0x77777777};
                pg8::TileOrder S; S.init(__builtin_amdgcn_readfirstlane(tb[8]), 2 * DFF / 256, G, bid, tb + 16);
                pg8::EpiSwiGLU8 E{wsp<unsigned char>(p, WS_ACT), DFF};
                pg8::gemm_phase<1>(lds, g, S, E, wave);
            }
            SEAM(pb + 9);
            if (PHEN(11) && IN(pb + 10)) { OPQ
                if (!MK_ONE_LAUNCH) moe_tables(p, tb, tid);
                { pg8::Gemm g{wsp<unsigned char>(p, WS_ACT), wsp<unsigned char>(p, WS_MD), DFF, DFF, (size_t)DM * DFF, 0x7f7f7f7f, 0x77777777};
                  pg8::TileOrder S; S.init(MAIN_RT, DM / 256, G, bid, tb + 16);
                  pg8::EpiBf16 E{wsp<bf16_t>(p, WS_YS), DM, 0};
                  pg8::gemm_phase<1>(lds, g, S, E, wave); }
                SEAM(pb + 10);
                const int ntail = (__builtin_amdgcn_readfirstlane(tb[8]) - MAIN_RT) * 8;
                if (bid < 2 * ntail) {
                    const int half = bid >= ntail ? 1 : 0, t = bid - half * ntail, pm = t >> 3;
                    const pg8::OneUnit S{pm, t & 7, __builtin_amdgcn_readfirstlane(tb[16 + MAIN_RT + pm]), 1};
                    const pg8::Gemm g{wsp<unsigned char>(p, WS_ACT) + (size_t)MAIN_RT * 256 * DFF + half * (DFF / 2), wsp<unsigned char>(p, WS_MD) + half * (DFF / 2), DFF, DFF / 2, (size_t)DM * DFF, 0x7f7f7f7f, 0x77777777, DFF};
                    float* P = wsp<float>(p, WS_SPLIT) + (size_t)t * 65536; unsigned* fl = wsp<unsigned>(p, WS_CTL) + CW_SPLIT + 64 * t;
                    if (half == 0) { pg8::EpiPartial E{P, fl}; pg8::gemm_phase<1>(lds, g, S, E, wave); }
                    else { pg8::EpiBf16Add E{wsp<bf16_t>(p, WS_YS) + (size_t)MAIN_RT * 256 * DM, DM, P, fl}; pg8::gemm_phase<1>(lds, g, S, E, wave);
                        if (tid == 0) __hip_atomic_fetch_add(wsp<unsigned>(p, WS_CTL) + CW_TAIL, 1u, __ATOMIC_RELAXED, __HIP_MEMORY_SCOPE_AGENT); }
                }
            }
            if (PHEN(12) && IN(pb + 11)) { OPQ
                if (!MK_ONE_LAUNCH) moe_tables(p, tb, tid);
                const int ntail = (__builtin_amdgcn_readfirstlane(tb[8]) - MAIN_RT) * 8;
                const int c0 = 2 * ntail <= G / 2 ? 2 * ntail : 0;
                if (bid >= c0) {
                    const int NGWf = (G - c0) * 8, gwf = (bid - c0) * 8 + wave;
#pragma nounroll
                    for (int pass = 0; pass < 2; ++pass) {
                        int nblk = 0;
                        if (pass) {
                            while ((int)__builtin_amdgcn_readfirstlane(__hip_atomic_load(wsp<unsigned>(p, WS_CTL) + CW_TAIL, __ATOMIC_RELAXED, __HIP_MEMORY_SCOPE_AGENT)) < min(ntail, G)) __builtin_amdgcn_s_sleep(16);
                            __builtin_amdgcn_fence(__ATOMIC_ACQUIRE, "agent");
                        }
                for (int row0 = gwf; row0 < ML; row0 += 8 * NGWf) {
                    i32x4r rt8[8];
#pragma unroll
                    for (int q = 0; q < 8; ++q) rt8[q] = *(const i32x4r*)(wsp<int>(p, WS_ROUTE) + (size_t)min(row0 + q * NGWf, ML - 1) * 8 + 4);
#pragma unroll
                    for (int q = 0; q < 8; ++q) { const int row = row0 + q * NGWf;
                        const int s0 = __builtin_amdgcn_readfirstlane(rt8[q].z), s1 = __builtin_amdgcn_readfirstlane(rt8[q].w);
                        const int blk = (row < ML && (s0 >= MAIN_RT * 256 || s1 >= MAIN_RT * 256)) ? 1 : 0; nblk += blk;
                        if (row < ML && blk == pass) {
                    const float g0 = __int_as_float(rt8[q].x), g1 = __int_as_float(rt8[q].y);
                    const u32x4* y0 = (const u32x4*)(wsp<bf16_t>(p, WS_YS) + (size_t)s0 * DM); const u32x4* y1 = (const u32x4*)(wsp<bf16_t>(p, WS_YS) + (size_t)s1 * DM);
                    const float* gv = mod + (size_t)(row >> 12) * MODW + 5 * DM;
                    const u32x4* xr = (const u32x4*)(wsp<bf16_t>(p, WS_X1) + (size_t)row * DM); float* orow = p.out + (size_t)row * DM;
#pragma unroll
                    for (int j = 0; j < 4; ++j) { const int c = lane + 64 * j; const u32x4 a = y0[c], bq = y1[c];
                        const u32x4 xw = xr[c]; const f32x4 x0 = (f32x4){bf_lo(xw.x), bf_hi(xw.x), bf_lo(xw.y), bf_hi(xw.y)}, x1 = (f32x4){bf_lo(xw.z), bf_hi(xw.z), bf_lo(xw.w), bf_hi(xw.w)}, gg0 = *((const f32x4*)gv + 2 * c), gg1 = *((const f32x4*)gv + 2 * c + 1);
                        f32x4 r0, r1;
                        r0.x = x0.x + gg0.x * (g0 * bf_lo(a.x) + g1 * bf_lo(bq.x)); r0.y = x0.y + gg0.y * (g0 * bf_hi(a.x) + g1 * bf_hi(bq.x));
                        r0.z = x0.z + gg0.z * (g0 * bf_lo(a.y) + g1 * bf_lo(bq.y)); r0.w = x0.w + gg0.w * (g0 * bf_hi(a.y) + g1 * bf_hi(bq.y));
                        r1.x = x1.x + gg1.x * (g0 * bf_lo(a.z) + g1 * bf_lo(bq.z)); r1.y = x1.y + gg1.y * (g0 * bf_hi(a.z) + g1 * bf_hi(bq.z));
                        r1.z = x1.z + gg1.z * (g0 * bf_lo(a.w) + g1 * bf_lo(bq.w)); r1.w = x1.w + gg1.w * (g0 * bf_hi(a.w) + g1 * bf_hi(bq.w));
                        *((f32x4*)orow + 2 * c) = r0; *((f32x4*)orow + 2 * c + 1) = r1; }
                        } }
                }
                        if (nblk == 0) break;
                    }
                }
            }
        }
    }
#undef IN
#undef SEAM
}

extern "C" void kernel_launch(void* const* d_in, const int* in_sizes, int n_in, void* d_out, int out_size, void* d_ws, size_t ws_size, hipStream_t stream) {
    static int grid = 0;
    if (grid == 0) {
        if (n_in != 28 || out_size != ML * DM || ws_size < WS_END) { fprintf(stderr, "kernel_launch: unexpected problem (n_in %d, out %d, ws %zu < %zu)\n", n_in, out_size, ws_size, (size_t)WS_END); grid = -1; return; }
        int dev = 0, cus = 0, per_cu = 0;
        if (hipGetDevice(&dev) != hipSuccess || hipDeviceGetAttribute(&cus, hipDeviceAttributeMultiprocessorCount, dev) != hipSuccess) { grid = -1; return; }
        if (hipFuncSetAttribute((const void*)fwd_kernel, hipFuncAttributeMaxDynamicSharedMemorySize, LDS_BYTES) != hipSuccess) { fprintf(stderr, "kernel_launch: hipFuncSetAttribute failed\n"); grid = -1; return; }
        if (hipOccupancyMaxActiveBlocksPerMultiprocessor(&per_cu, (const void*)fwd_kernel, 512, LDS_BYTES) != hipSuccess || per_cu < 1) { fprintf(stderr, "kernel_launch: occupancy query says %d\n", per_cu); }
        (void)hipGetLastError();
        grid = cus;
    }
    if (grid < 0) return;
    (void)hipMemsetAsync((char*)d_ws + WS_CTL, 0, CTL_BYTES, stream);
    Params prm{};
    for (int i = 0; i < 28; ++i) prm.in[i] = (const float*)d_in[i];
    prm.out = (float*)d_out; prm.ws = (unsigned char*)d_ws;
#if MK_ONE_LAUNCH
    prm.ph_lo = 0; prm.ph_hi = NPHASE + 1;
    hipLaunchKernelGGL(fwd_kernel, dim3(grid), dim3(512), LDS_BYTES, stream, prm);
#else
    for (int ph = 0; ph <= NPHASE; ++ph) {
        if (ph == 11 || ph == 12) continue;
        prm.ph_lo = ph; prm.ph_hi = ph + 1;
        hipLaunchKernelGGL(fwd_kernel, dim3(grid), dim3(512), LDS_BYTES, stream, prm);
    }
#endif
}
```

```cpp
#include <hip/hip_runtime.h>
#include <cstdio>
#include <cstdint>

#define LAS __attribute__((address_space(3)))
#define GAS __attribute__((address_space(1)))
typedef unsigned short bf16_t;
typedef short bf16x8 __attribute__((ext_vector_type(8)));
typedef float f32x2 __attribute__((ext_vector_type(2)));
typedef float f32x4 __attribute__((ext_vector_type(4)));
typedef float f32x16 __attribute__((ext_vector_type(16)));
typedef unsigned u32x2 __attribute__((ext_vector_type(2)));
typedef unsigned u32x4 __attribute__((ext_vector_type(4)));
typedef GAS unsigned gu32;
typedef int i32x4r __attribute__((ext_vector_type(4)));

#ifndef FFN1_FP8
#define FFN1_FP8 1
#endif
#ifndef FFN2_FP8
#define FFN2_FP8 1
#endif
#ifndef MK_ONE_LAUNCH
#define MK_ONE_LAUNCH 1
#endif

constexpr int DM = 2048, NB = 4, SEQ = 4096, CTXL = 256, KEYS = SEQ + CTXL;
constexpr int ML = NB * SEQ, MC = NB * CTXL, MT = ML + MC;
constexpr int INC = 4896, INCP = 5120, DFF = 7168, NEXP = 8, MODW = 6 * DM;
constexpr int MSLOT = 2 * ML + NEXP * 256;
constexpr float EPS = 1e-6f, LOG2E = 1.4426950408889634f;
constexpr int PC_AQ = 0, PC_AK = 512, PC_AV = 640, PC_BQ = 768, PC_BKV = 1152, PC_CQ = 1280, PC_CK = 1792, PC_CV = 2304, PC_CG = 2816,
              PC_DQ = 3328, PC_DK = 3840, PC_DV = 4352, PC_BKR = 4864;

constexpr size_t al256(size_t x) { return (x + 255) & ~(size_t)255; }
constexpr size_t WS_CTL = 0, CTL_BYTES = 1u << 20;
constexpr size_t WS_MOD = WS_CTL + CTL_BYTES;
constexpr size_t WS_ROPE64 = WS_MOD + al256((size_t)2 * 5 * MODW * 4);
constexpr size_t WS_ROPE32 = WS_ROPE64 + al256((size_t)SEQ * 32 * 2 * 4);
constexpr size_t WS_RKV = WS_ROPE32 + al256((size_t)SEQ * 16 * 2 * 4);
constexpr size_t WS_RPB = WS_RKV + al256((size_t)MT * 4);
constexpr size_t WS_ROUTE = WS_RPB + al256((size_t)2 * 8 * 15 * 128 * 4);
constexpr size_t WS_WIN = WS_ROUTE + al256((size_t)ML * 32);
constexpr size_t WS_WOUT = WS_WIN + al256((size_t)2 * INCP * DM * 2);
constexpr size_t WS_WUP = WS_WOUT + al256((size_t)2 * DM * DM * 2);
constexpr size_t WS_WGU = WS_WUP + al256((size_t)2 * 1792 * 512 * 2);
constexpr size_t WS_WD = WS_WGU + al256((size_t)2 * DFF * DM * 2);
constexpr size_t WS_MGU = WS_WD + al256((size_t)DM * DFF * 2);
constexpr size_t WS_MD = WS_MGU + al256((size_t)NEXP * 2 * DFF * DM * 2);
constexpr size_t WS_X1 = WS_MD + al256((size_t)NEXP * DM * DFF * 2);
constexpr size_t WS_H = WS_X1 + al256((size_t)MT * DM * 4);
constexpr size_t WS_P = WS_H + al256((size_t)MT * DM * 2);
constexpr size_t WS_UPRAW = WS_P + al256((size_t)MT * INCP * 2);
constexpr size_t WS_QA = WS_UPRAW + al256((size_t)MT * 1792 * 2);
constexpr size_t WS_KA = WS_QA + al256((size_t)MT * 512 * 2);
constexpr size_t WS_VTA = WS_KA + al256((size_t)NB * 2 * KEYS * 64 * 2);
constexpr size_t WS_QB = WS_VTA + al256((size_t)NB * 2 * KEYS * 64 * 2);
constexpr size_t WS_KB = WS_QB + al256((size_t)MT * 768 * 2);
constexpr size_t WS_VTB = WS_KB + al256((size_t)NB * 8 * KEYS * 96 * 2);
constexpr size_t HB64 = al256((size_t)NB * 8 * KEYS * 64 * 2);
constexpr size_t WS_QC = WS_VTB + HB64;
constexpr size_t WS_KC = WS_QC + al256((size_t)MT * 512 * 2);
constexpr size_t WS_KWF = WS_KC + HB64, WS_KWR = WS_KWF + HB64, WS_VTC = WS_KWR + HB64;
constexpr size_t WS_QD = WS_VTC + HB64;
constexpr size_t WS_KD = WS_QD + al256((size_t)MT * 512 * 2), WS_VTD = WS_KD + HB64;
constexpr size_t WS_KVST = WS_VTD + HB64;
constexpr size_t WS_SPREV = WS_KVST + al256((size_t)64 * 34 * 4096 * 4);
constexpr size_t WS_OCAT = WS_SPREV + al256((size_t)64 * 34 * 4096 * 2);
constexpr size_t WS_ACT = WS_OCAT + al256((size_t)MT * DM * 2);
constexpr size_t WS_HS = WS_ACT + al256((size_t)MSLOT * DFF * 2);
constexpr size_t WS_YS = WS_HS + al256((size_t)MSLOT * DM * 2);
constexpr size_t WS_SPLIT = WS_YS + al256((size_t)MSLOT * DM * 2);
constexpr size_t WS_RQ = WS_SPLIT + (size_t)64 * 65536 * 4;
constexpr size_t WS_END = WS_RQ + al256((size_t)MT * 4);
constexpr int CW_BAR = 4096;
constexpr int CW_Q = 8192;
constexpr int CW_ECNT = 16384;
constexpr int CW_SPLIT = 36864;
constexpr int CW_TAIL = 32768;

constexpr int RING_BYTES = 131072;
constexpr int MISC_OFF = 146432;
constexpr int LDS_BYTES = 147456;

__device__ __forceinline__ unsigned cvt_pk_bf16(float lo, float hi) { unsigned r; asm volatile("v_cvt_pk_bf16_f32 %0, %1, %2" : "=v"(r) : "v"(lo), "v"(hi)); return r; }
__device__ __forceinline__ float bf_lo(unsigned w) { return __uint_as_float(w << 16); }
__device__ __forceinline__ float bf_hi(unsigned w) { return __uint_as_float(w & 0xffff0000u); }
__device__ __forceinline__ float bf2f(bf16_t h) { return __uint_as_float((unsigned)h << 16); }
__device__ __forceinline__ float fexp2(float x) { return __builtin_amdgcn_exp2f(x); }
__device__ __forceinline__ float frcp(float x) { return __builtin_amdgcn_rcpf(x); }
__device__ __forceinline__ float silu_f(float g) { return g * frcp(1.0f + fexp2(-g * LOG2E)); }
__device__ __forceinline__ unsigned pack_fp8x4(float a, float b, float c, float d) {
    a = __builtin_amdgcn_fmed3f(a, -448.f, 448.f); b = __builtin_amdgcn_fmed3f(b, -448.f, 448.f); c = __builtin_amdgcn_fmed3f(c, -448.f, 448.f); d = __builtin_amdgcn_fmed3f(d, -448.f, 448.f);
    int w = 0; w = __builtin_amdgcn_cvt_pk_fp8_f32(a, b, w, false); w = __builtin_amdgcn_cvt_pk_fp8_f32(c, d, w, true); return (unsigned)w; }
#if 1
__device__ __forceinline__ float opaque_zero() { return 0.f; }
#else
__device__ __forceinline__ float opaque_zero() { float z; asm volatile("v_mov_b32 %0, 0" : "=v"(z)); return z; }
#endif
__device__ __forceinline__ float xhalf_max(float m) { const auto rr = __builtin_amdgcn_permlane32_swap(__float_as_uint(m), __float_as_uint(m), false, false); return fmaxf(__uint_as_float(rr[0]), __uint_as_float(rr[1])); }
__device__ __forceinline__ float xhalf_sum(float m) { const auto rr = __builtin_amdgcn_permlane32_swap(__float_as_uint(m), __float_as_uint(m), false, false); return __uint_as_float(rr[0]) + __uint_as_float(rr[1]); }
__device__ __forceinline__ int lnd_s(int x) { asm volatile("" : "+s"(x)); return x; }
__device__ __forceinline__ float shfl_idx(float x, int src) { return __int_as_float(__builtin_amdgcn_ds_bpermute(src << 2, __float_as_int(x))); }
__device__ __forceinline__ int lane_id_asm() { int l; asm volatile("v_mbcnt_lo_u32_b32 %0, -1, 0\n\tv_mbcnt_hi_u32_b32 %0, -1, %0" : "=v"(l)); return l; }
template <int N> __device__ __forceinline__ float dpp_ror(float v) { return __int_as_float(__builtin_amdgcn_update_dpp(0, __float_as_int(v), 0x120 + N, 0xf, 0xf, false)); }
__device__ __forceinline__ float row_sum16(float v) { v += dpp_ror<8>(v); v += dpp_ror<4>(v); v += dpp_ror<2>(v); v += dpp_ror<1>(v); return v; }
__device__ __forceinline__ float wave_sum(float v) {
    v = row_sum16(v);
    const float a = __int_as_float(__builtin_amdgcn_readlane(__float_as_int(v), 0)), b = __int_as_float(__builtin_amdgcn_readlane(__float_as_int(v), 16));
    const float c = __int_as_float(__builtin_amdgcn_readlane(__float_as_int(v), 32)), d = __int_as_float(__builtin_amdgcn_readlane(__float_as_int(v), 48));
    return (a + b) + (c + d);
}
__device__ __forceinline__ void row_bp(int row, int& b, int& p) { if (row < ML) { b = row >> 12; p = row & (SEQ - 1); } else { const int r = row - ML; b = r >> 8; p = SEQ + (r & (CTXL - 1)); } }
__device__ __forceinline__ int bp_row(int b, int p) { return p < SEQ ? b * SEQ + p : ML + b * CTXL + (p - SEQ); }
namespace pg8 {
constexpr int BM = 256, BK = 64, HALF = 128, HTB = HALF * BK * 2  , STAGE_BYTES = 8 * HTB, NXCD = 8, WGM = 8;
__host__ __device__ __forceinline__ int lds_byte(int r, int c) { const int st = (r >> 4) * 2 + (c >> 5), rr = r & 15, cc = c & 31, ob = rr * 64 + cc * 2; return st * 1024 + (ob ^ (((ob >> 9) & 1) << 5)); }
__host__ __device__ __forceinline__ void stage_rc(int b, int& R, int& C) { const int st = b / 1024, sb = b % 1024, swz = sb ^ (((sb >> 9) & 1) << 5); R = (st >> 1) * 16 + swz / 64; C = (st & 1) * 32 + (swz % 64) / 2; }
__host__ __device__ __forceinline__ int perm32(int rho) { const int n = rho >> 4, i = rho & 15; return 8 * (i >> 2) + 4 * n + (i & 3); }

struct Unit { int pm, pn, eb; };
struct Gemm { const void* A; const void* Bt; int lda, K; size_t bstride; int scaleA, scaleB; int ldb; };
typedef int i32x8 __attribute__((ext_vector_type(8)));
typedef int i32x4 __attribute__((ext_vector_type(4)));
__device__ __forceinline__ i32x8 cat8(bf16x8 lo, bf16x8 hi) { return __builtin_shufflevector(__builtin_bit_cast(i32x4, lo), __builtin_bit_cast(i32x4, hi), 0, 1, 2, 3, 4, 5, 6, 7); }

struct TileOrder {
    int nM, nN, nwg, G, c; const LAS int* tile_e;
    __device__ void init(int nM_, int nN_, int G_, int c_, const LAS int* te) { nM = nM_; nN = nN_; nwg = nM * nN; G = G_; c = c_; tile_e = te; }
    __device__ bool idle_last_round() const { const int R = (nwg + G - 1) / G; return c + (R - 1) * G >= nwg; }
    __device__ int first_idle() const { const int R = (nwg + G - 1) / G; return nwg - (R - 1) * G; }
    __device__ bool next(int i, Unit& u) const {
        const long L = (long)i * G + c; if (L >= nwg) return false;
        int wgid = (int)L; { const int q = nwg / NXCD, r = nwg % NXCD, xcd = wgid % NXCD, off = wgid / NXCD; wgid = (xcd < r ? xcd * (q + 1) : r * (q + 1) + (xcd - r) * q) + off; }
        const int nig = WGM * nN, gid = wgid / nig, fm = gid * WGM, gsz = (nM - fm) < WGM ? (nM - fm) : WGM;
        u.pm = fm + ((wgid % nig) % gsz); u.pn = (wgid % nig) / gsz; u.eb = tile_e ? __builtin_amdgcn_readfirstlane(tile_e[u.pm]) : 0; return true;
    }
};

struct EpiBf16 {
    static constexpr bool PERM = true;
    bf16_t* O; int ldc; int wt;
    __device__ __forceinline__ void operator()(const f32x4 (&acc)[2][2][4][2], const Unit& u, int wr, int wc, int fr, int fq) const {
        const int row0 = u.pm * BM + wr * 64 + fr, col0 = u.pn * BM + wc * 32 + 8 * fq;
        if (wt) {
            const __amdgpu_buffer_rsrc_t rs = __builtin_amdgcn_make_buffer_rsrc((void*)O, 0, 0x7ffffff0, 0x00020000);
#pragma unroll
            for (int ai = 0; ai < 2; ++ai)
#pragma unroll
                for (int m = 0; m < 4; ++m) { const int ob = ((row0 + ai * HALF + m * 16) * ldc + col0) * 2;
#pragma unroll
                    for (int bj = 0; bj < 2; ++bj) { const f32x4 v0 = acc[ai][bj][m][0], v1 = acc[ai][bj][m][1];
                        u32x4 w; w.x = cvt_pk_bf16(v0[0], v0[1]); w.y = cvt_pk_bf16(v0[2], v0[3]); w.z = cvt_pk_bf16(v1[0], v1[1]); w.w = cvt_pk_bf16(v1[2], v1[3]);
                        __builtin_amdgcn_raw_buffer_store_b128(w, rs, ob + bj * HALF * 2, 0, 16); } }
            return;
        }
#pragma unroll
        for (int ai = 0; ai < 2; ++ai)
#pragma unroll
            for (int m = 0; m < 4; ++m) { bf16_t* rowp = O + (size_t)(row0 + ai * HALF + m * 16) * ldc + col0;
#pragma unroll
                for (int bj = 0; bj < 2; ++bj) { const f32x4 v0 = acc[ai][bj][m][0], v1 = acc[ai][bj][m][1];
                    u32x4 w; w.x = cvt_pk_bf16(v0[0], v0[1]); w.y = cvt_pk_bf16(v0[2], v0[3]); w.z = cvt_pk_bf16(v1[0], v1[1]); w.w = cvt_pk_bf16(v1[2], v1[3]);
                    *(u32x4*)(rowp + bj * HALF) = w; } }
    }
};
struct EpiSwiGLU {
    static constexpr bool PERM = true;
    bf16_t* O; int ldc;
    __device__ __forceinline__ void operator()(const f32x4 (&acc)[2][2][4][2], const Unit& u, int wr, int wc, int fr, int fq) const {
        const int row0 = u.pm * BM + wr * 64 + fr, col0 = u.pn * HALF + wc * 32 + 8 * fq;
#pragma unroll
        for (int ai = 0; ai < 2; ++ai)
#pragma unroll
            for (int m = 0; m < 4; ++m) { bf16_t* rowp = O + (size_t)(row0 + ai * HALF + m * 16) * ldc + col0;
                float o[8];
#pragma unroll
                for (int n = 0; n < 2; ++n)
#pragma unroll
                    for (int j = 0; j < 4; ++j) o[n * 4 + j] = silu_f(acc[ai][0][m][n][j]) * acc[ai][1][m][n][j];
                u32x4 w; w.x = cvt_pk_bf16(o[0], o[1]); w.y = cvt_pk_bf16(o[2], o[3]); w.z = cvt_pk_bf16(o[4], o[5]); w.w = cvt_pk_bf16(o[6], o[7]);
                *(u32x4*)rowp = w; asm volatile("" ::: "memory"); }
    }
};
struct EpiSwiGLU8 {
    static constexpr bool PERM = true;
    unsigned char* O; int ldc;
    __device__ __forceinline__ void operator()(const f32x4 (&acc)[2][2][4][2], const Unit& u, int wr, int wc, int fr, int fq) const {
        const int row0 = u.pm * BM + wr * 64 + fr, col0 = u.pn * HALF + wc * 32 + 8 * fq;
#pragma unroll
        for (int ai = 0; ai < 2; ++ai)
#pragma unroll
            for (int m = 0; m < 4; ++m) { unsigned char* rowp = O + (size_t)(row0 + ai * HALF + m * 16) * ldc + col0;
                float o[8];
#pragma unroll
                for (int n = 0; n < 2; ++n)
#pragma unroll
                    for (int j = 0; j < 4; ++j) o[n * 4 + j] = silu_f(acc[ai][0][m][n][j]) * acc[ai][1][m][n][j];
                u32x2 w; w.x = pack_fp8x4(o[0], o[1], o[2], o[3]); w.y = pack_fp8x4(o[4], o[5], o[6], o[7]);
                *(u32x2*)rowp = w; asm volatile("" ::: "memory"); }
    }
};
template <bool BF32>
struct EpiResid {
    static constexpr bool PERM = true;
    const void* base_lat; const void* base_ctx; bf16_t* out; const float* gate;
    __device__ __forceinline__ void operator()(const f32x4 (&acc)[2][2][4][2], const Unit& u, int wr, int wc, int fr, int fq) const {
        const bool isctx = u.pm >= ML / BM;
        const char* base = isctx ? (const char*)base_ctx - (size_t)ML * DM * (BF32 ? 4 : 2) : (const char*)base_lat;
        const float* gv = gate + (size_t)(isctx ? 4 : (u.pm >> 4)) * MODW;
        const int col0 = u.pn * BM + wc * 32 + 8 * fq;
        f32x4 g[2][2];
#pragma unroll
        for (int bj = 0; bj < 2; ++bj)
#pragma unroll
            for (int n = 0; n < 2; ++n) g[bj][n] = *(const f32x4*)(gv + col0 + bj * HALF + n * 4);
        f32x4 bsf[BF32 ? 3 : 1][2][2]; u32x4 bsb[BF32 ? 1 : 3][2];
        const size_t off0 = (size_t)(u.pm * BM + wr * 64 + fr) * DM + col0;
#define ER_LOAD(q) do { const size_t off_ = off0 + (size_t)(((q) >> 2) * HALF + ((q) & 3) * 16) * DM; _Pragma("unroll") for (int bj = 0; bj < 2; ++bj) { \
            if constexpr (BF32) { _Pragma("unroll") for (int n = 0; n < 2; ++n) bsf[(q) % 3][bj][n] = *(const f32x4*)((const float*)base + off_ + bj * HALF + n * 4); } \
            else bsb[(q) % 3][bj] = *(const u32x4*)((const bf16_t*)base + off_ + bj * HALF); } } while (0)
        ER_LOAD(0); ER_LOAD(1);
#pragma unroll
        for (int q = 0; q < 8; ++q) {
            if (q + 2 < 8) ER_LOAD(q + 2);
            const int ai = q >> 2, m = q & 3; const size_t off = off0 + (size_t)(ai * HALF + m * 16) * DM;
#pragma unroll
            for (int bj = 0; bj < 2; ++bj) {
                f32x4 b0, b1;
                if constexpr (BF32) { b0 = bsf[q % 3][bj][0]; b1 = bsf[q % 3][bj][1]; }
                else { const u32x4 w = bsb[q % 3][bj]; b0 = (f32x4){bf_lo(w.x), bf_hi(w.x), bf_lo(w.y), bf_hi(w.y)}; b1 = (f32x4){bf_lo(w.z), bf_hi(w.z), bf_lo(w.w), bf_hi(w.w)}; }
                const f32x4 r0 = b0 + g[bj][0] * acc[ai][bj][m][0], r1 = b1 + g[bj][1] * acc[ai][bj][m][1];
                u32x4 o; o.x = cvt_pk_bf16(r0[0], r0[1]); o.y = cvt_pk_bf16(r0[2], r0[3]); o.z = cvt_pk_bf16(r1[0], r1[1]); o.w = cvt_pk_bf16(r1[2], r1[3]);
                *(u32x4*)(out + off + bj * HALF) = o; }
            asm volatile("" ::: "memory");
        }
#undef ER_LOAD
    }
};

struct OneUnit { int pm, pn, eb, valid; __device__ bool next(int i, Unit& u) const { if (i > 0 || !valid) return false; u.pm = pm; u.pn = pn; u.eb = eb; return true; } };
struct EpiPartial {
    static constexpr bool PERM = true;
    float* P; unsigned* flag;
    __device__ __forceinline__ void operator()(const f32x4 (&acc)[2][2][4][2], const Unit& u, int wr, int wc, int fr, int fq) const {
        const int wv = wr * 4 + wc, ln = fq * 16 + fr;
        const __amdgpu_buffer_rsrc_t rs = __builtin_amdgcn_make_buffer_rsrc((void*)P, 0, 65536 * 4, 0x00020000);
#pragma unroll
        for (int ai = 0; ai < 2; ++ai)
#pragma unroll
            for (int bj = 0; bj < 2; ++bj)
#pragma unroll
                for (int m = 0; m < 4; ++m)
#pragma unroll
                    for (int n = 0; n < 2; ++n) { const int gi = ((ai * 2 + bj) * 4 + m) * 2 + n;
                        __builtin_amdgcn_raw_buffer_store_b128(__builtin_bit_cast(u32x4, acc[ai][bj][m][n]), rs, ((wv * 32 + gi) * 64 + ln) * 16, 0, 16); }
        asm volatile("s_waitcnt vmcnt(0)" ::: "memory");
        if (ln == 0) __hip_atomic_fetch_add(flag, 1u, __ATOMIC_RELAXED, __HIP_MEMORY_SCOPE_AGENT);
    }
};
struct EpiBf16Add {
    static constexpr bool PERM = true;
    bf16_t* O; int ldc; const float* P; unsigned* flag;
    __device__ __forceinline__ void operator()(const f32x4 (&acc)[2][2][4][2], const Unit& u, int wr, int wc, int fr, int fq) const {
        const int wv = wr * 4 + wc, ln = fq * 16 + fr;
        while (__builtin_amdgcn_readfirstlane(__hip_atomic_load(flag, __ATOMIC_RELAXED, __HIP_MEMORY_SCOPE_AGENT)) < 8u) __builtin_amdgcn_s_sleep(4);
        __builtin_amdgcn_fence(__ATOMIC_ACQUIRE, "agent");
        const f32x4* pp = (const f32x4*)P + (size_t)(wv * 32) * 64 + ln;
        const int row0 = u.pm * BM + wr * 64 + fr, col0 = u.pn * BM + wc * 32 + 8 * fq;
        const __amdgpu_buffer_rsrc_t rs = __builtin_amdgcn_make_buffer_rsrc((void*)O, 0, 0x7ffffff0, 0x00020000);
        f32x4 q[3][2][2];
#define EA_LOAD(g_) do { _Pragma("unroll") for (int bj = 0; bj < 2; ++bj) _Pragma("unroll") for (int n = 0; n < 2; ++n) \
            q[(g_) % 3][bj][n] = pp[(((((g_) >> 2) * 2 + bj) * 4 + ((g_) & 3)) * 2 + n) * 64]; } while (0)
        EA_LOAD(0); EA_LOAD(1);
#pragma unroll
        for (int g_ = 0; g_ < 8; ++g_) {
            if (g_ + 2 < 8) EA_LOAD(g_ + 2);
            const int ai = g_ >> 2, m = g_ & 3; const int ob = ((row0 + ai * HALF + m * 16) * ldc + col0) * 2;
#pragma unroll
            for (int bj = 0; bj < 2; ++bj) { const f32x4 v0 = acc[ai][bj][m][0] + q[g_ % 3][bj][0], v1 = acc[ai][bj][m][1] + q[g_ % 3][bj][1];
                u32x4 w; w.x = cvt_pk_bf16(v0[0], v0[1]); w.y = cvt_pk_bf16(v0[2], v0[3]); w.z = cvt_pk_bf16(v1[0], v1[1]); w.w = cvt_pk_bf16(v1[2], v1[3]);
                __builtin_amdgcn_raw_buffer_store_b128(w, rs, ob + bj * HALF * 2, 0, 16); }
            asm volatile("" ::: "memory");
        }
#undef EA_LOAD
    }
};

template <int ES  , class Epi, class Sched>
__device__ __forceinline__ void gemm_phase(LAS unsigned char* lds, const Gemm g, const Sched& S, const Epi& E, int wid) {
    const int lane = lane_id_asm(), tid = wid * 64 + lane, wr = wid >> 2, wc = wid & 3, fr = lane & 15, fq = lane >> 4;
    const int K = g.K, nt = K * ES / (BK * 2), lda = g.lda, ldb = g.ldb ? g.ldb : g.K;
    int sclA = g.scaleA, sclB = g.scaleB; asm volatile("" : "+v"(sclA), "+v"(sclB));
    unsigned voffA[2], voffB[2];
#pragma unroll
    for (int i = 0; i < 2; ++i) { int R, C; stage_rc(tid * 16 + i * 8192, R, C); const int Rb = Epi::PERM ? ((R & ~31) + perm32(R & 31)) : R;
        voffA[i] = (unsigned)(R * lda * ES + C * 2); voffB[i] = (unsigned)(Rb * ldb * ES + C * 2); }
    const size_t kstep = (size_t)(BK * 2);
    const size_t hstepA = (size_t)HALF * lda * ES, hstepB = (size_t)HALF * ldb * ES;
    const size_t tstepA = 2 * hstepA, tstepB = 2 * hstepB;
    const unsigned ldsw = (unsigned)wid * 1024u;
    const int aoff = lds_byte(wr * 64 + fr, fq * 8), boff = lds_byte(wc * 32 + fr, fq * 8);
#define PG8_SA(b, h) (((b) * 2 + (h)) * HTB)
#define PG8_SB(b, h) ((4 + (b) * 2 + (h)) * HTB)
#define PG8_STAGE(bufoff, gbase, voff) do { _Pragma("unroll") for (int _i = 0; _i < 2; ++_i) \
        __builtin_amdgcn_global_load_lds((const GAS unsigned*)((const char*)(gbase) + (voff)[_i]), (LAS unsigned*)(lds + (bufoff) + ldsw + _i * 8192), 16, 0, 0); } while (0)
#define PG8_LDA(dst, b, h) do { _Pragma("unroll") for (int m = 0; m < 4; ++m) _Pragma("unroll") for (int k = 0; k < 2; ++k) dst[m][k] = *(const LAS bf16x8*)(lds + PG8_SA(b, h) + aoff + m * 2048 + k * 1024); } while (0)
#define PG8_LDB(dst, b, h) do { _Pragma("unroll") for (int n = 0; n < 2; ++n) _Pragma("unroll") for (int k = 0; k < 2; ++k) dst[n][k] = *(const LAS bf16x8*)(lds + PG8_SB(b, h) + boff + n * 2048 + k * 1024); } while (0)
#define PG8_MMA(ai, bj, At, Bt) do { __builtin_amdgcn_s_setprio(1); _Pragma("unroll") for (int m = 0; m < 4; ++m) _Pragma("unroll") for (int n = 0; n < 2; ++n) { \
        if constexpr (ES == 2) { _Pragma("unroll") for (int k = 0; k < 2; ++k) acc[ai][bj][m][n] = __builtin_amdgcn_mfma_f32_16x16x32_bf16(Bt[n][k], At[m][k], acc[ai][bj][m][n], 0, 0, 0); } \
        else { const i32x8 _a = cat8(Bt[n][0], Bt[n][1]), _b = cat8(At[m][0], At[m][1]); \
               asm volatile("v_mfma_scale_f32_16x16x128_f8f6f4 %0, %1, %2, %0, %3, %4 op_sel_hi:[0,0,0]" : "+v"(acc[ai][bj][m][n]) : "v"(_a), "v"(_b), "v"(sclB), "v"(sclA)); } } \
        __builtin_amdgcn_s_setprio(0); } while (0)
#define PG8_WAIT_V(n) asm volatile("s_waitcnt vmcnt(" #n ")" ::: "memory")
#define PG8_WAIT_L(n) asm volatile("s_waitcnt lgkmcnt(" #n ")" ::: "memory")
#define PG8_BAR __builtin_amdgcn_s_barrier()
#define PG8_SCHED __builtin_amdgcn_sched_barrier(0)
    Unit cur, nxt; int ui = 0;
    if (!S.next(0, cur)) return;
    f32x4 acc[2][2][4][2];
    float zr = opaque_zero();
#pragma unroll
    for (int a = 0; a < 2; ++a)
#pragma unroll
        for (int b = 0; b < 2; ++b)
#pragma unroll
            for (int m = 0; m < 4; ++m)
#pragma unroll
                for (int n = 0; n < 2; ++n) acc[a][b][m][n] = (f32x4){zr, zr, zr, zr};
    bf16x8 At[4][2], B0[2][2], B1[2][2];
    const char* cA = (const char*)g.A + (size_t)cur.pm * tstepA; const char* cB = (const char*)g.Bt + ((size_t)cur.eb * g.bstride) * ES + (size_t)cur.pn * tstepB;
    PG8_STAGE(PG8_SB(0, 0), cB, voffB); PG8_STAGE(PG8_SB(0, 1), cB + hstepB, voffB); PG8_STAGE(PG8_SA(0, 0), cA, voffA); PG8_STAGE(PG8_SA(0, 1), cA + hstepA, voffA);
    if (wr == 1) PG8_BAR;
    PG8_WAIT_V(2); PG8_BAR;
    PG8_STAGE(PG8_SB(1, 0), cB + kstep, voffB); PG8_STAGE(PG8_SA(1, 0), cA + kstep, voffA); PG8_STAGE(PG8_SB(1, 1), cB + hstepB + kstep, voffB);
    PG8_WAIT_V(6); PG8_BAR;
    for (;;) {
        const bool has_next = S.next(ui + 1, nxt);
        const char* nA = has_next ? (const char*)g.A + (size_t)nxt.pm * tstepA : cA;
        const char* nB = has_next ? (const char*)g.Bt + ((size_t)nxt.eb * g.bstride) * ES + (size_t)nxt.pn * tstepB : cB;
#pragma nounroll
        for (int t = 0; t < nt; t += 2) {
            const bool last = (t == nt - 2);
            const char* a1 = cA + (size_t)(t + 1) * kstep;
            const char* a2 = last ? nA : cA + (size_t)(t + 2) * kstep; const char* b2 = last ? nB : cB + (size_t)(t + 2) * kstep;
            const char* a3 = a2 + kstep; const char* b3 = b2 + kstep;
            PG8_LDB(B0, 0, 0); PG8_LDB(B1, 0, 1); PG8_SCHED; PG8_LDA(At, 0, 0); PG8_STAGE(PG8_SA(1, 1), a1 + hstepA, voffA);
            PG8_WAIT_V(8); PG8_WAIT_L(0); PG8_BAR; PG8_MMA(0, 0, At, B0); PG8_MMA(0, 1, At, B1); PG8_BAR; PG8_SCHED;
            PG8_LDA(At, 0, 1); PG8_STAGE(PG8_SB(0, 0), b2, voffB); PG8_STAGE(PG8_SB(0, 1), b2 + hstepB, voffB); PG8_STAGE(PG8_SA(0, 0), a2, voffA);
            PG8_WAIT_V(8); PG8_WAIT_L(0); PG8_BAR; PG8_MMA(1, 0, At, B0); PG8_MMA(1, 1, At, B1); PG8_BAR; PG8_SCHED;
            PG8_LDB(B0, 1, 0); PG8_LDB(B1, 1, 1); PG8_SCHED; PG8_LDA(At, 1, 0); PG8_STAGE(PG8_SA(0, 1), a2 + hstepA, voffA);
            PG8_WAIT_V(8); PG8_WAIT_L(0); PG8_BAR; PG8_MMA(0, 0, At, B0); PG8_MMA(0, 1, At, B1); PG8_BAR; PG8_SCHED;
            PG8_LDA(At, 1, 1); PG8_STAGE(PG8_SB(1, 0), b3, voffB); PG8_STAGE(PG8_SB(1, 1), b3 + hstepB, voffB); PG8_STAGE(PG8_SA(1, 0), a3, voffA);
            PG8_WAIT_V(8); PG8_WAIT_L(0); PG8_BAR; PG8_MMA(1, 0, At, B0); PG8_MMA(1, 1, At, B1); PG8_BAR; PG8_SCHED;
        }
        if (wr == 0) PG8_BAR;
        if constexpr (ES == 1) asm volatile("s_nop 15\n\ts_nop 15" ::: "memory");
        E(acc, cur, wr, wc, fr, fq);
        if (!has_next) break;
        zr = opaque_zero();
#pragma unroll
        for (int a = 0; a < 2; ++a)
#pragma unroll
            for (int b = 0; b < 2; ++b)
#pragma unroll
                for (int m = 0; m < 4; ++m)
#pragma unroll
                    for (int n = 0; n < 2; ++n) acc[a][b][m][n] = (f32x4){zr, zr, zr, zr};
        cur = nxt; cA = nA; cB = nB; ++ui;
        if (wr == 1) PG8_BAR;
    }
    PG8_WAIT_V(0);
    PG8_BAR;
#undef PG8_SA
#undef PG8_SB
#undef PG8_STAGE
#undef PG8_LDA
#undef PG8_LDB
#undef PG8_MMA
#undef PG8_WAIT_V
#undef PG8_WAIT_L
#undef PG8_BAR
#undef PG8_SCHED
}
}
#define XB_TMO      128
#define XB_XCNT(j)  (256  + 64 * (j))
#define XB_XSUB(j)  (1280 + 64 * (j))
#define XB_XGEN(j)  (2304 + 64 * (j))
#define XB_TOP      3328
#define XB_TOPGEN   3392
#define XCD_BAR_WORDS 3456
#define XB_SPIN_CAP (1u << 18)
__device__ __forceinline__ unsigned xb_ld(unsigned* p)              { return __hip_atomic_load(p, __ATOMIC_RELAXED, __HIP_MEMORY_SCOPE_AGENT); }
__device__ __forceinline__ unsigned xb_add(unsigned* p, unsigned v) { return __hip_atomic_fetch_add(p, v, __ATOMIC_RELAXED, __HIP_MEMORY_SCOPE_AGENT); }
__device__ __forceinline__ unsigned xb_xcc_id() { return (unsigned)__builtin_amdgcn_s_getreg((3 << 11) | 20) & 0xFu; }
#define XB_SPIN(cond, bar) do { unsigned _sp = 0; while (cond) { __builtin_amdgcn_s_sleep(1); \
    if ((++_sp & 255u) == 0u) { if (xb_ld(&(bar)[XB_TMO])) break; if (_sp > XB_SPIN_CAP) { atomicAdd(&(bar)[XB_TMO], 1u); break; } } } } while (0)
struct XcdBarrier { unsigned* bar; unsigned x; volatile LAS unsigned* st; };
__device__ __forceinline__ XcdBarrier xcd_barrier_post(unsigned* bar, volatile LAS unsigned* st, bool leader) {
    XcdBarrier b; b.bar = bar; b.x = xb_xcc_id(); b.st = st;
    if (leader) (void)xb_add(&bar[XB_XCNT(b.x)], 1u);
    return b;
}
__device__ __forceinline__ void xcd_barrier_complete(unsigned* bar, unsigned x, unsigned& nloc, unsigned& nx) {
    const unsigned G = gridDim.x * gridDim.y * gridDim.z;
    unsigned sum, cnt, mine, sp = 0u;
    for (;;) {
        sum = 0u; cnt = 0u; mine = 0u;
#pragma unroll
        for (unsigned j = 0; j < 16; ++j) { const unsigned c = xb_ld(&bar[XB_XCNT(j)]); sum += c; cnt += (c > 0u) ? 1u : 0u; mine = (j == x) ? c : mine; }
        if (sum == G) break;
        __builtin_amdgcn_s_sleep(1);
        if ((++sp & 255u) == 0u) { if (xb_ld(&bar[XB_TMO])) break; if (sp > XB_SPIN_CAP) { atomicAdd(&bar[XB_TMO], 1u); break; } }
    }
    nloc = mine > 0u ? mine : 1u; nx = cnt > 0u ? cnt : 1u;
}
__device__ __forceinline__ void xcd_barrier(const XcdBarrier& b, bool leader) {
    asm volatile("s_waitcnt vmcnt(0)" ::: "memory");
    __syncthreads();
    if (leader) {
        unsigned* bar = b.bar; unsigned bx = b.x;
        asm volatile("" : "+s"(bar), "+s"(bx));
        __builtin_amdgcn_s_waitcnt(0);
        unsigned nloc = b.st[0], nx = b.st[1];
        if (nloc == 0u) { xcd_barrier_complete(bar, bx, nloc, nx); b.st[0] = nloc; b.st[1] = nx; }
        const unsigned old = xb_add(&bar[XB_XSUB(bx)], 1u);
        const unsigned gen = old / nloc;
        if (old + 1u == (gen + 1u) * nloc) {
            __builtin_amdgcn_fence(__ATOMIC_RELEASE, "agent");
            asm volatile("s_waitcnt vmcnt(0)" ::: "memory");
            const unsigned og = xb_add(&bar[XB_TOP], 1u);
            const unsigned tg = og / nx;
            if (og + 1u == (tg + 1u) * nx) xb_add(&bar[XB_TOPGEN], 1u);
            else XB_SPIN(xb_ld(&bar[XB_TOPGEN]) == tg, bar);
            __builtin_amdgcn_fence(__ATOMIC_ACQUIRE, "agent");
            xb_add(&bar[XB_XGEN(bx)], 1u);
            asm volatile("s_waitcnt vmcnt(0)" ::: "memory");
        } else {
            XB_SPIN(xb_ld(&bar[XB_XGEN(bx)]) == gen, bar);
            __builtin_amdgcn_fence(__ATOMIC_ACQUIRE, "agent");
            asm volatile("s_waitcnt vmcnt(0)" ::: "memory");
        }
    }
    __syncthreads();
}

struct Params { const float* in[28]; float* out; unsigned char* ws; int ph_lo, ph_hi; };
enum { I_X = 0, I_C, I_CTX, I_CCTX, I_WADA, I_BADA, I_NMIX, I_NFFN, I_WIN, I_WOUT, I_AQN, I_AKN, I_ASINK, I_BQAN, I_BKVAN, I_BWUQ, I_BWUKV, I_BQN, I_BKN,
       I_CLD, I_DQN, I_DKN, I_DRPB, I_FGU, I_FD, I_MR, I_MGU, I_MD };
template <class T> __device__ __forceinline__ T* wsp(const Params& p, size_t off) { return (T*)(p.ws + off); }
typedef const __attribute__((address_space(4))) Params* KArg;
__device__ __forceinline__ Params load_params(KArg k) {
    asm volatile("" : "+s"(k));
    Params p;
#pragma unroll
    for (int i = 0; i < 28; ++i) p.in[i] = k->in[i];
    p.out = k->out; p.ws = k->ws; p.ph_lo = k->ph_lo; p.ph_hi = k->ph_hi; return p;
}

__device__ __forceinline__ int q_next(const Params& p, int q, int lane) {
    unsigned v = 0;
    if (lane == 0) v = __hip_atomic_fetch_add(wsp<unsigned>(p, WS_CTL) + CW_Q + 64 * q, 1u, __ATOMIC_RELAXED, __HIP_MEMORY_SCOPE_AGENT);
    return (int)__builtin_amdgcn_readfirstlane(v);
}

template <class RMap>
__device__ __forceinline__ void transpose_item(const float* W, int K, int N, bf16_t* WT, int ldt, const float* kgain, LAS float* scr, int item, int lane, RMap rmap) {
    const int nblk = N / 32, kb = item / nblk, nb = item % nblk, k0 = 64 * kb, n0 = 32 * nb;
#pragma unroll
    for (int i = 0; i < 32; ++i) { const int kk = 2 * i + (lane >> 5); float v = W[(size_t)(k0 + kk) * N + n0 + (lane & 31)]; if (kgain) v *= kgain[k0 + kk]; scr[kk * 33 + (lane & 31)] = v; }
    asm volatile("s_waitcnt lgkmcnt(0)" ::: "memory");
    const int c = lane & 7; const int drow = rmap(n0);
#pragma unroll
    for (int j = 0; j < 4; ++j) { const int n = (lane >> 3) + 8 * j; const LAS float* s = scr + (8 * c) * 33 + n;
        u32x4 o; o.x = cvt_pk_bf16(s[0 * 33], s[1 * 33]); o.y = cvt_pk_bf16(s[2 * 33], s[3 * 33]); o.z = cvt_pk_bf16(s[4 * 33], s[5 * 33]); o.w = cvt_pk_bf16(s[6 * 33], s[7 * 33]);
        *(u32x4*)(WT + (size_t)(drow + n) * ldt + k0 + 8 * c) = o; }
    asm volatile("s_waitcnt lgkmcnt(0)" ::: "memory");
}
template <class RMap>
__device__ __forceinline__ void transpose_item_fp8(const float* W, int K, int N, unsigned char* WT, LAS float* scr, int item, int lane, RMap rmap) {
    const int nblk = N / 32, kb = item / nblk, nb = item % nblk, k0 = 64 * kb, n0 = 32 * nb;
#pragma unroll 8
    for (int i = 0; i < 32; ++i) { const int kk = 2 * i + (lane >> 5); scr[kk * 33 + (lane & 31)] = W[(size_t)(k0 + kk) * N + n0 + (lane & 31)] * 256.0f; }
    asm volatile("s_waitcnt lgkmcnt(0)" ::: "memory");
    const int c = lane & 7; const int drow = rmap(n0);
#pragma unroll
    for (int j = 0; j < 4; ++j) { const int n = (lane >> 3) + 8 * j; const LAS float* s = scr + (8 * c) * 33 + n;
        u32x2 o; o.x = pack_fp8x4(s[0 * 33], s[1 * 33], s[2 * 33], s[3 * 33]); o.y = pack_fp8x4(s[4 * 33], s[5 * 33], s[6 * 33], s[7 * 33]);
        *(u32x2*)(WT + (size_t)(drow + n) * K + k0 + 8 * c) = o; }
    asm volatile("s_waitcnt lgkmcnt(0)" ::: "memory");
}
template <bool FP8, class RMap>
__device__ __forceinline__ void transpose_item64(const float* W, int K, int N, void* WT, LAS float* scr, int item, int lane, RMap rmap) {
    const int nblk = N / 64, kb = item / nblk, nb = item % nblk, k0 = 64 * kb, n0 = 64 * nb;
    f32x4 v[16];
    const float* src = W + (size_t)(k0 + (lane >> 4)) * N + n0 + 4 * (lane & 15);
#pragma unroll
    for (int i = 0; i < 16; ++i) v[i] = __builtin_nontemporal_load((const f32x4*)(src + (size_t)(4 * i) * N));
#pragma unroll
    for (int i = 0; i < 16; ++i) { LAS float* d = scr + ((lane >> 4) + 4 * i) * 65 + 4 * (lane & 15); d[0] = v[i].x; d[1] = v[i].y; d[2] = v[i].z; d[3] = v[i].w; }
    asm volatile("s_waitcnt lgkmcnt(0)" ::: "memory");
    const int c = lane & 7; const int drow = rmap(n0);
#pragma unroll
    for (int j = 0; j < 8; ++j) { const int n = (lane >> 3) + 8 * j; const LAS float* s = scr + (8 * c) * 65 + n;
        if constexpr (FP8) { u32x2 o; o.x = pack_fp8x4(s[0] * 256.f, s[65] * 256.f, s[130] * 256.f, s[195] * 256.f); o.y = pack_fp8x4(s[260] * 256.f, s[325] * 256.f, s[390] * 256.f, s[455] * 256.f);
            *(u32x2*)((unsigned char*)WT + (size_t)(drow + n) * K + k0 + 8 * c) = o; }
        else { u32x4 o; o.x = cvt_pk_bf16(s[0], s[65]); o.y = cvt_pk_bf16(s[130], s[195]); o.z = cvt_pk_bf16(s[260], s[325]); o.w = cvt_pk_bf16(s[390], s[455]);
            *(u32x4*)((bf16_t*)WT + (size_t)(drow + n) * K + k0 + 8 * c) = o; } }
    asm volatile("s_waitcnt lgkmcnt(0)" ::: "memory");
}
struct RmIdent { __device__ int operator()(int n0) const { return n0; } };
struct RmWin { __device__ int operator()(int n0) const { return n0 < 1280 ? n0 : (n0 < 1312 ? n0 - 1280 + PC_BKR : n0 - 32); } };
struct RmGateUp { __device__ int operator()(int n0) const { const int u = n0 < DFF ? n0 : n0 - DFF; return 256 * (u >> 7) + (n0 < DFF ? 0 : 128) + (u & 127); } };

constexpr int DI_IN = (DM / 64) * (INC / 32), DI_OUT = (DM / 64) * (DM / 32), DI_UQ = (384 / 64) * (768 / 32), DI_UKV = (128 / 64) * (1024 / 32);
constexpr int DI_GU = (DM / 64) * (2 * DFF / 64), DI_DN = (DFF / 64) * (DM / 64);
constexpr int DI_PER_L = DI_IN + DI_OUT + DI_UQ + DI_UKV, DI_ALL = 2 * DI_PER_L + DI_GU + DI_DN;
__device__ __forceinline__ void dense_items(const Params& p, LAS unsigned char* lds, int wave, int lane, int lo, int hi, int wi, int nw) {
    LAS float* scr = (LAS float*)(lds + wave * 16896);
    constexpr int I_IN = DI_IN, I_OUT = DI_OUT, I_UQ = DI_UQ, I_GU = DI_GU, I_DN = DI_DN, PER_L = DI_PER_L;
    for (int it = lo + wi; it < hi; it += nw) {
        int r = it;
        if (r < 2 * PER_L) { const int l = r / PER_L; r -= l * PER_L;
            if (r < I_IN) { transpose_item(p.in[I_WIN] + (size_t)l * DM * INC, DM, INC, wsp<bf16_t>(p, WS_WIN) + (size_t)l * INCP * DM, DM, nullptr, scr, r, lane, RmWin()); continue; } r -= I_IN;
            if (r < I_OUT) { transpose_item(p.in[I_WOUT] + (size_t)l * DM * DM, DM, DM, wsp<bf16_t>(p, WS_WOUT) + (size_t)l * DM * DM, DM, nullptr, scr, r, lane, RmIdent()); continue; } r -= I_OUT;
            if (r < I_UQ) { transpose_item(p.in[I_BWUQ] + (size_t)l * 384 * 768, 384, 768, wsp<bf16_t>(p, WS_WUP) + (size_t)l * 1792 * 512, 512, p.in[I_BQAN] + l * 384, scr, r, lane, RmIdent()); continue; } r -= I_UQ;
            transpose_item(p.in[I_BWUKV] + (size_t)l * 128 * 1024, 128, 1024, wsp<bf16_t>(p, WS_WUP) + (size_t)l * 1792 * 512 + (size_t)768 * 512 + 384, 512, p.in[I_BKVAN] + l * 128, scr, r, lane, RmIdent()); continue; }
        r -= 2 * PER_L;
        if (r < I_GU) { transpose_item64<(FFN1_FP8 != 0)>(p.in[I_FGU], DM, 2 * DFF, wsp<unsigned char>(p, WS_WGU), scr, r, lane, RmGateUp()); continue; } r -= I_GU;
#if FFN2_FP8
        if (r < I_DN) { transpose_item64<true>(p.in[I_FD], DFF, DM, wsp<unsigned char>(p, WS_WD), scr, r, lane, RmIdent()); continue; } r -= I_DN;
#else
        if (r < I_DN) { transpose_item64<false>(p.in[I_FD], DFF, DM, wsp<bf16_t>(p, WS_WD), scr, r, lane, RmIdent()); continue; } r -= I_DN;
#endif
    }
}
__device__ __forceinline__ void p0_prologue(const Params& p, LAS unsigned char* lds, int G, int vcu, int wave) {
    const int lane = lane_id_asm(), tid = wave * 64 + lane;
    {
        LAS float* sv = (LAS float*)lds;
        LAS float* red = (LAS float*)(lds + 5 * DM * 4);
        bool loaded = false;
        for (int u = blockIdx.x; u < 2 * (MODW / 128); u += G) {
            if (!loaded) { for (int i = tid; i < 5 * DM; i += 512) { const int v = i / DM, k = i % DM; const float cv = v < 4 ? p.in[I_C][v * DM + k] : p.in[I_CCTX][k]; sv[i] = cv / (1.0f + __expf(-cv)); } loaded = true; __syncthreads(); }
            const int l = u / (MODW / 128), n0 = (u % (MODW / 128)) * 128;
            int hi = lane >> 5, c4 = lane & 31; asm volatile("" : "+v"(hi), "+v"(c4));
            const float* W = p.in[I_WADA] + (size_t)l * DM * MODW + n0 + 4 * c4 + (size_t)hi * MODW;
            float a[5][4];
#pragma unroll
            for (int v = 0; v < 5; ++v) { a[v][0] = 0.f; a[v][1] = 0.f; a[v][2] = 0.f; a[v][3] = 0.f; }
#pragma unroll 16
            for (int k = wave * 256; k < wave * 256 + 256; k += 2) { const f32x4 w = __builtin_nontemporal_load((const f32x4*)(W + (size_t)k * MODW));
#pragma unroll
                for (int v = 0; v < 5; ++v) { const float s = sv[v * DM + k + hi]; a[v][0] += s * w.x; a[v][1] += s * w.y; a[v][2] += s * w.z; a[v][3] += s * w.w; } }
#pragma unroll
            for (int v = 0; v < 5; ++v) {
#pragma unroll
                for (int j = 0; j < 4; ++j) a[v][j] = xhalf_sum(a[v][j]);
                if (hi == 0) *(LAS f32x4*)(red + (wave * 5 + v) * 128 + 4 * c4) = (f32x4){a[v][0], a[v][1], a[v][2], a[v][3]}; }
            __syncthreads();
            for (int i = tid; i < 5 * 128; i += 512) { const int v = i / 128, n = i % 128; float s = 0.f;
#pragma unroll
                for (int w = 0; w < 8; ++w) s += red[(w * 5 + v) * 128 + n];
                wsp<float>(p, WS_MOD)[((size_t)l * 5 + v) * MODW + n0 + n] = s + p.in[I_BADA][(size_t)l * MODW + n0 + n]; }
            __syncthreads();
        }
        __syncthreads();
    }
    const int gw = vcu * 8 + wave, NGW = G * 8;
    const unsigned zu = __float_as_uint(opaque_zero());
    for (int i = gw * 64 + lane; i < SEQ * 48; i += NGW * 64) {
        const int t = i / 48, j = i % 48; const float rw = (float)(t >> 6), cl = (float)(t & 63);
        if (j < 32) { const float fr = __powf(10000.0f, -(float)(j & 15) / 16.0f); const float ang = (j < 16 ? rw : cl) * fr; const float s = __sinf(ang), c = __cosf(ang);
            wsp<float>(p, WS_ROPE64)[(t * 32 + j) * 2] = c; wsp<float>(p, WS_ROPE64)[(t * 32 + j) * 2 + 1] = s; }
        else { const int jj = j - 32; const float fr = __powf(10000.0f, -(float)(jj & 7) / 8.0f); const float ang = (jj < 8 ? rw : cl) * fr; const float s = __sinf(ang), c = __cosf(ang);
            wsp<float>(p, WS_ROPE32)[(t * 16 + jj) * 2] = c; wsp<float>(p, WS_ROPE32)[(t * 16 + jj) * 2 + 1] = s; }
    }
    for (int i = gw * 64 + lane; i < 2 * 8 * 15 * 128; i += NGW * 64) {
        const int lh = i / (15 * 128), r = i % (15 * 128), dr = r >> 7, dc = (r & 127) - 48;
        wsp<float>(p, WS_RPB)[i] = (dc >= 0 && dc < 31) ? p.in[I_DRPB][(size_t)lh * 15 * 31 + dr * 31 + dc] * LOG2E : 0.f;
    }
    for (int i = gw * 64 + lane; i < 2 * (INCP - INC) * DM / 8; i += NGW * 64) {
        const int l = i / ((INCP - INC) * DM / 8), r = i % ((INCP - INC) * DM / 8);
        *(u32x4*)(wsp<bf16_t>(p, WS_WIN) + ((size_t)l * INCP + INC) * DM + (size_t)r * 8) = (u32x4){zu, zu, zu, zu};
    }
    for (int i = gw * 64 + lane; i < 2 * (768 * 16 + 1024 * 48); i += NGW * 64) {
        const int l = i / (768 * 16 + 1024 * 48), r = i % (768 * 16 + 1024 * 48);
        bf16_t* base = wsp<bf16_t>(p, WS_WUP) + (size_t)l * 1792 * 512;
        bf16_t* d = r < 768 * 16 ? base + (size_t)(r / 16) * 512 + 384 + (r % 16) * 8 : base + (size_t)(768 + (r - 768 * 16) / 48) * 512 + ((r - 768 * 16) % 48) * 8;
        *(u32x4*)d = (u32x4){zu, zu, zu, zu};
    }
    dense_items(p, lds, wave, lane, 0, DI_PER_L, gw, NGW);
}

constexpr int CONV_GU = (DM / 64) * (2 * DFF / 64), CONV_DN = (DFF / 64) * (DM / 64), NCONV = NEXP * (CONV_GU + CONV_DN);
struct ConvItem { const float* src; unsigned char* dst; int N, K; };
__device__ __forceinline__ void moe_item_load(const Params& p, int r, int lane, ConvItem& it, f32x4 (&v)[16]) {
    const int e = r / (CONV_GU + CONV_DN); r -= e * (CONV_GU + CONV_DN);
    const bool gu = r < CONV_GU; const int item = gu ? r : r - CONV_GU;
    const int N = gu ? 2 * DFF : DM, K = gu ? DM : DFF;
    const float* W = gu ? p.in[I_MGU] + (size_t)e * DM * 2 * DFF : p.in[I_MD] + (size_t)e * DFF * DM;
    unsigned char* WT = gu ? wsp<unsigned char>(p, WS_MGU) + (size_t)e * 2 * DFF * DM : wsp<unsigned char>(p, WS_MD) + (size_t)e * DM * DFF;
    const int nblk = N / 64, kb = item / nblk, nb = item % nblk, k0 = 64 * kb, n0 = 64 * nb;
    const int drow = gu ? RmGateUp()(n0) : n0;
    it.src = W + (size_t)(k0 + (lane >> 4)) * N + n0 + 4 * (lane & 15); it.N = N; it.K = K;
    it.dst = WT + (size_t)drow * K + k0 + 8 * (lane & 7);
#pragma unroll
    for (int i = 0; i < 16; ++i) v[i] = __builtin_nontemporal_load((const f32x4*)(it.src + (size_t)(4 * i) * N));
}
__device__ __forceinline__ void moe_item_finish(const ConvItem& it, const f32x4 (&v)[16], LAS float* scr, int lane) {
#pragma unroll
    for (int i = 0; i < 16; ++i) { LAS float* d = scr + ((lane >> 4) + 4 * i) * 65 + 4 * (lane & 15); d[0] = v[i].x; d[1] = v[i].y; d[2] = v[i].z; d[3] = v[i].w; }
    asm volatile("s_waitcnt lgkmcnt(0)" ::: "memory");
    const int c = lane & 7;
#pragma unroll
    for (int j = 0; j < 8; ++j) { const int n = (lane >> 3) + 8 * j; const LAS float* s = scr + (8 * c) * 65 + n;
        u32x2 o; o.x = pack_fp8x4(s[0] * 256.f, s[65] * 256.f, s[130] * 256.f, s[195] * 256.f); o.y = pack_fp8x4(s[260] * 256.f, s[325] * 256.f, s[390] * 256.f, s[455] * 256.f);
        *(u32x2*)(it.dst + (size_t)n * it.K) = o; }
    asm volatile("s_waitcnt lgkmcnt(0)" ::: "memory");
}
__device__ __forceinline__ void moe_convert_pipe(const Params& p, LAS unsigned char* lds, int wave, int lane, int lo, int hi, int wi, int nw) {
    LAS float* scr = (LAS float*)(lds + wave * 16896);
    int r = lo + wi;
    if (r >= hi) return;
    ConvItem ia, ib; f32x4 va[16], vb[16];
    moe_item_load(p, r, lane, ia, va);
    for (;;) {
        const int rb = r + nw;
        if (rb < hi) moe_item_load(p, rb, lane, ib, vb);
        moe_item_finish(ia, va, scr, lane);
        if (rb >= hi) break;
        const int ra = rb + nw;
        if (ra < hi) moe_item_load(p, ra, lane, ia, va);
        moe_item_finish(ib, vb, scr, lane);
        if (ra >= hi) break;
        r = ra;
    }
}

__device__ __forceinline__ void moe_convert_item(const Params& p, LAS float* scr, int r, int lane) {
    const int e = r / (CONV_GU + CONV_DN); r -= e * (CONV_GU + CONV_DN);
    if (r < CONV_GU) transpose_item64<true>(p.in[I_MGU] + (size_t)e * DM * 2 * DFF, DM, 2 * DFF, wsp<unsigned char>(p, WS_MGU) + (size_t)e * 2 * DFF * DM, scr, r, lane, RmGateUp());
    else transpose_item64<true>(p.in[I_MD] + (size_t)e * DFF * DM, DFF, DM, wsp<unsigned char>(p, WS_MD) + (size_t)e * DM * DFF, scr, r - CONV_GU, lane, RmIdent());
}
__device__ __forceinline__ void moe_convert(const Params& p, LAS unsigned char* lds, int wave, int lane, int lo, int hi, int wi, int nw) {
    LAS float* scr = (LAS float*)(lds + wave * 16896);
    for (int r = lo + wi; r < hi; r += nw) moe_convert_item(p, scr, r, lane);
}

__device__ __forceinline__ f32x4 ldx4(const void* row, int c, bool xb) {
    if (xb) { const u32x2 w = *((const u32x2*)row + c); return (f32x4){bf_lo(w.x), bf_hi(w.x), bf_lo(w.y), bf_hi(w.y)}; }
    return *((const f32x4*)row + c);
}
template <bool FP8 = false, bool XB = false>
__device__ __forceinline__ void norm_mod_row(const void* xrow, const float* gain, const float* sh, const float* sc, bf16_t* orow, int lane, f32x4 (&v)[8]) {
    float ss = 0.f;
    f32x4 gq[8], aq[8], sq[8];
#pragma unroll
    for (int j = 0; j < 8; ++j) { const int c = lane + 64 * j; v[j] = ldx4(xrow, c, XB); gq[j] = *((const f32x4*)gain + c); aq[j] = *((const f32x4*)sc + c); sq[j] = *((const f32x4*)sh + c); }
#pragma unroll
    for (int j = 0; j < 8; ++j) ss += (v[j].x * v[j].x + v[j].y * v[j].y) + (v[j].z * v[j].z + v[j].w * v[j].w);
    const float rstd = 1.0f / sqrtf(wave_sum(ss) * (1.0f / DM) + EPS);
#pragma unroll
    for (int j = 0; j < 8; ++j) { const int c = lane + 64 * j; const f32x4 g = gq[j], a = aq[j], s = sq[j];
        v[j] = (v[j] * rstd * g) * (a + 1.0f) + s;
        if constexpr (FP8) { *((unsigned*)orow + c) = pack_fp8x4(v[j].x, v[j].y, v[j].z, v[j].w); }
        else { u32x2 w; w.x = cvt_pk_bf16(v[j].x, v[j].y); w.y = cvt_pk_bf16(v[j].z, v[j].w); *((u32x2*)orow + c) = w; } }
}
template <bool FP8 = false, bool XB = false>
__device__ __forceinline__ void norm_mod_row2(const void* xa, const float* gain, const float* sh, const float* sc, bf16_t* oa, int opitch_elems, int lane) {
    f32x4 va[8], vb[8], g[8], a[8], s[8];
#pragma unroll
    for (int j = 0; j < 8; ++j) { const int c = lane + 64 * j; va[j] = ldx4(xa, c, XB); vb[j] = ldx4((const char*)xa + (size_t)DM * (XB ? 2 : 4), c, XB);
        g[j] = *((const f32x4*)gain + c); a[j] = *((const f32x4*)sc + c); s[j] = *((const f32x4*)sh + c); }
    float sa = 0.f, sb = 0.f;
#pragma unroll
    for (int j = 0; j < 8; ++j) { sa += (va[j].x * va[j].x + va[j].y * va[j].y) + (va[j].z * va[j].z + va[j].w * va[j].w); sb += (vb[j].x * vb[j].x + vb[j].y * vb[j].y) + (vb[j].z * vb[j].z + vb[j].w * vb[j].w); }
    const float ra = 1.0f / sqrtf(wave_sum(sa) * (1.0f / DM) + EPS), rb = 1.0f / sqrtf(wave_sum(sb) * (1.0f / DM) + EPS);
    bf16_t* ob = oa + opitch_elems;
#pragma unroll
    for (int j = 0; j < 8; ++j) { const int c = lane + 64 * j; const f32x4 m1 = g[j] * (a[j] + 1.0f);
        const f32x4 ya = (va[j] * ra) * m1 + s[j], yb = (vb[j] * rb) * m1 + s[j];
        if constexpr (FP8) { *((unsigned*)oa + c) = pack_fp8x4(ya.x, ya.y, ya.z, ya.w); *((unsigned*)ob + c) = pack_fp8x4(yb.x, yb.y, yb.z, yb.w); }
        else { u32x2 w; w.x = cvt_pk_bf16(ya.x, ya.y); w.y = cvt_pk_bf16(ya.z, ya.w); *((u32x2*)oa + c) = w; w.x = cvt_pk_bf16(yb.x, yb.y); w.y = cvt_pk_bf16(yb.z, yb.w); *((u32x2*)ob + c) = w; } }
}
struct HeadKind { int src, nh; const float* gain; int rope; float scale; bf16_t* dst; int keymajor; };
__device__ __forceinline__ void prep_heads_load(const Params& p, const HeadKind& k, int row, int lane, u32x2 (&w)[2]) {
    const int g = lane >> 4, l16 = lane & 15;
    const bf16_t* prow = wsp<bf16_t>(p, WS_P) + (size_t)row * INCP + k.src + 4 * l16;
#pragma unroll
    for (int it = 0; it < 2; ++it) { const int h = min(4 * it + g, k.nh - 1); w[it] = *(const u32x2*)(prow + h * 64); }
}
__device__ __forceinline__ void prep_heads_compute(const Params& p, const HeadKind& k, int row, int lane, const u32x2 (&w)[2], const f32x4 (&rope)[2], const f32x4 gn) {
    const int g = lane >> 4, l16 = lane & 15;
    int b, pos; row_bp(row, b, pos);
    const bool dorope = k.rope && row < ML;
#pragma unroll
    for (int it = 0; it < 2; ++it) {
        const int h = 4 * it + g;
        if (4 * it < k.nh) {
            float x[4] = {bf_lo(w[it].x), bf_hi(w[it].x), bf_lo(w[it].y), bf_hi(w[it].y)};
            if (k.gain) {
                float ss = (x[0] * x[0] + x[1] * x[1]) + (x[2] * x[2] + x[3] * x[3]);
                ss = row_sum16(ss);
                const float r = 1.0f / sqrtf(ss * (1.0f / 64.0f) + EPS);
                x[0] *= r * gn.x; x[1] *= r * gn.y; x[2] *= r * gn.z; x[3] *= r * gn.w;
            }
            if (k.rope) {
                float y[4];
#pragma unroll
                for (int e = 0; e < 4; ++e) y[e] = dpp_ror<8>(x[e]);
                if (dorope) {
                    const float cs[8] = {rope[0].x, rope[0].y, rope[0].z, rope[0].w, rope[1].x, rope[1].y, rope[1].z, rope[1].w};
#pragma unroll
                    for (int e = 0; e < 4; ++e) { const float c = cs[2 * e], s = cs[2 * e + 1];
                        x[e] = l16 < 8 ? x[e] * c - y[e] * s : y[e] * s + x[e] * c; }
                }
            }
            if (h < k.nh) {
                u32x2 o; o.x = cvt_pk_bf16(x[0] * k.scale, x[1] * k.scale); o.y = cvt_pk_bf16(x[2] * k.scale, x[3] * k.scale);
                bf16_t* d = k.keymajor == 1 ? k.dst + (((size_t)(b * k.nh + h)) * (KEYS / 32) + (pos >> 5)) * 2048 + (l16 >> 1) * 256 + (pos & 31) * 8 + 4 * (l16 & 1)
                          : k.keymajor == 2 ? k.dst + (((size_t)(b * k.nh + h)) * (KEYS / 64) + (pos >> 6)) * 4096 + (l16 >> 1) * 512 + (pos & 63) * 8 + 4 * (l16 & 1)
                                            : k.dst + (size_t)row * (k.nh * 64) + h * 64 + 4 * l16;
                *(u32x2*)d = o;
            }
        }
    }
}

struct TrKind { const bf16_t* src; int spitch, scol, nh; const float* rowscale; int rope; float scale; int decay; bf16_t* dst; bf16_t* dst2; float lgf2, lgr2; int tiled; };
__device__ __forceinline__ void tr_store_tiled32(LAS bf16_t* scr, bf16_t* img, int lane) {
    unsigned w[32];
#pragma unroll
    for (int t = 0; t < 32; ++t) w[t] = (unsigned)scr[(2 * t) * 72 + lane] | ((unsigned)scr[(2 * t + 1) * 72 + lane] << 16);
#pragma unroll
    for (int q = 0; q < 8; ++q) *(u32x4*)(img + (q >> 2) * 2048 + ((q & 3) * 64 + lane) * 8) = (u32x4){w[4 * q], w[4 * q + 1], w[4 * q + 2], w[4 * q + 3]};
}
__device__ __forceinline__ void tr_store_tiled(LAS bf16_t* scr, bf16_t* img, int lane) {
    unsigned w[32];
#pragma unroll
    for (int t = 0; t < 32; ++t) w[t] = (unsigned)scr[(2 * t) * 72 + lane] | ((unsigned)scr[(2 * t + 1) * 72 + lane] << 16);
#pragma unroll
    for (int q = 0; q < 8; ++q) *(u32x4*)(img + (q * 64 + lane) * 8) = (u32x4){w[4 * q], w[4 * q + 1], w[4 * q + 2], w[4 * q + 3]};
}
__device__ __forceinline__ void tr_store(LAS bf16_t* scr, bf16_t* dst, int lane) {
    unsigned w[32];
#pragma unroll
    for (int t = 0; t < 32; ++t) w[t] = (unsigned)scr[(2 * t) * 72 + lane] | ((unsigned)scr[(2 * t + 1) * 72 + lane] << 16);
#pragma unroll
    for (int q = 0; q < 8; ++q) *(u32x4*)(dst + (size_t)lane * KEYS + 8 * q) = (u32x4){w[4 * q], w[4 * q + 1], w[4 * q + 2], w[4 * q + 3]};
}
__device__ __forceinline__ void prep_transpose_unit(const Params& p, const TrKind& k, int b, int h, int tt, LAS bf16_t* scr, int lane) {
    const int p0 = 64 * tt, c8 = lane & 7;
    const bool latent = p0 < SEQ;
    float x[8][8];
#pragma unroll
    for (int i = 0; i < 8; ++i) {
        const int tok = (lane >> 3) + 8 * i, row = bp_row(b, p0 + tok);
        const u32x4 w = *(const u32x4*)(k.src + (size_t)row * k.spitch + k.scol + h * (k.nh > 0 ? 64 : 128) + 8 * c8);
        const float rs = (k.rowscale ? k.rowscale[row] : 1.0f) * k.scale;
        x[i][0] = bf_lo(w.x) * rs; x[i][1] = bf_hi(w.x) * rs; x[i][2] = bf_lo(w.y) * rs; x[i][3] = bf_hi(w.y) * rs;
        x[i][4] = bf_lo(w.z) * rs; x[i][5] = bf_hi(w.z) * rs; x[i][6] = bf_lo(w.w) * rs; x[i][7] = bf_hi(w.w) * rs;
        if (k.rope) {
            float y[8];
#pragma unroll
            for (int e = 0; e < 8; ++e) y[e] = shfl_idx(x[i][e], lane ^ 4);
            if (latent) {
                const float* cs = wsp<float>(p, WS_ROPE64) + ((size_t)(p0 + tok) * 32 + 8 * (c8 & 3)) * 2;
#pragma unroll
                for (int e = 0; e < 8; ++e) { const float c = cs[2 * e], s = cs[2 * e + 1]; x[i][e] = c8 < 4 ? x[i][e] * c - y[e] * s : y[e] * s + x[i][e] * c; }
            }
        }
    }
    const int nh = k.nh > 0 ? k.nh : -k.nh;
    for (int pass = 0; pass < (k.decay ? 2 : 1); ++pass) {
#pragma unroll
        for (int i = 0; i < 8; ++i) {
            const int tok = (lane >> 3) + 8 * i; float wgt = 1.0f;
            if (k.decay) { const int pc = (p0 + tok) & 127; wgt = pass == 0 ? fexp2(k.lgf2 * (float)(127 - pc)) : fexp2(k.lgr2 * (float)pc); }
            u32x4 o; o.x = cvt_pk_bf16(x[i][0] * wgt, x[i][1] * wgt); o.y = cvt_pk_bf16(x[i][2] * wgt, x[i][3] * wgt); o.z = cvt_pk_bf16(x[i][4] * wgt, x[i][5] * wgt); o.w = cvt_pk_bf16(x[i][6] * wgt, x[i][7] * wgt);
            *(LAS u32x4*)(scr + tok * 72 + 8 * c8) = o;
        }
        asm volatile("s_waitcnt lgkmcnt(0)" ::: "memory");
        if (k.tiled == 1) tr_store_tiled(scr, k.dst + ((size_t)(b * nh + h) * (KEYS / 64) + tt) * 4096, lane);
        else tr_store_tiled32(scr, (pass == 0 ? k.dst : k.dst2) + ((size_t)(b * nh + h) * (KEYS / 32) + 2 * tt) * 2048, lane);
        asm volatile("s_waitcnt lgkmcnt(0)" ::: "memory");
    }
}

struct MlaRegs { unsigned cq[3], ckv; u32x2 wk[4]; f32x4 rope[2]; };
__device__ __forceinline__ void prep_mla_load(const Params& p, int row, int lane, MlaRegs& R) {
    const bf16_t* prow = wsp<bf16_t>(p, WS_P) + (size_t)row * INCP;
    const int g = lane >> 5, l32 = lane & 31; const bool act = l32 < 24; const int d0 = 4 * l32;
#pragma unroll
    for (int j = 0; j < 3; ++j) R.cq[j] = *(const unsigned*)(prow + PC_BQ + 2 * (lane + 64 * j));
    R.ckv = *(const unsigned*)(prow + PC_BKV + 2 * lane);
    const int dd = act ? d0 : 0;
#pragma unroll
    for (int i = 0; i < 4; ++i) { const int h = 2 * i + g;
        R.wk[i] = l32 < 16 || !act ? *(const u32x2*)(wsp<bf16_t>(p, WS_UPRAW) + (size_t)row * 1792 + 768 + h * 128 + dd) : *(const u32x2*)(prow + PC_BKR + (d0 - 64)); }
    { const int pos = row < ML ? (row & (SEQ - 1)) : 0;
      const float* cs = wsp<float>(p, WS_ROPE32) + ((size_t)pos * 16 + (d0 >= 64 && act ? (d0 - 64) & 15 : 0)) * 2; R.rope[0] = *(const f32x4*)cs; R.rope[1] = *(const f32x4*)(cs + 4); }
}
__device__ __forceinline__ void prep_mla_compute(const Params& p, int l, int row, int lane, const MlaRegs& R, const f32x4 gq, const f32x4 gk) {
    int b, pos; row_bp(row, b, pos);
    float sq = 0.f, skv = 0.f;
    {
#pragma unroll
      for (int j = 0; j < 3; ++j) { const float a = bf_lo(R.cq[j]), c = bf_hi(R.cq[j]); sq += a * a + c * c; }
      const float a = bf_lo(R.ckv), c = bf_hi(R.ckv); skv = a * a + c * c; }
    sq = wave_sum(sq); skv = wave_sum(skv);
    const float rq = 1.0f / sqrtf(sq * (1.0f / 384.0f) + EPS), rkv = 1.0f / sqrtf(skv * (1.0f / 128.0f) + EPS);
    if (lane == 0) { wsp<float>(p, WS_RKV)[row] = rkv; wsp<float>(p, WS_RQ)[row] = rq; }
    const int g = lane >> 5, l32 = lane & 31; const bool act = l32 < 24; const int d0 = 4 * l32;
    const bool latent = row < ML;
    const float qscale = 0.10206207261596575f * LOG2E;
    const float cs[8] = {R.rope[0].x, R.rope[0].y, R.rope[0].z, R.rope[0].w, R.rope[1].x, R.rope[1].y, R.rope[1].z, R.rope[1].w};
    const int plane = (lane & 32) | (l32 < 20 ? l32 + 4 : l32 - 4);
#pragma unroll
    for (int i4 = 0; i4 < 4; ++i4) {
        const int h = 2 * i4 + g;
        { float x[4] = {0.f, 0.f, 0.f, 0.f};
          if (act) { const u32x2 w = R.wk[i4]; const float sc = l32 < 16 ? rkv : 1.0f; x[0] = bf_lo(w.x) * sc; x[1] = bf_hi(w.x) * sc; x[2] = bf_lo(w.y) * sc; x[3] = bf_hi(w.y) * sc; }
          float ss = (x[0] * x[0] + x[1] * x[1]) + (x[2] * x[2] + x[3] * x[3]);
          ss = row_sum16(ss); ss += shfl_idx(ss, lane ^ 16);
          const float r = 1.0f / sqrtf(ss * (1.0f / 96.0f) + EPS);
          if (act) { const f32x4 gn = gk; x[0] *= r * gn.x; x[1] *= r * gn.y; x[2] *= r * gn.z; x[3] *= r * gn.w; }
          float y[4];
#pragma unroll
          for (int e = 0; e < 4; ++e) y[e] = shfl_idx(x[e], plane);
          if (latent && l32 >= 16 && act) {
#pragma unroll
              for (int e = 0; e < 4; ++e) { const float c = cs[2 * e], s = cs[2 * e + 1]; x[e] = l32 < 20 ? x[e] * c - y[e] * s : y[e] * s + x[e] * c; } }
          if (act) { u32x2 o; o.x = cvt_pk_bf16(x[0], x[1]); o.y = cvt_pk_bf16(x[2], x[3]);
              *(u32x2*)(wsp<bf16_t>(p, WS_KB) + ((((size_t)(b * 8 + h)) * (KEYS / 64) + (pos >> 6)) * 12 + (d0 >> 3)) * 512 + (pos & 63) * 8 + (d0 & 7)) = o; } }
    }
}
__device__ __forceinline__ int permkey(int m) { const int a = m >> 3, h = (m >> 2) & 1, c = m & 3; return 16 * (a >> 1) + 8 * h + c + 4 * (a & 1); }
__device__ __forceinline__ bf16x8 pack8(const f32x16& s, int o) {
    u32x4 w; w.x = cvt_pk_bf16(s[o], s[o + 1]); w.y = cvt_pk_bf16(s[o + 2], s[o + 3]); w.z = cvt_pk_bf16(s[o + 4], s[o + 5]); w.w = cvt_pk_bf16(s[o + 6], s[o + 7]);
    return __builtin_bit_cast(bf16x8, w);
}
template <bool GAIN, bool ROPE>
__device__ __forceinline__ void load_q_prepped(const bf16_t* qrow, const float* gain, const float* rope, float scale, int hi, bf16x8 (&qf)[4]) {
    u32x4 raw[4]; f32x4 gn[4][2], cs[2][4];
#pragma unroll
    for (int d0 = 0; d0 < 4; ++d0) raw[d0] = *(const u32x4*)(qrow + 16 * d0 + 8 * hi);
    if constexpr (GAIN) {
#pragma unroll
        for (int d0 = 0; d0 < 4; ++d0) { gn[d0][0] = *(const f32x4*)(gain + 16 * d0 + 8 * hi); gn[d0][1] = *(const f32x4*)(gain + 16 * d0 + 8 * hi + 4); } }
    if constexpr (ROPE) {
#pragma unroll
        for (int dd = 0; dd < 2; ++dd)
#pragma unroll
            for (int j = 0; j < 4; ++j) cs[dd][j] = *(const f32x4*)(rope + (16 * dd + 8 * hi) * 2 + 4 * j); }
    float x[4][8];
#pragma unroll
    for (int d0 = 0; d0 < 4; ++d0) { x[d0][0] = bf_lo(raw[d0].x); x[d0][1] = bf_hi(raw[d0].x); x[d0][2] = bf_lo(raw[d0].y); x[d0][3] = bf_hi(raw[d0].y);
        x[d0][4] = bf_lo(raw[d0].z); x[d0][5] = bf_hi(raw[d0].z); x[d0][6] = bf_lo(raw[d0].w); x[d0][7] = bf_hi(raw[d0].w); }
    if constexpr (GAIN) {
        float ss = 0.f;
#pragma unroll
        for (int d0 = 0; d0 < 4; ++d0)
#pragma unroll
            for (int e = 0; e < 8; e += 2) ss += x[d0][e] * x[d0][e] + x[d0][e + 1] * x[d0][e + 1];
        ss = xhalf_sum(ss);
        const float r = 1.0f / sqrtf(ss * (1.0f / 64.0f) + EPS);
#pragma unroll
        for (int d0 = 0; d0 < 4; ++d0)
#pragma unroll
            for (int e = 0; e < 8; ++e) x[d0][e] *= r * gn[d0][e >> 2][e & 3];
    }
    if constexpr (ROPE) {
#pragma unroll
        for (int dd = 0; dd < 2; ++dd)
#pragma unroll
            for (int e = 0; e < 8; ++e) { const float c = cs[dd][e >> 1][2 * (e & 1)], s = cs[dd][e >> 1][2 * (e & 1) + 1]; const float lo = x[dd][e], up = x[dd + 2][e];
                x[dd][e] = lo * c - up * s; x[dd + 2][e] = lo * s + up * c; }
    }
#pragma unroll
    for (int d0 = 0; d0 < 4; ++d0) { u32x4 w; w.x = cvt_pk_bf16(x[d0][0] * scale, x[d0][1] * scale); w.y = cvt_pk_bf16(x[d0][2] * scale, x[d0][3] * scale);
        w.z = cvt_pk_bf16(x[d0][4] * scale, x[d0][5] * scale); w.w = cvt_pk_bf16(x[d0][6] * scale, x[d0][7] * scale); qf[d0] = __builtin_bit_cast(bf16x8, w); }
}
struct AttnArgs {
    const bf16_t* Q; int qpitch;
    const float* qgain; const float* qrope; float qscale;
    const bf16_t* K;
    const bf16_t* Vt;
    bf16_t* O; int opitch;
    int t0, t1, c0, c1;
    float sink2;
    int q0, qrow;
    const float* rpb;
};
template <int DQK, int MODE>
__device__ __forceinline__ void attn_wave(const AttnArgs& a, int lane) {
    constexpr int ND = DQK / 16;
    const int r32 = lane & 31, hi = lane >> 5;
    const float NEG = -__builtin_inff();
    bf16x8 qf[ND];
    load_q_prepped<true, MODE == 1>(a.Q + (size_t)r32 * a.qpitch, a.qgain, a.qrope + r32 * 64, a.qscale, hi, qf);
    static_assert(DQK == 64, "tiled 32-key images: K [8 chunks][32 rows][8], V^T [4 kc][64 d][8]");
    const __amdgpu_buffer_rsrc_t krs = __builtin_amdgcn_make_buffer_rsrc((void*)a.K, 0, 0x7ffffff0, 0x00020000), vrs = __builtin_amdgcn_make_buffer_rsrc((void*)a.Vt, 0, 0x7ffffff0, 0x00020000);
    const int klo = (hi * 256 + permkey(r32) * 8) * 2, vlo = ((hi * 64 + r32) * 8) * 2;
#define AW_K(t, d0) __builtin_bit_cast(bf16x8, __builtin_amdgcn_raw_buffer_load_b128(krs, klo, (t) * 4096 + (d0) * 1024, 0))
#define AW_V(t, s, d0) __builtin_bit_cast(bf16x8, __builtin_amdgcn_raw_buffer_load_b128(vrs, vlo, (t) * 4096 + (s) * 2048 + (d0) * 512, 0))
    f32x16 o0, o1; const float zr = opaque_zero();
#pragma unroll
    for (int r = 0; r < 16; ++r) { o0[r] = zr; o1[r] = zr; }
    float m_run = 0.f, l_run = 0.f;
    const int n1 = a.t1 - a.t0, n = n1 + (a.c1 - a.c0);
#define AW_TILE(ii) ((ii) < n1 ? a.t0 + (ii) : a.c0 + ((ii) - n1))
    bf16x8 kf[ND], vf[2][2], k1[ND], v1[2][2], k2[ND], v2[2][2];
    { const int tA = AW_TILE(0), tB = AW_TILE(n > 1 ? 1 : 0);
#pragma unroll
      for (int d0 = 0; d0 < ND; ++d0) { kf[d0] = AW_K(tA, d0); k1[d0] = AW_K(tB, d0); }
#pragma unroll
      for (int d0 = 0; d0 < 2; ++d0)
#pragma unroll
          for (int s = 0; s < 2; ++s) { vf[d0][s] = AW_V(tA, s, d0); v1[d0][s] = AW_V(tB, s, d0); } }
    auto step = [&](int i, bf16x8 (&kf)[ND], bf16x8 (&vf)[2][2], bf16x8 (&kn)[ND], bf16x8 (&vn)[2][2]) __attribute__((always_inline)) {
        const int cur = AW_TILE(i); const bool masked = i < n1;
        { const int t2 = AW_TILE(i + 2 < n ? i + 2 : n - 1);
#pragma unroll
          for (int d0 = 0; d0 < ND; ++d0) kn[d0] = AW_K(t2, d0);
#pragma unroll
          for (int d0 = 0; d0 < 2; ++d0)
#pragma unroll
              for (int s = 0; s < 2; ++s) vn[d0][s] = AW_V(t2, s, d0); }
        float bias[16];
        if (MODE == 2 && masked) {
            const int kr = cur >> 1, w = a.q0 + r32, cb = (cur & 1) * 32 + 8 * hi;
            const float* rp = a.rpb + (kr - a.qrow + 7) * 128 + (cb - w + 15 + 48);
#pragma unroll
            for (int r = 0; r < 16; ++r) bias[r] = rp[16 * (r >> 3) + (r & 7)];
        }
        f32x16 st;
#pragma unroll
        for (int r = 0; r < 16; ++r) st[r] = -m_run;
#pragma unroll
        for (int d0 = 0; d0 < ND; ++d0) st = __builtin_amdgcn_mfma_f32_32x32x16_bf16(kf[d0], qf[d0], st, 0, 0, 0);
        if (MODE == 1 && masked) {
            const int dt = cur * 32 - a.q0;
            if (dt <= -128 || dt >= 128) {
                const int dq = a.q0 + r32 - cur * 32 - 8 * hi;
#pragma unroll
                for (int r = 0; r < 16; ++r) { const int dd = dq - (16 * (r >> 3) + (r & 7)); if (dd > 128 || dd < -128) st[r] = NEG; }
            }
        }
        if (MODE == 2 && masked) {
            const int kr = cur >> 1, w = a.q0 + r32; const int cs = min(max(w - 8, 0), 48);
            const int cb = (cur & 1) * 32 + 8 * hi;
            const int c0 = cb - cs;
#pragma unroll
            for (int r = 0; r < 16; ++r) { const int o = 16 * (r >> 3) + (r & 7); st[r] = ((unsigned)(c0 + o) < 16u) ? st[r] + bias[r] : NEG; }
        }
        float mq[4] = {st[0], st[1], st[2], st[3]};
#pragma unroll
        for (int r = 4; r < 16; ++r) mq[r & 3] = fmaxf(mq[r & 3], st[r]);
        float mx = fmaxf(fmaxf(mq[0], mq[1]), fmaxf(mq[2], mq[3]));
        mx = xhalf_max(mx);
        if (__any(mx > 8.0f)) {
            const float d = fmaxf(mx, 0.f), f = fexp2(-d);
            m_run += d; l_run *= f;
#pragma unroll
            for (int r = 0; r < 16; ++r) { o0[r] *= f; o1[r] *= f; st[r] -= d; }
        }
        float pq[4] = {0.f, 0.f, 0.f, 0.f};
#pragma unroll
        for (int r = 0; r < 8; ++r) { st[r] = fexp2(st[r]); pq[r & 3] += st[r]; }
        const bf16x8 p0 = pack8(st, 0);
        o0 = __builtin_amdgcn_mfma_f32_32x32x16_bf16(vf[0][0], p0, o0, 0, 0, 0);
        o1 = __builtin_amdgcn_mfma_f32_32x32x16_bf16(vf[1][0], p0, o1, 0, 0, 0);
#pragma unroll
        for (int r = 8; r < 16; ++r) { st[r] = fexp2(st[r]); pq[r & 3] += st[r]; }
        l_run += (pq[0] + pq[1]) + (pq[2] + pq[3]);
        const bf16x8 p1 = pack8(st, 8);
        o0 = __builtin_amdgcn_mfma_f32_32x32x16_bf16(vf[0][1], p1, o0, 0, 0, 0);
        o1 = __builtin_amdgcn_mfma_f32_32x32x16_bf16(vf[1][1], p1, o1, 0, 0, 0);
    };
    for (int i = 0; i < n; i += 3) { step(i, kf, vf, k2, v2); if (i + 1 < n) step(i + 1, k1, v1, kf, vf); if (i + 2 < n) step(i + 2, k2, v2, k1, v1); }
#undef AW_TILE
#undef AW_K
#undef AW_V
    l_run = xhalf_sum(l_run);
    if (a.sink2 != NEG) l_run += fexp2(a.sink2 - m_run);
    const float inv = 1.0f / l_run;
    bf16_t* orow = a.O + (size_t)r32 * a.opitch + 4 * hi;
#pragma unroll
    for (int g = 0; g < 4; ++g) {
        u32x2 w0, w1;
        w0.x = cvt_pk_bf16(o0[4 * g] * inv, o0[4 * g + 1] * inv); w0.y = cvt_pk_bf16(o0[4 * g + 2] * inv, o0[4 * g + 3] * inv);
        w1.x = cvt_pk_bf16(o1[4 * g] * inv, o1[4 * g + 1] * inv); w1.y = cvt_pk_bf16(o1[4 * g + 2] * inv, o1[4 * g + 3] * inv);
        *(u32x2*)(orow + 8 * g) = w0; *(u32x2*)(orow + 32 + 8 * g) = w1;
    }
}

__device__ __forceinline__ void ret_c1_unit(const Params& p, int chain, int c, int lane) {
    const int r32 = lane & 31, hi = lane >> 5, bh = chain >> 1, dir = chain & 1;
    const bf16_t* kw = wsp<bf16_t>(p, dir ? WS_KWR : WS_KWF) + ((size_t)bh * (KEYS / 32) + 4 * c) * 2048 + (hi * 64 + r32) * 8;
    const bf16_t* vt = wsp<bf16_t>(p, WS_VTC) + ((size_t)bh * (KEYS / 32) + 4 * c) * 2048 + (hi * 64 + r32) * 8;
    f32x16 acc[2][2]; const float zr = opaque_zero();
#pragma unroll
    for (int mi = 0; mi < 2; ++mi)
#pragma unroll
        for (int ni = 0; ni < 2; ++ni)
#pragma unroll
            for (int r = 0; r < 16; ++r) acc[mi][ni][r] = zr;
    bf16x8 af[8][2], bfr[8][2];
#pragma unroll
    for (int s = 0; s < 8; ++s)
#pragma unroll
        for (int mi = 0; mi < 2; ++mi) { af[s][mi] = *(const bf16x8*)(kw + (s >> 1) * 2048 + (s & 1) * 1024 + mi * 256); bfr[s][mi] = *(const bf16x8*)(vt + (s >> 1) * 2048 + (s & 1) * 1024 + mi * 256); }
#pragma unroll
    for (int s = 0; s < 8; ++s)
#pragma unroll
        for (int mi = 0; mi < 2; ++mi)
#pragma unroll
            for (int ni = 0; ni < 2; ++ni) acc[mi][ni] = __builtin_amdgcn_mfma_f32_32x32x16_bf16(af[s][mi], bfr[s][ni], acc[mi][ni], 0, 0, 0);
    float* out = wsp<float>(p, WS_KVST) + ((size_t)chain * 34 + c) * 4096;
#pragma unroll
    for (int mi = 0; mi < 2; ++mi)
#pragma unroll
        for (int ni = 0; ni < 2; ++ni)
#pragma unroll
            for (int g = 0; g < 4; ++g)
                *(f32x4*)(out + (size_t)(r32 + 32 * ni) * 64 + 32 * mi + 8 * g + 4 * hi) = (f32x4){acc[mi][ni][4 * g], acc[mi][ni][4 * g + 1], acc[mi][ni][4 * g + 2], acc[mi][ni][4 * g + 3]};
}
__device__ __forceinline__ void ret_c2(const Params& p, int l, int gtid, int gthreads) {
    for (int idx = gtid; idx < 64 * 4096; idx += gthreads) {
        const int chain = idx >> 12, e = idx & 4095, dir = chain & 1, h = (chain >> 1) & 7;
        const float lg = -__expf(p.in[I_CLD][(l * 2 + dir) * 8 + h]);
        const float dec = __expf(lg * 128.0f);
        const float* kv = wsp<float>(p, WS_KVST) + (size_t)chain * 34 * 4096 + e;
        bf16_t* sp = wsp<bf16_t>(p, WS_SPREV) + (size_t)chain * 34 * 4096 + e;
        float kvv[34];
#pragma unroll
        for (int st = 0; st < 34; ++st) { const int cc = dir == 0 ? (st < 2 ? 32 + st : st - 2) : 33 - st; kvv[st] = kv[(size_t)cc * 4096]; }
        float s = 0.f;
#pragma unroll
        for (int st = 0; st < 34; ++st) { const int cc = dir == 0 ? (st < 2 ? 32 + st : st - 2) : 33 - st; sp[(size_t)cc * 4096] = (bf16_t)(cvt_pk_bf16(s, 0.f) & 0xffffu); s = s * dec + kvv[st]; }
    }
}
__device__ __forceinline__ void ret_c3_unit(const Params& p, int l, int bh, int c, int qq, int lane) {
    const int r32 = lane & 31, hi = lane >> 5, b = bh >> 3, h = bh & 7;
    const int row0 = c < 32 ? b * SEQ + 128 * c + 32 * qq : ML + b * CTXL + 128 * (c - 32) + 32 * qq;
    const float lgf2 = -__expf(p.in[I_CLD][(l * 2 + 0) * 8 + h]) * LOG2E, lgr2 = -__expf(p.in[I_CLD][(l * 2 + 1) * 8 + h]) * LOG2E;
    bf16x8 qf[4];
    if (c < 32) load_q_prepped<false, true>(wsp<bf16_t>(p, WS_P) + (size_t)(row0 + r32) * INCP + PC_CQ + h * 64, nullptr, wsp<float>(p, WS_ROPE64) + (size_t)((row0 + r32) & (SEQ - 1)) * 64, 1.0f, hi, qf);
    else load_q_prepped<false, false>(wsp<bf16_t>(p, WS_P) + (size_t)(row0 + r32) * INCP + PC_CQ + h * 64, nullptr, nullptr, 1.0f, hi, qf);
    const bf16_t* kp = wsp<bf16_t>(p, WS_KC) + ((size_t)bh * (KEYS / 32) + 4 * c) * 2048 + hi * 256 + permkey(r32) * 8;
    const bf16_t* vp = wsp<bf16_t>(p, WS_VTC) + ((size_t)bh * (KEYS / 32) + 4 * c) * 2048 + (hi * 64 + r32) * 8;
    bf16x8 spa[2][2][4]; u32x2 gq0[4], gq1[4];
    { const bf16_t* gp0 = wsp<bf16_t>(p, WS_P) + (size_t)(row0 + r32) * INCP + PC_CG + h * 64 + 4 * hi;
#pragma unroll
      for (int dir = 0; dir < 2; ++dir) { const bf16_t* sp = wsp<bf16_t>(p, WS_SPREV) + (((size_t)(bh * 2 + dir)) * 34 + c) * 4096 + (size_t)r32 * 64 + 8 * hi;
#pragma unroll
          for (int s = 0; s < 4; ++s) { spa[dir][0][s] = *(const bf16x8*)(sp + 16 * s); spa[dir][1][s] = *(const bf16x8*)(sp + 32 * 64 + 16 * s); } }
#pragma unroll
      for (int g = 0; g < 4; ++g) { gq0[g] = *(const u32x2*)(gp0 + 8 * g); gq1[g] = *(const u32x2*)(gp0 + 32 + 8 * g); } }
    f32x16 o0, o1; const float zr = opaque_zero();
#pragma unroll
    for (int r = 0; r < 16; ++r) { o0[r] = zr; o1[r] = zr; }
    const int il = 32 * qq + r32;
#pragma unroll 1
    for (int kt = 0; kt < 4; ++kt) {
        f32x16 st;
#pragma unroll
        for (int r = 0; r < 16; ++r) st[r] = zr;
#pragma unroll
        for (int d0 = 0; d0 < 4; ++d0) { const bf16x8 kf = *(const bf16x8*)(kp + kt * 2048 + d0 * 512); st = __builtin_amdgcn_mfma_f32_32x32x16_bf16(kf, qf[d0], st, 0, 0, 0); }
        const int dq = il - 32 * kt - 8 * hi;
#pragma unroll
        for (int r = 0; r < 16; ++r) { const int dd = dq - (16 * (r >> 3) + (r & 7));
            const float dec = dd > 0 ? fexp2(lgf2 * (float)dd) : (dd == 0 ? 2.0f : fexp2(lgr2 * (float)(-dd)));
            st[r] *= dec; }
        const bf16x8 p0 = pack8(st, 0), p1 = pack8(st, 8);
        const bf16x8 v00 = *(const bf16x8*)(vp + kt * 2048), v01 = *(const bf16x8*)(vp + kt * 2048 + 1024), v10 = *(const bf16x8*)(vp + kt * 2048 + 256), v11 = *(const bf16x8*)(vp + kt * 2048 + 1024 + 256);
        o0 = __builtin_amdgcn_mfma_f32_32x32x16_bf16(v00, p0, o0, 0, 0, 0); o0 = __builtin_amdgcn_mfma_f32_32x32x16_bf16(v01, p1, o0, 0, 0, 0);
        o1 = __builtin_amdgcn_mfma_f32_32x32x16_bf16(v10, p0, o1, 0, 0, 0); o1 = __builtin_amdgcn_mfma_f32_32x32x16_bf16(v11, p1, o1, 0, 0, 0);
    }
#pragma unroll
    for (int dir = 0; dir < 2; ++dir) {
        f32x16 c0, c1;
#pragma unroll
        for (int r = 0; r < 16; ++r) { c0[r] = zr; c1[r] = zr; }
#pragma unroll
        for (int s = 0; s < 4; ++s) { c0 = __builtin_amdgcn_mfma_f32_32x32x16_bf16(spa[dir][0][s], qf[s], c0, 0, 0, 0); c1 = __builtin_amdgcn_mfma_f32_32x32x16_bf16(spa[dir][1][s], qf[s], c1, 0, 0, 0); }
        const float wgt = dir == 0 ? fexp2(lgf2 * (float)(il + 1)) : fexp2(lgr2 * (float)(128 - il));
#pragma unroll
        for (int r = 0; r < 16; ++r) { o0[r] += wgt * c0[r]; o1[r] += wgt * c1[r]; }
    }
    float ss = 0.f;
#pragma unroll
    for (int r = 0; r < 16; ++r) ss += o0[r] * o0[r] + o1[r] * o1[r];
    ss = xhalf_sum(ss);
    const float rstd = 1.0f / sqrtf(ss * (1.0f / 64.0f) + EPS);
    bf16_t* op = wsp<bf16_t>(p, WS_OCAT) + (size_t)(row0 + r32) * DM + 1024 + h * 64 + 4 * hi;
#pragma unroll
    for (int g = 0; g < 4; ++g) {
        const u32x2 g0 = gq0[g], g1 = gq1[g];
        u32x2 w0, w1;
        w0.x = cvt_pk_bf16(o0[4 * g] * rstd * silu_f(bf_lo(g0.x)), o0[4 * g + 1] * rstd * silu_f(bf_hi(g0.x))); w0.y = cvt_pk_bf16(o0[4 * g + 2] * rstd * silu_f(bf_lo(g0.y)), o0[4 * g + 3] * rstd * silu_f(bf_hi(g0.y)));
        w1.x = cvt_pk_bf16(o1[4 * g] * rstd * silu_f(bf_lo(g1.x)), o1[4 * g + 1] * rstd * silu_f(bf_hi(g1.x))); w1.y = cvt_pk_bf16(o1[4 * g + 2] * rstd * silu_f(bf_lo(g1.y)), o1[4 * g + 3] * rstd * silu_f(bf_hi(g1.y)));
        *(u32x2*)(op + 8 * g) = w0; *(u32x2*)(op + 32 + 8 * g) = w1;
    }
}
constexpr int MLA_KIMG = 12288, MLA_VIMG = 8192, MLA_NT = KEYS / 64, MLA_NS = 6, MLA_D = MLA_NS - 1, MLA_VOFF = MLA_NS * MLA_KIMG;
__device__ __forceinline__ void mla_dma_tile(const unsigned char* kimg, const unsigned char* vimg, LAS unsigned char* lds, int slot, int w, int lane) {
#pragma unroll
    for (int i = 0; i < 3; ++i) {
        const int j = w + 8 * i;
        if (j < 20) {
            const unsigned char* src = j < 12 ? kimg + j * 1024 + lane * 16 : vimg + (j - 12) * 1024 + lane * 16;
            LAS unsigned char* dst = j < 12 ? lds + slot * MLA_KIMG + j * 1024 : lds + MLA_VOFF + slot * MLA_VIMG + (j - 12) * 1024;
            __builtin_amdgcn_global_load_lds((const GAS unsigned*)src, (LAS unsigned*)dst, 16, 0, 0);
        }
    }
}
__device__ __forceinline__ void mla_unit(const Params& p, LAS unsigned char* lds, int bh, int qb, int tile0, int ntiles, int tid, const float* qgain  ) {
    const int lane = tid & 63, w = __builtin_amdgcn_readfirstlane(tid >> 6), r32 = lane & 31, hi = lane >> 5, b = bh >> 3, h = bh & 7;
    const bool late = w >= 4;
    const int row0 = (qb < 16 ? b * SEQ + 256 * qb : ML + b * CTXL) + 32 * w;
    const unsigned char* kimg = wsp<unsigned char>(p, WS_KB) + ((size_t)bh * MLA_NT + tile0) * MLA_KIMG;
    const unsigned char* vimg = wsp<unsigned char>(p, WS_VTB) + ((size_t)bh * MLA_NT + tile0) * MLA_VIMG;
    bf16x8 qf[6];
    { const bf16_t* qrow = wsp<bf16_t>(p, WS_UPRAW) + (size_t)(row0 + r32) * 1792 + h * 96 + 8 * hi;
      u32x4 raw[6]; f32x4 gn[6][2], cs[4];
#pragma unroll
      for (int d0 = 0; d0 < 6; ++d0) raw[d0] = *(const u32x4*)(qrow + 16 * d0);
      const float rq = wsp<float>(p, WS_RQ)[row0 + r32];
#pragma unroll
      for (int d0 = 0; d0 < 6; ++d0) { gn[d0][0] = *(const f32x4*)(qgain + 16 * d0 + 8 * hi); gn[d0][1] = *(const f32x4*)(qgain + 16 * d0 + 8 * hi + 4); }
      const bool latent = qb < 16;
      { const float* rp = wsp<float>(p, WS_ROPE32) + ((size_t)(latent ? ((row0 + r32) & (SEQ - 1)) : 0) * 16 + 8 * hi) * 2;
#pragma unroll
        for (int j = 0; j < 4; ++j) cs[j] = *(const f32x4*)(rp + 4 * j); }
      asm volatile("s_waitcnt vmcnt(0)" ::: "memory");
      float x[6][8]; float ss = 0.f;
#pragma unroll
      for (int d0 = 0; d0 < 6; ++d0) { x[d0][0] = bf_lo(raw[d0].x); x[d0][1] = bf_hi(raw[d0].x); x[d0][2] = bf_lo(raw[d0].y); x[d0][3] = bf_hi(raw[d0].y);
          x[d0][4] = bf_lo(raw[d0].z); x[d0][5] = bf_hi(raw[d0].z); x[d0][6] = bf_lo(raw[d0].w); x[d0][7] = bf_hi(raw[d0].w);
#pragma unroll
          for (int e = 0; e < 8; e += 2) ss += x[d0][e] * x[d0][e] + x[d0][e + 1] * x[d0][e + 1]; }
      ss = xhalf_sum(ss);
      const float r = rq / sqrtf(rq * rq * ss * (1.0f / 96.0f) + EPS);
#pragma unroll
      for (int d0 = 0; d0 < 6; ++d0)
#pragma unroll
          for (int e = 0; e < 8; ++e) x[d0][e] *= r * gn[d0][e >> 2][e & 3];
      if (latent) {
#pragma unroll
          for (int e = 0; e < 8; ++e) { const float c = cs[e >> 1][2 * (e & 1)], s = cs[e >> 1][2 * (e & 1) + 1]; const float lo = x[4][e], up = x[5][e];
              x[4][e] = lo * c - up * s; x[5][e] = lo * s + up * c; } }
      const float qscale = 0.10206207261596575f * LOG2E;
#pragma unroll
      for (int d0 = 0; d0 < 6; ++d0) { u32x4 w; w.x = cvt_pk_bf16(x[d0][0] * qscale, x[d0][1] * qscale); w.y = cvt_pk_bf16(x[d0][2] * qscale, x[d0][3] * qscale);
          w.z = cvt_pk_bf16(x[d0][4] * qscale, x[d0][5] * qscale); w.w = cvt_pk_bf16(x[d0][6] * qscale, x[d0][7] * qscale); qf[d0] = __builtin_bit_cast(bf16x8, w); }
    }
#pragma unroll
    for (int i = 0; i < MLA_D; ++i) if (i < ntiles) mla_dma_tile(kimg + (size_t)i * MLA_KIMG, vimg + (size_t)i * MLA_VIMG, lds, i, w, lane);
    f32x16 o0, o1; const float zr = opaque_zero();
#pragma unroll
    for (int r = 0; r < 16; ++r) { o0[r] = zr; o1[r] = zr; }
    float m_run = 0.f, l_run = 0.f;
    if (ntiles >= MLA_D) { if (!late) asm volatile("s_waitcnt vmcnt(12)" ::: "memory"); else asm volatile("s_waitcnt vmcnt(8)" ::: "memory"); }
    else asm volatile("s_waitcnt vmcnt(0)" ::: "memory");
    __builtin_amdgcn_s_barrier();
    const int koff = (hi * 64 + permkey(r32)) * 16;
    const int voff = (hi * 64 + r32) * 16;
    bf16x8 kf[12];
#pragma unroll
    for (int d0 = 0; d0 < 6; ++d0) { kf[2 * d0] = *(const LAS bf16x8*)(lds + koff + d0 * 2048); kf[2 * d0 + 1] = *(const LAS bf16x8*)(lds + koff + d0 * 2048 + 512); }
    int slot = 0;
#define MLA_SEAM(t) do { if ((t) + MLA_D - 1 < ntiles) { if (!late) asm volatile("s_waitcnt vmcnt(9) lgkmcnt(0)" ::: "memory"); else asm volatile("s_waitcnt vmcnt(6) lgkmcnt(0)" ::: "memory"); } \
        else asm volatile("s_waitcnt vmcnt(0) lgkmcnt(0)" ::: "memory"); \
        __builtin_amdgcn_s_barrier(); \
        if ((t) + MLA_D < ntiles) mla_dma_tile(kimg + (size_t)((t) + MLA_D) * MLA_KIMG, vimg + (size_t)((t) + MLA_D) * MLA_VIMG, lds, slot == 0 ? MLA_NS - 1 : slot - 1, w, lane); } while (0)
    for (int t = 0; t < ntiles; ++t) {
        if (late) MLA_SEAM(t);
        f32x16 s0, s1;
#pragma unroll
        for (int r = 0; r < 16; ++r) { s0[r] = -m_run; s1[r] = -m_run; }
        __builtin_amdgcn_sched_barrier(0);
#pragma unroll
        for (int d0 = 0; d0 < 6; ++d0) {
            s0 = __builtin_amdgcn_mfma_f32_32x32x16_bf16(kf[2 * d0], qf[d0], s0, 0, 0, 0);
            s1 = __builtin_amdgcn_mfma_f32_32x32x16_bf16(kf[2 * d0 + 1], qf[d0], s1, 0, 0, 0);
        }
        __builtin_amdgcn_sched_barrier(0);
        if (!late) MLA_SEAM(t);
        const LAS unsigned char* vs = lds + MLA_VOFF + slot * MLA_VIMG + voff;
        const LAS unsigned char* ks = lds + (slot + 1 == MLA_NS ? 0 : slot + 1) * MLA_KIMG + koff;
        bf16x8 vf[8];
#pragma unroll
        for (int d0 = 0; d0 < 2; ++d0)
#pragma unroll
            for (int q = 0; q < 4; ++q) vf[d0 * 4 + q] = *(const LAS bf16x8*)(vs + q * 2048 + d0 * 512);
        if (t + 1 < ntiles) {
#pragma unroll
            for (int d0 = 0; d0 < 6; ++d0) { kf[2 * d0] = *(const LAS bf16x8*)(ks + d0 * 2048); kf[2 * d0 + 1] = *(const LAS bf16x8*)(ks + d0 * 2048 + 512); }
        }
        __builtin_amdgcn_sched_barrier(0);
        float mq[4];
#pragma unroll
        for (int r = 0; r < 4; ++r) mq[r] = fmaxf(s0[r], s1[r]);
#pragma unroll
        for (int r = 4; r < 16; ++r) mq[r & 3] = fmaxf(fmaxf(mq[r & 3], s0[r]), s1[r]);
        float mx = fmaxf(fmaxf(mq[0], mq[1]), fmaxf(mq[2], mq[3]));
        mx = xhalf_max(mx);
        if (__any(mx > 8.0f)) {
            const float d = fmaxf(mx, 0.f), f = fexp2(-d);
            m_run += d; l_run *= f;
#pragma unroll
            for (int r = 0; r < 16; ++r) { o0[r] *= f; o1[r] *= f; s0[r] -= d; s1[r] -= d; }
        }
        float pq[4] = {0.f, 0.f, 0.f, 0.f};
#define MLA_GRP(S, O, G, VA, VB) do { _Pragma("unroll") for (int r = (O); r < (O) + 8; ++r) { S[r] = fexp2(S[r]); pq[G] += S[r]; } \
            const bf16x8 pg = pack8(S, O); \
            o0 = __builtin_amdgcn_mfma_f32_32x32x16_bf16(vf[VA], pg, o0, 0, 0, 0); o1 = __builtin_amdgcn_mfma_f32_32x32x16_bf16(vf[VB], pg, o1, 0, 0, 0); } while (0)
        MLA_GRP(s0, 0, 0, 0, 4); MLA_GRP(s0, 8, 1, 1, 5); MLA_GRP(s1, 0, 2, 2, 6); MLA_GRP(s1, 8, 3, 3, 7);
#undef MLA_GRP
        l_run += (pq[0] + pq[1]) + (pq[2] + pq[3]);
        slot = slot + 1 == MLA_NS ? 0 : slot + 1;
    }
#undef MLA_SEAM
    l_run = xhalf_sum(l_run);
    const float inv = 1.0f / l_run;
    bf16_t* orow = wsp<bf16_t>(p, WS_OCAT) + (size_t)(row0 + r32) * DM + 512 + h * 64 + 4 * hi;
#pragma unroll
    for (int g = 0; g < 4; ++g) {
        u32x2 w0, w1;
        w0.x = cvt_pk_bf16(o0[4 * g] * inv, o0[4 * g + 1] * inv); w0.y = cvt_pk_bf16(o0[4 * g + 2] * inv, o0[4 * g + 3] * inv);
        w1.x = cvt_pk_bf16(o1[4 * g] * inv, o1[4 * g + 1] * inv); w1.y = cvt_pk_bf16(o1[4 * g + 2] * inv, o1[4 * g + 3] * inv);
        *(u32x2*)(orow + 8 * g) = w0; *(u32x2*)(orow + 32 + 8 * g) = w1;
    }
    asm volatile("s_waitcnt vmcnt(0) lgkmcnt(0)" ::: "memory");
}
__device__ __forceinline__ void moe_tables(const Params& p, LAS int* tb, int tid) {
    if (tid < NEXP)
        tb[160 + tid] = (int)__hip_atomic_load(wsp<unsigned>(p, WS_CTL) + CW_ECNT + 64 * tid, __ATOMIC_RELAXED, __HIP_MEMORY_SCOPE_AGENT);
    __syncthreads();
    if (tid == 0) {
        int base = 0;
        for (int e = 0; e < NEXP; ++e) {
            const int cnt = tb[160 + e];
            const int nt = (cnt + 255) >> 8; tb[e] = base * 256;
            int ev = e; asm volatile("" : "+v"(ev));
#pragma clang loop vectorize(disable) unroll(disable)
            for (int t = 0; t < nt; ++t) tb[16 + base + t] = ev;
            base += nt;
        }
        tb[8] = base;
    }
    __syncthreads();
}

__device__ __forceinline__ int gemm_cus(int nwg, int G) { const int R = (nwg + G - 1) / G; const int g = (((nwg + R - 1) / R) + 7) & ~7; return g < G ? g : G; }

constexpr int NPHASE = 24;
constexpr int MAIN_RT = 2 * ML / 256;
constexpr int CONV_C1 = 0, CONV_C2 = CONV_C1 + 7168, CONV_CF = CONV_C2 + 0  , CONV_C3 = CONV_CF + (FFN2_FP8 ? 22528 : 21504), CONV_C4 = CONV_C3 + 9216;
constexpr int DI_GU_A = 5632;
constexpr int CONV_WQG = 544;
constexpr int CONV_C5 = CONV_C4 + 2 * CONV_WQG * 32;
static_assert(CONV_C5 <= NCONV, "conversion shares");
__global__ void __launch_bounds__(512, 2) fwd_kernel(Params pk) {
    const KArg ka0 = (KArg)__builtin_amdgcn_kernarg_segment_ptr(); (void)pk;
    Params p = load_params(ka0);
    extern __shared__ __attribute__((aligned(16))) unsigned char lds_raw[];
    LAS unsigned char* lds = (LAS unsigned char*)lds_raw;
    volatile LAS unsigned* MISC = (volatile LAS unsigned*)(lds + MISC_OFF);
    const int wave_o = __builtin_amdgcn_readfirstlane((int)threadIdx.x >> 6);
    const int G_o = gridDim.x; const int vcu_o = (G_o % 8 == 0) ? ((int)blockIdx.x % 8) * (G_o / 8) + (int)blockIdx.x / 8 : (int)blockIdx.x;
    { const int t0 = threadIdx.x; if (t0 < 256) MISC[t0] = 0u; }
    __syncthreads();
    XcdBarrier bar; bar.bar = wsp<unsigned>(p, WS_CTL) + CW_BAR; bar.x = 0; bar.st = MISC + 8;
#if MK_ONE_LAUNCH
    bar = xcd_barrier_post(wsp<unsigned>(p, WS_CTL) + CW_BAR, MISC + 8, wave_o == 0 && lane_id_asm() == 0);
#endif
    const int lo = p.ph_lo, hi = p.ph_hi;
#define IN(k) (lo <= (k) && (k) < hi)
#ifndef PH_MASK
#define PH_MASK 0xffffffffu
#endif
#define PHEN(k) (((PH_MASK) >> (k)) & 1u)
#ifndef REP_MASK
#define REP_MASK 0u
#endif
#ifndef REP_LAYER
#define REP_LAYER -1
#endif
#define REPS(k) (1 + (int)((((REP_MASK) >> (k)) & 1u) && (REP_LAYER < 0 || l == REP_LAYER)))
#if MK_ONE_LAUNCH
#define SEAM(k) do { if (IN(k) && IN((k) + 1)) xcd_barrier(bar, wave_o == 0 && lane_id_asm() == 0); } while (0)
#else
#define SEAM(k) do { } while (0)
#endif
#ifdef NO_LWS
#define LAUNDER_WS
#else
#define LAUNDER_WS asm volatile("" : "+s"(p.ws))
#endif
#define OPQ Params p = load_params(ka0); const int lane = lane_id_asm(), wave = lnd_s(wave_o), tid = wave * 64 + lane, bid = lnd_s((int)blockIdx.x), G = lnd_s(G_o), vcu = lnd_s(vcu_o), gw = vcu * 8 + wave, NGW = G * 8; \
    (void)tid; (void)bid; (void)gw; (void)NGW; LAUNDER_WS; if (REP_MASK) __syncthreads();
    LAS int* tb = (LAS int*)(lds + MISC_OFF + 256);

    if (PHEN(0) && IN(0)) for (int rep = 0, l = 1; rep < REPS(0); ++rep) { OPQ p0_prologue(p, lds, G, vcu, wave); }
    SEAM(0);

#pragma unroll
    for (int l = 0; l < 2; ++l) {
        const int pb = 1 + 12 * l;
        const float* mod = wsp<float>(p, WS_MOD) + (size_t)l * 5 * MODW;
        const int mrows = l == 0 ? MT : ML;
        if (PHEN(1) && IN(pb + 0)) for (int rep = 0; rep < REPS(1); ++rep) { OPQ
            for (int row = 2 * gw; row < MT; row += 2 * NGW) {
                const float* ma = mod + (size_t)(row < ML ? (row >> 12) : 4) * MODW;
                if (l == 0) norm_mod_row2<false, false>(row < ML ? p.in[I_X] + (size_t)row * DM : p.in[I_CTX] + (size_t)(row - ML) * DM, p.in[I_NMIX] + l * DM, ma, ma + DM, wsp<bf16_t>(p, WS_H) + (size_t)row * DM, DM, lane);
                else norm_mod_row2<false, true>(wsp<bf16_t>(p, WS_X1) + (size_t)row * DM, p.in[I_NMIX] + l * DM, ma, ma + DM, wsp<bf16_t>(p, WS_H) + (size_t)row * DM, DM, lane);
            }
        }
        SEAM(pb + 0);
        if (PHEN(2) && IN(pb + 1)) for (int rep = 0; rep < REPS(2); ++rep) { OPQ
            pg8::Gemm g{wsp<bf16_t>(p, WS_H), wsp<bf16_t>(p, WS_WIN) + (size_t)l * INCP * DM, DM, DM, 0, 0, 0};
            pg8::TileOrder S; S.init(MT / 256, INCP / 256, G, bid, nullptr);
            pg8::EpiBf16 E{wsp<bf16_t>(p, WS_P), INCP};
            pg8::gemm_phase<2>(lds, g, S, E, wave);
            { const int fi = S.first_idle(); const bool all = fi >= G;
              if (all || S.idle_last_round()) { const int wi = all ? gw : (bid - fi) * 8 + wave, nw = all ? NGW : (G - fi) * 8;
                  if (l == 0) dense_items(p, lds, wave, lane, 2 * DI_PER_L, 2 * DI_PER_L + DI_GU_A, wi, nw);
                  moe_convert_pipe(p, lds, wave, lane, l == 0 ? 0 : CONV_C3, l == 0 ? CONV_C1 : CONV_C4, wi, nw); } }
        }
        SEAM(pb + 1);
        if (PHEN(3) && IN(pb + 2)) for (int rep = 0; rep < REPS(3); ++rep) { OPQ
#ifndef NO_UPG
            { pg8::Gemm g{wsp<bf16_t>(p, WS_P) + PC_BQ, wsp<bf16_t>(p, WS_WUP) + (size_t)l * 1792 * 512, INCP, 512, 0, 0, 0};
              pg8::TileOrder S; S.init(MT / 256, 7, G, bid, nullptr);
              pg8::EpiBf16 E{wsp<bf16_t>(p, WS_UPRAW), 1792};
              pg8::gemm_phase<2>(lds, g, S, E, wave); }
#endif
            __syncthreads();
#ifndef NO_HEADS
            { const int l16h = lane & 15;
              const f32x4 g_ak = *(const f32x4*)(p.in[I_AKN] + l * 64 + 4 * l16h), g_dk = *(const f32x4*)(p.in[I_DKN] + l * 64 + 4 * l16h), g_no = {1.f, 1.f, 1.f, 1.f};
            for (int row = gw; row < MT; row += 2 * NGW) {
                const int rb = row + NGW < MT ? row + NGW : row;
                const HeadKind kak{PC_AK, 2, p.in[I_AKN] + l * 64, 1, 1.0f, wsp<bf16_t>(p, WS_KA), 1};
                const HeadKind kck{PC_CK, 8, nullptr, 1, 0.125f, wsp<bf16_t>(p, WS_KC), 1};
                const HeadKind kdk{PC_DK, 8, p.in[I_DKN] + l * 64, 0, 1.0f, wsp<bf16_t>(p, WS_KD), 1};
                u32x2 w1[2], w3[2], w5[2], u1[2], u3[2], u5[2];
                f32x4 ra[2], rbp[2];
                { const float* ca = wsp<float>(p, WS_ROPE64) + ((size_t)(row < ML ? (row & (SEQ - 1)) : 0) * 32 + 4 * (l16h & 7)) * 2; ra[0] = *(const f32x4*)ca; ra[1] = *(const f32x4*)(ca + 4);
                  const float* cb = wsp<float>(p, WS_ROPE64) + ((size_t)(rb < ML ? (rb & (SEQ - 1)) : 0) * 32 + 4 * (l16h & 7)) * 2; rbp[0] = *(const f32x4*)cb; rbp[1] = *(const f32x4*)(cb + 4); }
                prep_heads_load(p, kak, row, lane, w1); prep_heads_load(p, kck, row, lane, w3); prep_heads_load(p, kdk, row, lane, w5);
                prep_heads_load(p, kak, rb, lane, u1); prep_heads_load(p, kck, rb, lane, u3); prep_heads_load(p, kdk, rb, lane, u5);
                prep_heads_compute(p, kak, row, lane, w1, ra, g_ak); prep_heads_compute(p, kck, row, lane, w3, ra, g_no); prep_heads_compute(p, kdk, row, lane, w5, ra, g_dk);
                prep_heads_compute(p, kak, rb, lane, u1, rbp, g_ak); prep_heads_compute(p, kck, rb, lane, u3, rbp, g_no); prep_heads_compute(p, kdk, rb, lane, u5, rbp, g_dk);
            } }
#endif
#ifndef NO_TR
            LAS bf16_t* scr = (LAS bf16_t*)(lds + wave * 16384);
            for (int u = (gw + NGW / 2) % NGW; u < NB * 68 * 26; u += NGW) {
                const int b = u / (68 * 26), r = u % (68 * 26), tt = r / 26, hh = r % 26;
                if (hh < 2) { const TrKind k{wsp<bf16_t>(p, WS_P), INCP, PC_AV, 2, nullptr, 0, 1.0f, 0, wsp<bf16_t>(p, WS_VTA), nullptr, 0.f, 0.f, 2}; prep_transpose_unit(p, k, b, hh, tt, scr, lane); }
                else if (hh < 10) { const TrKind k{wsp<bf16_t>(p, WS_P), INCP, PC_CV, 8, nullptr, 0, 1.0f, 0, wsp<bf16_t>(p, WS_VTC), nullptr, 0.f, 0.f, 2}; prep_transpose_unit(p, k, b, hh - 2, tt, scr, lane); }
                else if (hh < 18) { const TrKind k{wsp<bf16_t>(p, WS_P), INCP, PC_DV, 8, nullptr, 0, 1.0f, 0, wsp<bf16_t>(p, WS_VTD), nullptr, 0.f, 0.f, 2}; prep_transpose_unit(p, k, b, hh - 10, tt, scr, lane); }
                else { const int h = hh - 18;
                    const float lgf2 = -__expf(p.in[I_CLD][(l * 2 + 0) * 8 + h]) * LOG2E, lgr2 = -__expf(p.in[I_CLD][(l * 2 + 1) * 8 + h]) * LOG2E;
                    const TrKind k{wsp<bf16_t>(p, WS_P), INCP, PC_CK, 8, nullptr, 1, 0.125f, 1, wsp<bf16_t>(p, WS_KWF), wsp<bf16_t>(p, WS_KWR), lgf2, lgr2, 2}; prep_transpose_unit(p, k, b, h, tt, scr, lane); }
            }
#endif
        }
        SEAM(pb + 2);
        if (PHEN(4) && IN(pb + 3)) for (int rep = 0; rep < REPS(4); ++rep) { OPQ
            { const int l32m = lane & 31, d0m = l32m < 24 ? 4 * l32m : 0;
              const f32x4 gq = *(const f32x4*)(p.in[I_BQN] + l * 96 + d0m), gk = *(const f32x4*)(p.in[I_BKN] + l * 96 + d0m);
            for (int row = gw; row < MT; row += 2 * NGW) {
                const int rb = row + NGW < MT ? row + NGW : row;
                MlaRegs Ra, Rb; prep_mla_load(p, row, lane, Ra); prep_mla_load(p, rb, lane, Rb);
                prep_mla_compute(p, l, row, lane, Ra, gq, gk); prep_mla_compute(p, l, rb, lane, Rb, gq, gk);
            } }
            for (int u = (gw + NGW / 2) % NGW; u < 64 * 34; u += NGW) ret_c1_unit(p, u / 34, u % 34, lane);
        }
        SEAM(pb + 3);
        if (PHEN(5) && IN(pb + 4)) for (int rep = 0; rep < REPS(5); ++rep) { OPQ
            LAS bf16_t* scr = (LAS bf16_t*)(lds + wave * 16384);
            for (int u = gw; u < NB * 68 * 8; u += NGW) {
                const int b = u / (68 * 8), r = u % (68 * 8), tt = r / 8, h = r % 8;
                const TrKind k{wsp<bf16_t>(p, WS_UPRAW), 1792, 768 + 64, -8, wsp<float>(p, WS_RKV), 0, 1.0f, 0, wsp<bf16_t>(p, WS_VTB), nullptr, 0.f, 0.f, 1};
                prep_transpose_unit(p, k, b, h, tt, scr, lane);
            }
            ret_c2(p, l, vcu * 512 + tid, G * 512);
        }
        SEAM(pb + 4);
        if (PHEN(6) && IN(pb + 5)) for (int rep = 0; rep < REPS(6); ++rep) { OPQ
#ifndef REP_MLA
#define REP_MLA 1
#endif
#ifndef REP_WQ
#define REP_WQ 1
#endif
            for (int rep2 = 0; rep2 < REP_MLA; ++rep2)
            { const int nmla = NB * 8 * 16 + (l == 0 ? NB * 8 : 0);
              for (int u = vcu; u < nmla; u += G) {
                  if (u < NB * 8 * 16) mla_unit(p, lds, u >> 4, u & 15, 0, MLA_NT, tid, p.in[I_BQN] + l * 96);
                  else mla_unit(p, lds, u - NB * 8 * 16, 16, SEQ / 64, CTXL / 64, tid, p.in[I_BQN] + l * 96);
                  __builtin_amdgcn_s_barrier();
              } }
            const int nq = l == 0 ? 136 : 128;
            const int gD = NB * 8 * (nq / 8), gA = NB * 2 * (nq / 2), gC = NB * 8 * ((l == 0 ? 34 : 32) / 2);
            const int total = gD + gA + gC;
            const float NEG = -__builtin_inff();
            for (int rep3 = 0; rep3 < REP_WQ; ++rep3) {
            unsigned qpend = 0u;
            if (tid == 0) qpend = __hip_atomic_fetch_add(wsp<unsigned>(p, WS_CTL) + CW_Q + 64 * (l + 2 * rep + 4 * rep3), 1u, __ATOMIC_RELAXED, __HIP_MEMORY_SCOPE_AGENT);
            for (;;) {
                __syncthreads();
                if (tid == 0) { MISC[16] = qpend; qpend = __hip_atomic_fetch_add(wsp<unsigned>(p, WS_CTL) + CW_Q + 64 * (l + 2 * rep + 4 * rep3), 1u, __ATOMIC_RELAXED, __HIP_MEMORY_SCOPE_AGENT); }
                __syncthreads();
                const int qi = (int)MISC[16];
                if (qi >= 4 * max((total + 2) / 3, CONV_WQG)) break;
                if ((qi & 3) == 3) {
                    if ((qi >> 2) < CONV_WQG && rep3 == 0 && rep == 0) { const int r0 = CONV_C4 + l * CONV_WQG * 32 + (qi >> 2) * 32 + wave * 4; moe_convert_pipe(p, lds, wave, lane_id_asm(), r0, r0 + 4, 0, 1); }
                    continue;
                }
                int gi = 3 * (qi >> 2) + (qi & 3);
                if (gi >= total) continue;
                if (gi < gD + gA) {
                    int mixer, b, h, qb;
                    if (gi < gD) { mixer = 3; const int rg = gi % (nq / 8), bh = gi / (nq / 8); b = bh >> 3; h = bh & 7; qb = 8 * rg + wave; }
                    else { gi -= gD; mixer = 0; const int qp = gi % (nq / 2), bg = gi / (nq / 2); b = bg >> 1; h = 4 * (bg & 1) + (wave & 3); qb = 2 * qp + (wave >> 2); }
                    const int bh = b * 8 + h;
                    const bool cq = qb >= 128;
                    const int row0 = cq ? ML + b * CTXL + 32 * (qb - 128) : b * SEQ + 32 * qb;
                    AttnArgs a; a.c0 = 128; a.c1 = 136; a.sink2 = NEG; a.q0 = 0; a.qrow = 0; a.rpb = nullptr; a.opitch = DM; a.t0 = 0; a.t1 = 0; a.qpitch = INCP; a.qscale = 0.125f * LOG2E; a.qrope = nullptr;
                    if (mixer == 0) {
                        a.Q = wsp<bf16_t>(p, WS_P) + (size_t)row0 * INCP + PC_AQ + h * 64; a.qgain = p.in[I_AQN] + l * 64; if (!cq) a.qrope = wsp<float>(p, WS_ROPE64) + (size_t)(32 * qb) * 64;
                        a.K = wsp<bf16_t>(p, WS_KA) + (size_t)(b * 2 + (h >> 2)) * KEYS * 64; a.Vt = wsp<bf16_t>(p, WS_VTA) + (size_t)(b * 2 + (h >> 2)) * 64 * KEYS;
                        a.O = wsp<bf16_t>(p, WS_OCAT) + (size_t)row0 * DM + h * 64; a.sink2 = p.in[I_ASINK][l * 8 + h] * LOG2E;
                        if (!cq) { a.t0 = max(0, qb - 4); a.t1 = min(128, qb + 5); a.q0 = 32 * qb; attn_wave<64, 1>(a, lane); } else attn_wave<64, 0>(a, lane);
                    } else {
                        a.Q = wsp<bf16_t>(p, WS_P) + (size_t)row0 * INCP + PC_DQ + h * 64; a.qgain = p.in[I_DQN] + l * 64;
                        a.K = wsp<bf16_t>(p, WS_KD) + (size_t)bh * KEYS * 64; a.Vt = wsp<bf16_t>(p, WS_VTD) + (size_t)bh * 64 * KEYS;
                        a.O = wsp<bf16_t>(p, WS_OCAT) + (size_t)row0 * DM + 1536 + h * 64;
                        if (!cq) { const int gr = qb >> 1, rs = min(max(gr - 4, 0), 56); a.t0 = 2 * rs; a.t1 = a.t0 + 16; a.q0 = (qb & 1) * 32; a.qrow = gr; a.rpb = wsp<float>(p, WS_RPB) + (size_t)(l * 8 + h) * 15 * 128;
                            attn_wave<64, 2>(a, lane); } else attn_wave<64, 0>(a, lane);
                    }
                } else {
                    gi -= gD + gA;
                    const int nch2 = (l == 0 ? 34 : 32) / 2;
                    const int c = 2 * (gi % nch2) + (wave >> 2), bh = gi / nch2;
                    ret_c3_unit(p, l, bh, c, wave & 3, lane_id_asm());
                }
            }
            }
        }
        SEAM(pb + 5);
        if (PHEN(7) && IN(pb + 6)) for (int rep = 0; rep < REPS(7); ++rep) { OPQ
            pg8::Gemm g{wsp<bf16_t>(p, WS_OCAT), wsp<bf16_t>(p, WS_WOUT) + (size_t)l * DM * DM, DM, DM, 0, 0, 0};
            const int Gg = gemm_cus((mrows / 256) * (DM / 256), G);
            pg8::TileOrder S; S.init(mrows / 256, DM / 256, Gg, bid, nullptr);
            if (bid < Gg) {
                if (l == 0) { pg8::EpiResid<true> E{p.in[I_X], p.in[I_CTX], wsp<bf16_t>(p, WS_X1), mod + 2 * DM}; pg8::gemm_phase<2>(lds, g, S, E, wave); }
                else { pg8::EpiResid<false> E{wsp<bf16_t>(p, WS_X1), wsp<bf16_t>(p, WS_X1) + (size_t)ML * DM, wsp<bf16_t>(p, WS_X1), mod + 2 * DM}; pg8::gemm_phase<2>(lds, g, S, E, wave); }
            }
            if (l == 0) { if (Gg >= G) { dense_items(p, lds, wave, lane, 2 * DI_PER_L + DI_GU_A, DI_ALL, gw, NGW); moe_convert(p, lds, wave, lane, CONV_C1, CONV_C2, gw, NGW); }
              else if (bid >= Gg) { dense_items(p, lds, wave, lane, 2 * DI_PER_L + DI_GU_A, DI_ALL, (bid - Gg) * 8 + wave, (G - Gg) * 8);
                  moe_convert_pipe(p, lds, wave, lane, CONV_C1, CONV_C2, (bid - Gg) * 8 + wave, (G - Gg) * 8); } }
        }
        SEAM(pb + 6);
        if (PHEN(8) && IN(pb + 7)) for (int rep = 0; rep < REPS(8); ++rep) { OPQ
            if (l == 0) {
                for (int row = 2 * gw; row < MT; row += 2 * NGW) {
                    const float* ma = mod + (size_t)(row < ML ? (row >> 12) : 4) * MODW;
                    norm_mod_row2<(FFN1_FP8 != 0), true>(wsp<bf16_t>(p, WS_X1) + (size_t)row * DM, p.in[I_NFFN] + l * DM, ma + 3 * DM, ma + 4 * DM, wsp<bf16_t>(p, WS_H) + (size_t)row * (FFN1_FP8 ? DM / 2 : DM), FFN1_FP8 ? DM / 2 : DM, lane);
                }
            } else {
                LAS float* rt = (LAS float*)lds;
                LAS int* lcnt = (LAS int*)(lds + 65536);
                LAS int* rinfo = (LAS int*)(lds + 65536 + 64);
                for (int i = tid; i < DM * 8; i += 512) rt[i] = p.in[I_MR][i];
                if (tid < 16) lcnt[tid] = 0;
                __syncthreads();
                for (int grp = bid; grp < ML / 64; grp += G) {
                    const float* mv = mod + (size_t)((grp * 64) >> 12) * MODW;
                    const u32x2* xr = (const u32x2*)(wsp<bf16_t>(p, WS_X1) + (size_t)(grp * 64 + wave * 8) * DM);
                    u32x2 xn[8]; f32x4 m1[8], sq[8];
#pragma unroll
                    for (int j = 0; j < 8; ++j) xn[j] = xr[lane + 64 * j];
#pragma unroll
                    for (int j = 0; j < 8; ++j) { const int c = lane + 64 * j; const f32x4 gq = *((const f32x4*)(p.in[I_NFFN] + l * DM) + c), aq = *((const f32x4*)(mv + 4 * DM) + c);
                        sq[j] = *((const f32x4*)(mv + 3 * DM) + c); m1[j] = gq * (aq + 1.0f); }
#pragma nounroll
                    for (int rr = 0; rr < 8; ++rr) {
                        const int rl = wave * 8 + rr, row = grp * 64 + rl;
                        f32x4 v[8];
#pragma unroll
                        for (int j = 0; j < 8; ++j) v[j] = (f32x4){bf_lo(xn[j].x), bf_hi(xn[j].x), bf_lo(xn[j].y), bf_hi(xn[j].y)};
                        if (rr < 7) { xr += DM / 4;
#pragma unroll
                            for (int j = 0; j < 8; ++j) xn[j] = xr[lane + 64 * j]; }
                        { float ss = 0.f;
#pragma unroll
                          for (int j = 0; j < 8; ++j) ss += (v[j].x * v[j].x + v[j].y * v[j].y) + (v[j].z * v[j].z + v[j].w * v[j].w);
                          const float rstd = 1.0f / sqrtf(wave_sum(ss) * (1.0f / DM) + EPS);
                          unsigned* orow = (unsigned*)(wsp<unsigned char>(p, WS_H) + (size_t)row * DM);
#pragma unroll
                          for (int j = 0; j < 8; ++j) { v[j] = (v[j] * rstd) * m1[j] + sq[j]; orow[lane + 64 * j] = pack_fp8x4(v[j].x, v[j].y, v[j].z, v[j].w); } }
                        float lg[8];
#pragma unroll
                        for (int e = 0; e < 8; ++e) lg[e] = 0.f;
#pragma unroll
                        for (int j = 0; j < 8; ++j)
#pragma unroll
                            for (int c = 0; c < 4; ++c) { const int k = 4 * (lane + 64 * j) + c; const f32x4 r0 = *(const LAS f32x4*)(rt + k * 8), r1 = *(const LAS f32x4*)(rt + k * 8 + 4); const float x = v[j][c];
                                lg[0] += x * r0.x; lg[1] += x * r0.y; lg[2] += x * r0.z; lg[3] += x * r0.w; lg[4] += x * r1.x; lg[5] += x * r1.y; lg[6] += x * r1.z; lg[7] += x * r1.w; }
#pragma unroll
                        for (int e = 0; e < 8; ++e) lg[e] = wave_sum(lg[e]);
                        int e0 = 0; float l0 = lg[0];
#pragma unroll
                        for (int e = 1; e < 8; ++e) if (lg[e] > l0) { l0 = lg[e]; e0 = e; }
                        int e1 = -1; float l1 = -__builtin_inff();
#pragma unroll
                        for (int e = 0; e < 8; ++e) if (e != e0 && lg[e] > l1) { l1 = lg[e]; e1 = e; }
                        if (lane == 0) {
                            const float g0 = 1.0f / (1.0f + __expf(l1 - l0));
                            const int r0 = __hip_atomic_fetch_add(lcnt + e0, 1, __ATOMIC_RELAXED, __HIP_MEMORY_SCOPE_WORKGROUP), r1 = __hip_atomic_fetch_add(lcnt + e1, 1, __ATOMIC_RELAXED, __HIP_MEMORY_SCOPE_WORKGROUP);
                            rinfo[rl * 8 + 0] = e0; rinfo[rl * 8 + 1] = e1; rinfo[rl * 8 + 2] = r0; rinfo[rl * 8 + 3] = r1; rinfo[rl * 8 + 4] = __float_as_int(g0); rinfo[rl * 8 + 5] = __float_as_int(1.0f - g0);
                        }
                    }
                    __syncthreads();
                    if (tid < 8) lcnt[8 + tid] = (int)__hip_atomic_fetch_add(wsp<unsigned>(p, WS_CTL) + CW_ECNT + 64 * tid, (unsigned)lcnt[tid], __ATOMIC_RELAXED, __HIP_MEMORY_SCOPE_AGENT);
                    __syncthreads();
                    if (tid < 64) { int* ro = wsp<int>(p, WS_ROUTE) + (size_t)(grp * 64 + tid) * 8; const int e0 = rinfo[tid * 8], e1 = rinfo[tid * 8 + 1];
                        ro[0] = e0; ro[1] = e1; ro[2] = lcnt[8 + e0] + rinfo[tid * 8 + 2]; ro[3] = lcnt[8 + e1] + rinfo[tid * 8 + 3]; ro[4] = rinfo[tid * 8 + 4]; ro[5] = rinfo[tid * 8 + 5]; }
                    __syncthreads();
                    if (tid < 8) lcnt[tid] = 0;
                    __syncthreads();
                }
            }
        }
        SEAM(pb + 7);
        if (l == 0) {
            if (PHEN(9) && IN(pb + 8)) for (int rep = 0; rep < REPS(9); ++rep) { OPQ
                pg8::TileOrder S; S.init(MT / 256, 2 * DFF / 256, G, bid, nullptr);
#if FFN2_FP8
                pg8::EpiSwiGLU8 E{wsp<unsigned char>(p, WS_ACT), DFF};
#else
                pg8::EpiSwiGLU E{wsp<bf16_t>(p, WS_ACT), DFF};
#endif
#if FFN1_FP8
                pg8::Gemm g{wsp<unsigned char>(p, WS_H), wsp<unsigned char>(p, WS_WGU), DM, DM, 0, 0x7f7f7f7f, 0x77777777};
                pg8::gemm_phase<1>(lds, g, S, E, wave);
#else
                pg8::Gemm g{wsp<bf16_t>(p, WS_H), wsp<bf16_t>(p, WS_WGU), DM, DM, 0, 0, 0};
                pg8::gemm_phase<2>(lds, g, S, E, wave);
#endif
                { const int fi = S.first_idle(); if (fi >= G) moe_convert(p, lds, wave, lane, CONV_C2, CONV_CF, gw, NGW);
                  else if (S.idle_last_round()) moe_convert(p, lds, wave, lane, CONV_C2, CONV_CF, (bid - fi) * 8 + wave, (G - fi) * 8); }
            }
            SEAM(pb + 8);
            if (PHEN(10) && IN(pb + 9)) for (int rep = 0; rep < REPS(10); ++rep) { OPQ
                const int Gg = gemm_cus((MT / 256) * (DM / 256), G);
                pg8::TileOrder S; S.init(MT / 256, DM / 256, Gg, bid, nullptr);
                pg8::EpiResid<false> E{wsp<bf16_t>(p, WS_X1), wsp<bf16_t>(p, WS_X1) + (size_t)ML * DM, wsp<bf16_t>(p, WS_X1), mod + 5 * DM};
#if FFN2_FP8
                pg8::Gemm g{wsp<unsigned char>(p, WS_ACT), wsp<unsigned char>(p, WS_WD), DFF, DFF, 0, 0x7f7f7f7f, 0x77777777};
                if (bid < Gg) pg8::gemm_phase<1>(lds, g, S, E, wave);
#else
                pg8::Gemm g{wsp<bf16_t>(p, WS_ACT), wsp<bf16_t>(p, WS_WD), DFF, DFF, 0, 0, 0};
                if (bid < Gg) pg8::gemm_phase<2>(lds, g, S, E, wave);
#endif
                if (Gg >= G) { dense_items(p, lds, wave, lane, DI_PER_L, 2 * DI_PER_L, gw, NGW); moe_convert(p, lds, wave, lane, CONV_CF, CONV_C3, gw, NGW); }
                else if (bid >= Gg) { dense_items(p, lds, wave, lane, DI_PER_L, 2 * DI_PER_L, (bid - Gg) * 8 + wave, (G - Gg) * 8);
                    moe_convert_pipe(p, lds, wave, lane, CONV_CF, CONV_C3, (bid - Gg) * 8 + wave, (G - Gg) * 8); }
            }
            SEAM(pb + 9);
        } else {
            if (PHEN(9) && IN(pb + 8)) for (int rep = 0; rep < REPS(9); ++rep) { OPQ
                moe_convert(p, lds, wave, lane, CONV_C5, NCONV, gw, NGW);
                __syncthreads();
                moe_tables(p, tb, tid);
                for (int row = gw; row < ML; row += 4 * NGW) {
                    i32x4r rt4[4]; u32x4 v4[4][2];
#pragma unroll
                    for (int q = 0; q < 4; ++q) { const int rw = min(row + q * NGW, ML - 1);
                        rt4[q] = *(const i32x4r*)(wsp<int>(p, WS_ROUTE) + (size_t)rw * 8);
                        const u32x4* src = (const u32x4*)(wsp<unsigned char>(p, WS_H) + (size_t)rw * DM);
                        v4[q][0] = src[lane]; v4[q][1] = src[lane + 64]; }
#pragma unroll
                    for (int q = 0; q < 4; ++q) { const int rw = row + q * NGW;
                        if (rw < ML) {
                            int* ro = wsp<int>(p, WS_ROUTE) + (size_t)rw * 8;
                            const int s0 = tb[rt4[q].x] + rt4[q].z, s1 = tb[rt4[q].y] + rt4[q].w;
                            if (lane == 0) { ro[6] = s0; ro[7] = s1; }
                            u32x4* d0 = (u32x4*)(wsp<unsigned char>(p, WS_HS) + (size_t)s0 * DM); u32x4* d1 = (u32x4*)(wsp<unsigned char>(p, WS_HS) + (size_t)s1 * DM);
                            d0[lane] = v4[q][0]; d1[lane] = v4[q][0]; d0[lane + 64] = v4[q][1]; d1[lane + 64] = v4[q][1];
                        } }
                }
            }
            SEAM(pb + 8);
            if (PHEN(10) && IN(pb + 9)) for (int rep = 0; rep < REPS(10); ++rep) { OPQ
                if (!MK_ONE_LAUNCH) moe_tables(p, tb, tid);
                pg8::Gemm g{wsp<unsigned char>(p, WS_HS), wsp<unsigned char>(p, WS_MGU), DM, DM, (size_t)2 * DFF * DM, 0x7f7f7f7f, 0x77777777};
                pg8::TileOrder S; S.init(__builtin_amdgcn_readfirstlane(tb[8]), 2 * DFF / 256, G, bid, tb + 16);
                pg8::EpiSwiGLU8 E{wsp<unsigned char>(p, WS_ACT), DFF};
                pg8::gemm_phase<1>(lds, g, S, E, wave);
            }
            SEAM(pb + 9);
            if (PHEN(11) && IN(pb + 10)) { OPQ
                if (!MK_ONE_LAUNCH) moe_tables(p, tb, tid);
                { pg8::Gemm g{wsp<unsigned char>(p, WS_ACT), wsp<unsigned char>(p, WS_MD), DFF, DFF, (size_t)DM * DFF, 0x7f7f7f7f, 0x77777777};
                  pg8::TileOrder S; S.init(MAIN_RT, DM / 256, G, bid, tb + 16);
                  pg8::EpiBf16 E{wsp<bf16_t>(p, WS_YS), DM, 0};
                  pg8::gemm_phase<1>(lds, g, S, E, wave); }
                SEAM(pb + 10);
                const int ntail = (__builtin_amdgcn_readfirstlane(tb[8]) - MAIN_RT) * 8;
                if (bid < 2 * ntail) {
                    const int half = bid >= ntail ? 1 : 0, t = bid - half * ntail, pm = t >> 3;
                    const pg8::OneUnit S{pm, t & 7, __builtin_amdgcn_readfirstlane(tb[16 + MAIN_RT + pm]), 1};
                    const pg8::Gemm g{wsp<unsigned char>(p, WS_ACT) + (size_t)MAIN_RT * 256 * DFF + half * (DFF / 2), wsp<unsigned char>(p, WS_MD) + half * (DFF / 2), DFF, DFF / 2, (size_t)DM * DFF, 0x7f7f7f7f, 0x77777777, DFF};
                    float* P = wsp<float>(p, WS_SPLIT) + (size_t)t * 65536; unsigned* fl = wsp<unsigned>(p, WS_CTL) + CW_SPLIT + 64 * t;
                    if (half == 0) { pg8::EpiPartial E{P, fl}; pg8::gemm_phase<1>(lds, g, S, E, wave); }
                    else { pg8::EpiBf16Add E{wsp<bf16_t>(p, WS_YS) + (size_t)MAIN_RT * 256 * DM, DM, P, fl}; pg8::gemm_phase<1>(lds, g, S, E, wave);
                        if (tid == 0) __hip_atomic_fetch_add(wsp<unsigned>(p, WS_CTL) + CW_TAIL, 1u, __ATOMIC_RELAXED, __HIP_MEMORY_SCOPE_AGENT); }
                }
            }
            if (PHEN(12) && IN(pb + 11)) { OPQ
                if (!MK_ONE_LAUNCH) moe_tables(p, tb, tid);
                const int ntail = (__builtin_amdgcn_readfirstlane(tb[8]) - MAIN_RT) * 8;
                const int c0 = 2 * ntail <= G / 2 ? 2 * ntail : 0;
                if (bid >= c0) {
                    const int NGWf = (G - c0) * 8, gwf = (bid - c0) * 8 + wave;
#pragma nounroll
                    for (int pass = 0; pass < 2; ++pass) {
                        int nblk = 0;
                        if (pass) {
                            while ((int)__builtin_amdgcn_readfirstlane(__hip_atomic_load(wsp<unsigned>(p, WS_CTL) + CW_TAIL, __ATOMIC_RELAXED, __HIP_MEMORY_SCOPE_AGENT)) < min(ntail, G)) __builtin_amdgcn_s_sleep(16);
                            __builtin_amdgcn_fence(__ATOMIC_ACQUIRE, "agent");
                        }
                for (int row0 = gwf; row0 < ML; row0 += 8 * NGWf) {
                    i32x4r rt8[8];
#pragma unroll
                    for (int q = 0; q < 8; ++q) rt8[q] = *(const i32x4r*)(wsp<int>(p, WS_ROUTE) + (size_t)min(row0 + q * NGWf, ML - 1) * 8 + 4);
#pragma unroll
                    for (int q = 0; q < 8; ++q) { const int row = row0 + q * NGWf;
                        const int s0 = __builtin_amdgcn_readfirstlane(rt8[q].z), s1 = __builtin_amdgcn_readfirstlane(rt8[q].w);
                        const int blk = (row < ML && (s0 >= MAIN_RT * 256 || s1 >= MAIN_RT * 256)) ? 1 : 0; nblk += blk;
                        if (row < ML && blk == pass) {
                    const float g0 = __int_as_float(rt8[q].x), g1 = __int_as_float(rt8[q].y);
                    const u32x4* y0 = (const u32x4*)(wsp<bf16_t>(p, WS_YS) + (size_t)s0 * DM); const u32x4* y1 = (const u32x4*)(wsp<bf16_t>(p, WS_YS) + (size_t)s1 * DM);
                    const float* gv = mod + (size_t)(row >> 12) * MODW + 5 * DM;
                    const u32x4* xr = (const u32x4*)(wsp<bf16_t>(p, WS_X1) + (size_t)row * DM); float* orow = p.out + (size_t)row * DM;
#pragma unroll
                    for (int j = 0; j < 4; ++j) { const int c = lane + 64 * j; const u32x4 a = y0[c], bq = y1[c];
                        const u32x4 xw = xr[c]; const f32x4 x0 = (f32x4){bf_lo(xw.x), bf_hi(xw.x), bf_lo(xw.y), bf_hi(xw.y)}, x1 = (f32x4){bf_lo(xw.z), bf_hi(xw.z), bf_lo(xw.w), bf_hi(xw.w)}, gg0 = *((const f32x4*)gv + 2 * c), gg1 = *((const f32x4*)gv + 2 * c + 1);
                        f32x4 r0, r1;
                        r0.x = x0.x + gg0.x * (g0 * bf_lo(a.x) + g1 * bf_lo(bq.x)); r0.y = x0.y + gg0.y * (g0 * bf_hi(a.x) + g1 * bf_hi(bq.x));
                        r0.z = x0.z + gg0.z * (g0 * bf_lo(a.y) + g1 * bf_lo(bq.y)); r0.w = x0.w + gg0.w * (g0 * bf_hi(a.y) + g1 * bf_hi(bq.y));
                        r1.x = x1.x + gg1.x * (g0 * bf_lo(a.z) + g1 * bf_lo(bq.z)); r1.y = x1.y + gg1.y * (g0 * bf_hi(a.z) + g1 * bf_hi(bq.z));
                        r1.z = x1.z + gg1.z * (g0 * bf_lo(a.w) + g1 * bf_lo(bq.w)); r1.w = x1.w + gg1.w * (g0 * bf_hi(a.w) + g1 * bf_hi(bq.w));
                        *((f32x4*)orow + 2 * c) = r0; *((f32x4*)orow + 2 * c + 1) = r1; }
                        } }
                }
                        if (nblk == 0) break;
                    }
                }
            }
        }
    }
#undef IN
#undef SEAM
}

extern "C" void kernel_launch(void* const* d_in, const int* in_sizes, int n_in, void* d_out, int out_size, void* d_ws, size_t ws_size, hipStream_t stream) {
    static int grid = 0;
    if (grid == 0) {
        if (n_in != 28 || out_size != ML * DM || ws_size < WS_END) { fprintf(stderr, "kernel_launch: unexpected problem (n_in %d, out %d, ws %zu < %zu)\n", n_in, out_size, ws_size, (size_t)WS_END); grid = -1; return; }
        int dev = 0, cus = 0, per_cu = 0;
        if (hipGetDevice(&dev) != hipSuccess || hipDeviceGetAttribute(&cus, hipDeviceAttributeMultiprocessorCount, dev) != hipSuccess) { grid = -1; return; }
        if (hipFuncSetAttribute((const void*)fwd_kernel, hipFuncAttributeMaxDynamicSharedMemorySize, LDS_BYTES) != hipSuccess) { fprintf(stderr, "kernel_launch: hipFuncSetAttribute failed\n"); grid = -1; return; }
        if (hipOccupancyMaxActiveBlocksPerMultiprocessor(&per_cu, (const void*)fwd_kernel, 512, LDS_BYTES) != hipSuccess || per_cu < 1) { fprintf(stderr, "kernel_launch: occupancy query says %d\n", per_cu); }
        (void)hipGetLastError();
        grid = cus;
    }
    if (grid < 0) return;
    (void)hipMemsetAsync((char*)d_ws + WS_CTL, 0, CTL_BYTES, stream);
    Params prm{};
    for (int i = 0; i < 28; ++i) prm.in[i] = (const float*)d_in[i];
    prm.out = (float*)d_out; prm.ws = (unsigned char*)d_ws;
#if MK_ONE_LAUNCH
    prm.ph_lo = 0; prm.ph_hi = NPHASE + 1;
    hipLaunchKernelGGL(fwd_kernel, dim3(grid), dim3(512), LDS_BYTES, stream, prm);
#else
    for (int ph = 0; ph <= NPHASE; ++ph) {
        if (ph == 11 || ph == 12) continue;
        prm.ph_lo = ph; prm.ph_hi = ph + 1;
        hipLaunchKernelGGL(fwd_kernel, dim3(grid), dim3(512), LDS_BYTES, stream, prm);
    }
#endif
}
```
